# Optimizing an MI355X kernel written in HIP

```python
import math
import numpy as np
import jax
import jax.numpy as jnp
from jax import lax

D_MODEL = 2048
BATCH = 2
SEQ = 4096
DEPTH = 2

HEAD_DIM = 128
N_MIXERS = 4
HEADS_PER_MIXER = D_MODEL // (N_MIXERS * HEAD_DIM)
MIX_W = HEADS_PER_MIXER * HEAD_DIM
IDX_HEADS = 16
IDX_DIM = 64
DSA_TOPK_MAX = 256
DIFF_DIM = HEAD_DIM // 2
MOBA_BLOCK = 256
MOBA_TOPK = 3
MOBA_Q_CHUNK = 64
DILATED_PATTERNS = ((128, 1), (512, 4), (2048, 16))
Q_BLOCK = 128
ROPE_THETA = 10000.0
N_EXPERTS = 16
N_GROUPS = 4
EXPERTS_PER_GROUP = N_EXPERTS // N_GROUPS
TOP_K = 2
D_FF_EXPERT = D_MODEL // 2
EXPERT_BLOCK = 128
LN_EPS = 1e-5
DEEPNORM_ALPHA = (2 * DEPTH) ** 0.25
DEEPNORM_BETA = (8 * DEPTH) ** -0.25
COL_SIZES = (
    MIX_W, HEAD_DIM, HEAD_DIM,
    IDX_HEADS * IDX_DIM, IDX_DIM, IDX_HEADS,
    MIX_W, MIX_W, MIX_W,
    MIX_W, MIX_W, MIX_W,
    MIX_W, MIX_W, MIX_W,
)
VALUE_COLS = (2, 8, 11, 14)
D_IN = sum(COL_SIZES)

kernel_name = 'hybrid_dsa_diff_moba_dilated_moe'


def _layer_norm(x, g, b):
    xf = x.astype(jnp.float32)
    mu = jnp.mean(xf, axis=-1, keepdims=True)
    var = jnp.mean(jnp.square(xf - mu), axis=-1, keepdims=True)
    return ((xf - mu) * lax.rsqrt(var + LN_EPS) * g + b).astype(x.dtype)


def _rms_norm(x, g):
    xf = x.astype(jnp.float32)
    return (xf * lax.rsqrt(jnp.mean(jnp.square(xf), axis=-1, keepdims=True) + LN_EPS) * g).astype(x.dtype)


def _rope(x, pos):
    d = x.shape[-1]
    inv = jnp.power(ROPE_THETA, -jnp.arange(0, d, 2, dtype=jnp.float32) / d)
    ang = pos.astype(jnp.float32)[..., None] * inv
    cos = jnp.cos(ang)[:, :, None, :]
    sin = jnp.sin(ang)[:, :, None, :]
    xf = x.astype(jnp.float32)
    x1, x2 = xf[..., : d // 2], xf[..., d // 2:]
    return jnp.concatenate([x1 * cos - x2 * sin, x1 * sin + x2 * cos], axis=-1).astype(x.dtype)


def _heads(t, d):
    return t.reshape(t.shape[0], t.shape[1], -1, d)


def _unblock(o):
    o = jnp.moveaxis(o, 0, 1)
    return o.reshape((o.shape[0], -1) + o.shape[3:])


def _dsa_attention(q, k, v, iq, ik, iw):
    B, S, H, Dh = q.shape
    n_keep = min(DSA_TOPK_MAX, S // 4)
    key_pos = jnp.arange(S)
    b_idx = jnp.arange(B)[:, None, None]

    def block(i):
        t0 = i * Q_BLOCK
        qb = lax.dynamic_slice_in_dim(q, t0, Q_BLOCK, axis=1)
        iqb = lax.dynamic_slice_in_dim(iq, t0, Q_BLOCK, axis=1)
        iwb = lax.dynamic_slice_in_dim(iw, t0, Q_BLOCK, axis=1).astype(jnp.float32) * IDX_HEADS ** -0.5
        q_pos = t0 + jnp.arange(Q_BLOCK)
        rel = jax.nn.relu(jnp.einsum('bqhd,bsd->bqhs', iqb, ik).astype(jnp.float32) * IDX_DIM ** -0.5)
        score = jnp.einsum('bqh,bqhs->bqs', iwb, rel)
        score = jnp.where(key_pos[None, None, :] <= q_pos[None, :, None], score, -jnp.inf)
        _, idx = lax.top_k(score, n_keep)
        valid = idx <= q_pos[None, :, None]
        k_sel = k[b_idx, idx]
        v_sel = v[b_idx, idx]
        logits = jnp.einsum('bqhd,bqkd->bhqk', qb, k_sel).astype(jnp.float32) * Dh ** -0.5
        p = jax.nn.softmax(jnp.where(valid[:, None], logits, -jnp.inf), axis=-1).astype(v.dtype)
        return jnp.einsum('bhqk,bqkd->bqhd', p, v_sel)

    return _unblock(lax.map(block, jnp.arange(S // Q_BLOCK)))


def _diff_attention(q, k, v, lam):
    B, S, H, _, dd = q.shape
    key_pos = jnp.arange(S)

    def block(i):
        t0 = i * Q_BLOCK
        qb = lax.dynamic_slice_in_dim(q, t0, Q_BLOCK, axis=1)
        q_pos = t0 + jnp.arange(Q_BLOCK)
        causal = key_pos[None, :] <= q_pos[:, None]
        s = jnp.einsum('bqhcd,bshcd->bhcqs', qb, k).astype(jnp.float32) * dd ** -0.5
        p = jax.nn.softmax(jnp.where(causal, s, -jnp.inf), axis=-1)
        w = p[:, :, 0] - lam * p[:, :, 1]
        return jnp.einsum('bhqs,bshd->bqhd', w.astype(v.dtype), v)

    return _unblock(lax.map(block, jnp.arange(S // Q_BLOCK)))


def _moba_attention(q, k, v):
    B, S, H, Dh = q.shape
    sp = -(-S // MOBA_BLOCK) * MOBA_BLOCK
    n_blk = sp // MOBA_BLOCK
    n_sel = min(MOBA_TOPK, n_blk)
    pad = ((0, 0), (0, sp - S), (0, 0), (0, 0))
    q, k, v = jnp.pad(q, pad), jnp.pad(k, pad), jnp.pad(v, pad)
    kbh = k.reshape(B, n_blk, MOBA_BLOCK, H, Dh).transpose(0, 3, 1, 2, 4)
    vbh = v.reshape(B, n_blk, MOBA_BLOCK, H, Dh).transpose(0, 3, 1, 2, 4)
    k_mean = jnp.mean(kbh.astype(jnp.float32), axis=3).astype(k.dtype)
    b_idx = jnp.arange(B)[:, None, None, None]
    h_idx = jnp.arange(H)[None, None, :, None]
    blk_ids = jnp.arange(n_blk)
    scale = Dh ** -0.5
    n_sel_keys = n_sel * MOBA_BLOCK

    def block(i):
        t0 = i * MOBA_Q_CHUNK
        qb = lax.dynamic_slice_in_dim(q, t0, MOBA_Q_CHUNK, axis=1)
        q_pos = t0 + jnp.arange(MOBA_Q_CHUNK)
        own = t0 // MOBA_BLOCK
        gate = jnp.einsum('bqhd,bhnd->bqhn', qb, k_mean).astype(jnp.float32)
        gate = jnp.where(blk_ids < own, gate, -jnp.inf)
        _, sel = lax.top_k(gate, n_sel)
        sel_ok = sel < own
        k_sel = kbh[b_idx, h_idx, sel]
        v_sel = vbh[b_idx, h_idx, sel]
        k_own = lax.dynamic_index_in_dim(kbh, own, axis=2, keepdims=False)
        v_own = lax.dynamic_index_in_dim(vbh, own, axis=2, keepdims=False)
        own_pos = own * MOBA_BLOCK + jnp.arange(MOBA_BLOCK)
        causal = own_pos[None, :] <= q_pos[:, None]
        s_sel = jnp.einsum('bqhd,bqhnkd->bqhnk', qb, k_sel).astype(jnp.float32) * scale
        s_sel = jnp.where(sel_ok[..., None], s_sel, -jnp.inf).reshape(B, MOBA_Q_CHUNK, H, n_sel_keys)
        s_own = jnp.einsum('bqhd,bhkd->bqhk', qb, k_own).astype(jnp.float32) * scale
        s_own = jnp.where(causal[None, :, None, :], s_own, -jnp.inf)
        p = jax.nn.softmax(jnp.concatenate([s_sel, s_own], axis=-1), axis=-1).astype(v.dtype)
        p_sel = p[..., :n_sel_keys].reshape(B, MOBA_Q_CHUNK, H, n_sel, MOBA_BLOCK)
        p_own = p[..., n_sel_keys:]
        return (jnp.einsum('bqhnk,bqhnkd->bqhd', p_sel, v_sel)
                + jnp.einsum('bqhk,bhkd->bqhd', p_own, v_own))

    return _unblock(lax.map(block, jnp.arange(sp // MOBA_Q_CHUNK)))[:, :S]


def _dilated_branch(q, k, v, window, dilation):
    B, S, H, Dh = q.shape
    band = window // dilation
    n_sub = -(-S // dilation)
    nb = -(-n_sub // band)
    sp = dilation * nb * band

    def to_blocks(a):
        a = jnp.pad(a, ((0, 0), (0, sp - S), (0, 0), (0, 0)))
        a = a.reshape(B, nb * band, dilation, H, Dh).transpose(0, 2, 1, 3, 4)
        return a.reshape(B, dilation, nb, band, H, Dh)

    def with_prev(a):
        prev = jnp.pad(a[:, :, :-1], ((0, 0), (0, 0), (1, 0), (0, 0), (0, 0), (0, 0)))
        return jnp.concatenate([prev, a], axis=3)

    qb = to_blocks(q)
    kk = with_prev(to_blocks(k))
    vv = with_prev(to_blocks(v))
    qi = jnp.arange(band)[:, None]
    ki = jnp.arange(2 * band)[None, :]
    dist = qi + band - ki
    band_ok = (dist >= 0) & (dist <= band)
    mask = band_ok[None] & ((jnp.arange(nb)[:, None, None] > 0) | (ki >= band)[None])
    logits = jnp.einsum('brjqhd,brjkhd->brjhqk', qb, kk).astype(jnp.float32) * Dh ** -0.5
    logits = jnp.where(mask[:, None], logits, -jnp.inf)
    lse = jax.nn.logsumexp(logits, axis=-1, keepdims=True)
    p = jnp.exp(logits - lse).astype(v.dtype)
    o = jnp.einsum('brjhqk,brjkhd->brjqhd', p, vv)
    o = o.reshape(B, dilation, nb * band, H, Dh).transpose(0, 2, 1, 3, 4).reshape(B, sp, H, Dh)[:, :S]
    lse = lse[..., 0].transpose(0, 1, 2, 4, 3).reshape(B, dilation, nb * band, H)
    lse = lse.transpose(0, 2, 1, 3).reshape(B, sp, H)[:, :S]
    return o, lse


def _dilated_attention(q, k, v):
    outs, lses = [], []
    for window, dilation in DILATED_PATTERNS:
        o, lse = _dilated_branch(q, k, v, window, dilation)
        outs.append(o)
        lses.append(lse)
    wts = jax.nn.softmax(jnp.stack(lses, axis=0), axis=0)
    return jnp.einsum('pbsh,pbshd->bshd', wts.astype(v.dtype), jnp.stack(outs, axis=0))


def _moe(x, router_w, router_bias, w_gate, w_up, w_down):
    B, S, D = x.shape
    T = B * S
    xt = x.reshape(T, D)
    aff = jax.nn.sigmoid(jnp.dot(xt, router_w).astype(jnp.float32))
    grouped = (aff + router_bias.astype(jnp.float32)).reshape(T, N_GROUPS, EXPERTS_PER_GROUP)
    group_score = jnp.sum(lax.top_k(grouped, TOP_K)[0], axis=-1)
    g = jnp.argmax(group_score, axis=-1)
    in_group = jnp.take_along_axis(grouped, g[:, None, None], axis=1)[:, 0]
    _, local = lax.top_k(in_group, TOP_K)
    e_idx = g[:, None] * EXPERTS_PER_GROUP + local
    gate = jnp.take_along_axis(aff, e_idx, axis=1)
    gate = gate / jnp.sum(gate, axis=-1, keepdims=True)
    A = T * TOP_K
    e_flat = e_idx.reshape(A)
    tok_flat = jnp.repeat(jnp.arange(T, dtype=jnp.int32), TOP_K)
    order = jnp.argsort(e_flat)
    e_sorted = e_flat[order]
    counts = jnp.bincount(e_flat, length=N_EXPERTS)
    padded = (counts + EXPERT_BLOCK - 1) // EXPERT_BLOCK * EXPERT_BLOCK
    start = jnp.cumsum(counts) - counts
    pend = jnp.cumsum(padded)
    pstart = pend - padded
    dest = pstart[e_sorted] + (jnp.arange(A) - start[e_sorted])
    n_slots = A + N_EXPERTS * EXPERT_BLOCK
    n_blocks = n_slots // EXPERT_BLOCK
    slot_tok = jnp.full((n_slots,), T, jnp.int32).at[dest].set(tok_flat[order])
    slot_gate = jnp.zeros((n_slots,), jnp.float32).at[dest].set(gate.reshape(A)[order])
    block_expert = jnp.minimum(jnp.searchsorted(pend, jnp.arange(n_blocks) * EXPERT_BLOCK, side='right'), N_EXPERTS - 1)
    x_pad = jnp.concatenate([xt, jnp.zeros((1, D), xt.dtype)], axis=0)
    xs = x_pad[slot_tok].reshape(n_blocks, EXPERT_BLOCK, D)

    def expert_block(args):
        xb, e = args
        h = jax.nn.silu(xb @ w_gate[e]) * (xb @ w_up[e])
        return h @ w_down[e]

    ys = lax.map(expert_block, (xs, block_expert)).reshape(n_slots, D)
    ys = (ys * slot_gate[:, None]).astype(xt.dtype)
    out = jnp.zeros((T + 1, D), xt.dtype).at[slot_tok].add(ys)[:T]
    return out.reshape(B, S, D)


def setup_inputs(seed: int = 0) -> dict:
    key = jax.random.key(seed)
    ks = jax.random.split(key, 16)
    f32 = jnp.float32
    col_scale = jnp.asarray(np.concatenate([
        np.full((n,), DEEPNORM_BETA if i in VALUE_COLS else 1.0, np.float32)
        for i, n in enumerate(COL_SIZES)]))
    x = jax.random.normal(ks[0], (BATCH, SEQ, D_MODEL), f32)
    positions = jnp.broadcast_to(jnp.arange(SEQ, dtype=jnp.int32), (BATCH, SEQ))
    w_in = jax.random.normal(ks[1], (DEPTH, D_MODEL, D_IN), f32) * (D_MODEL ** -0.5) * col_scale
    w_out = jax.random.normal(ks[2], (DEPTH, D_MODEL, D_MODEL), f32) * (D_MODEL ** -0.5 * DEEPNORM_BETA)
    diff_lambda = jax.random.normal(ks[3], (DEPTH, 4, DIFF_DIM), f32) * 0.1
    diff_norm_g = 1.0 + 0.02 * jax.random.normal(ks[4], (DEPTH, HEAD_DIM), f32)
    ln_mix_g = 1.0 + 0.02 * jax.random.normal(ks[5], (DEPTH, D_MODEL), f32)
    ln_mix_b = 0.02 * jax.random.normal(ks[6], (DEPTH, D_MODEL), f32)
    router_w = jax.random.normal(ks[7], (D_MODEL, N_EXPERTS), f32) * D_MODEL ** -0.5
    router_bias = 0.01 * jax.random.normal(ks[8], (N_EXPERTS,), f32)
    w_gate = jax.random.normal(ks[9], (DEPTH, N_EXPERTS, D_MODEL, D_FF_EXPERT), f32) * (D_MODEL ** -0.5 * DEEPNORM_BETA)
    w_up = jax.random.normal(ks[10], (DEPTH, N_EXPERTS, D_MODEL, D_FF_EXPERT), f32) * (D_MODEL ** -0.5 * DEEPNORM_BETA)
    w_down = jax.random.normal(ks[11], (DEPTH, N_EXPERTS, D_FF_EXPERT, D_MODEL), f32) * (D_FF_EXPERT ** -0.5 * DEEPNORM_BETA)
    ln_ffn_g = 1.0 + 0.02 * jax.random.normal(ks[12], (DEPTH, D_MODEL), f32)
    ln_ffn_b = 0.02 * jax.random.normal(ks[13], (DEPTH, D_MODEL), f32)
    return {'x': x, 'positions': positions, 'w_in': w_in, 'w_out': w_out,
            'diff_lambda': diff_lambda, 'diff_norm_g': diff_norm_g,
            'ln_mix_g': ln_mix_g, 'ln_mix_b': ln_mix_b,
            'router_w': router_w, 'router_bias': router_bias,
            'w_gate': w_gate, 'w_up': w_up, 'w_down': w_down,
            'ln_ffn_g': ln_ffn_g, 'ln_ffn_b': ln_ffn_b}


def reference(x, positions, w_in, w_out, diff_lambda, diff_norm_g, ln_mix_g, ln_mix_b,
              router_w, router_bias, w_gate, w_up, w_down, ln_ffn_g, ln_ffn_b):
    B, S, _ = x.shape
    H = HEADS_PER_MIXER
    split_at = np.cumsum(COL_SIZES)[:-1].tolist()
    for layer in range(DEPTH):
        proj = jnp.einsum('bsd,dc->bsc', x, w_in[layer])
        (a_q, a_k, a_v, i_q, i_k, i_w, b_q, b_k, b_v,
         c_q, c_k, c_v, d_q, d_k, d_v) = jnp.split(proj, split_at, axis=-1)
        o_a = _dsa_attention(_rope(_heads(a_q, HEAD_DIM), positions),
                             _rope(a_k[:, :, None], positions)[:, :, 0], a_v,
                             _rope(_heads(i_q, IDX_DIM), positions),
                             _rope(i_k[:, :, None], positions)[:, :, 0], i_w)
        lam_init = 0.8 - 0.6 * math.exp(-0.3 * layer)
        lq1, lk1, lq2, lk2 = diff_lambda[layer].astype(jnp.float32)
        lam = jnp.exp(jnp.sum(lq1 * lk1)) - jnp.exp(jnp.sum(lq2 * lk2)) + lam_init
        bq = _rope(_heads(b_q, DIFF_DIM), positions).reshape(B, S, H, 2, DIFF_DIM)
        bk = _rope(_heads(b_k, DIFF_DIM), positions).reshape(B, S, H, 2, DIFF_DIM)
        o_b = _diff_attention(bq, bk, _heads(b_v, HEAD_DIM), lam)
        o_b = (_rms_norm(o_b, diff_norm_g[layer]) * (1.0 - lam_init)).astype(x.dtype)
        o_c = _moba_attention(_rope(_heads(c_q, HEAD_DIM), positions),
                              _rope(_heads(c_k, HEAD_DIM), positions), _heads(c_v, HEAD_DIM))
        o_d = _dilated_attention(_rope(_heads(d_q, HEAD_DIM), positions),
                                 _rope(_heads(d_k, HEAD_DIM), positions), _heads(d_v, HEAD_DIM))
        mix = jnp.concatenate([o_a.reshape(B, S, MIX_W), o_b.reshape(B, S, MIX_W),
                               o_c.reshape(B, S, MIX_W), o_d.reshape(B, S, MIX_W)], axis=-1)
        x = _layer_norm(DEEPNORM_ALPHA * x + mix @ w_out[layer], ln_mix_g[layer], ln_mix_b[layer])
        moe_out = _moe(x, router_w, router_bias, w_gate[layer], w_up[layer], w_down[layer])
        x = _layer_norm(DEEPNORM_ALPHA * x + moe_out, ln_ffn_g[layer], ln_ffn_b[layer])
    return x
```

```cpp
#include <hip/hip_runtime.h>
#include <hip/hip_cooperative_groups.h>
#include <cstdio>
#include <cstdint>
namespace cg = cooperative_groups;

#ifndef MK_N_LAUNCHES
#define MK_N_LAUNCHES 1
#endif

#define LAS __attribute__((address_space(3)))
typedef unsigned short bf16_t;
typedef short bf16x8 __attribute__((ext_vector_type(8)));
typedef short s16x4 __attribute__((ext_vector_type(4)));
typedef float f32x2 __attribute__((ext_vector_type(2)));
typedef float f32x4 __attribute__((ext_vector_type(4)));
typedef float f32x16 __attribute__((ext_vector_type(16)));
typedef unsigned u32x2 __attribute__((ext_vector_type(2)));
typedef unsigned u32x4 __attribute__((ext_vector_type(4)));
typedef __bf16 bf16x2_t __attribute__((ext_vector_type(2)));
typedef int v8i32_t __attribute__((ext_vector_type(8)));

constexpr int NB = 2, SEQ = 4096, T = NB * SEQ, DM = 2048, DEPTH = 2;
constexpr int PP = 6480;
constexpr int NPROJ = 6656;
constexpr int C_AQ = 0, C_AK = 512, C_AV = 640, C_IQ = 768, C_IK = 1792, C_IW = 1856, C_BQ = 1872, C_BK = 2384, C_BV = 2896,
              C_CQ = 3408, C_CK = 3920, C_CV = 4432, C_DQ = 4944, C_DK = 5456, C_DV = 5968;
constexpr int NE = 16, DFF = 1024, HROWS = 20480;
constexpr float LN_EPS = 1e-5f;
constexpr float ALPHA = 1.41421356237309515f;
constexpr float LOG2E = 1.4426950408889634f;
constexpr float NEG_INF = -__builtin_huge_valf();

constexpr size_t MiB = 1u << 20;
constexpr size_t WS_CTL = 0, CTL_BYTES = 1 * MiB;
constexpr size_t WS_WIN = 1 * MiB;
constexpr size_t WS_WOUT = 53 * MiB;
constexpr size_t WS_WGU = 69 * MiB;
constexpr size_t WS_WD = 325 * MiB;
constexpr size_t WS_XB = 453 * MiB;
constexpr size_t WS_PROJ = 485 * MiB;
constexpr size_t WS_MIX = 587 * MiB;
constexpr size_t WS_Y1 = 619 * MiB;
constexpr size_t WS_XF2 = 683 * MiB;
constexpr size_t WS_X1B = 747 * MiB;
constexpr size_t WS_XQ = 763 * MiB;
constexpr size_t WS_H = 780 * MiB;
constexpr size_t WS_YS = 820 * MiB;
constexpr size_t WS_R128 = 900 * MiB;
constexpr size_t WS_R64 = 904 * MiB;
constexpr size_t WS_ROUTE = 906 * MiB;
constexpr size_t WS_BM = 910 * MiB;
constexpr size_t WS_END = 914 * MiB;
constexpr size_t RT_TOKE = 0, RT_RANK = 65536, RT_LIST = 131072, RT_GATE = 131072 + 524288;
constexpr size_t RT_TOKG = 2 * MiB, RT_BLK = 2 * MiB + 65536;
constexpr int CW_QUEUE = 64;
constexpr int CW_CNT = 1024;
constexpr int CW_BAR = 4096;
#define XB_TMO      128
#define XB_SPIN_CAP (1u << 22)
constexpr int CW_DSAC = 8192;
constexpr size_t KM_OFF = 262144;

constexpr int LDS_CTL_OFF = 155648;
constexpr int LDS_BYTES = 156672;
constexpr int VP = 320;
constexpr int VT_BYTES = 32 * VP;

__constant__ short GRP[104][4] = {
{1,0,64,0}, {1,32,64,32}, {1,128,64,0}, {1,160,64,32}, {1,256,64,0}, {1,288,64,32}, {1,384,64,0}, {1,416,64,32}, {1,512,64,0}, {1,544,64,32}, {0,640,32,0}, {0,704,32,0}, {2,768,32,0}, {2,832,32,0}, {2,896,32,0}, {2,960,32,0}, {2,1024,32,0}, {2,1088,32,0}, {2,1152,32,0}, {2,1216,32,0}, {2,1280,32,0}, {2,1344,32,0}, {2,1408,32,0}, {2,1472,32,0}, {2,1536,32,0}, {2,1600,32,0}, {2,1664,32,0}, {2,1728,32,0}, {2,1792,32,0}, {3,1856,0,0}, {1,3408,64,0}, {1,3440,64,32}, {1,3536,64,0}, {1,3568,64,32}, {1,3664,64,0}, {1,3696,64,32}, {1,3792,64,0}, {1,3824,64,32}, {1,3920,64,0}, {1,3952,64,32}, {1,4048,64,0}, {1,4080,64,32}, {1,4176,64,0}, {1,4208,64,32}, {1,4304,64,0}, {1,4336,64,32}, {0,4432,32,0}, {0,4496,32,0}, {0,4560,32,0}, {0,4624,32,0}, {0,4688,32,0}, {0,4752,32,0}, {0,4816,32,0}, {0,4880,32,0}, {1,4944,64,0}, {1,4976,64,32}, {1,5072,64,0}, {1,5104,64,32}, {1,5200,64,0}, {1,5232,64,32}, {1,5328,64,0}, {1,5360,64,32}, {1,5456,64,0}, {1,5488,64,32}, {1,5584,64,0}, {1,5616,64,32}, {1,5712,64,0}, {1,5744,64,32}, {1,5840,64,0}, {1,5872,64,32}, {0,5968,32,0}, {0,6032,32,0}, {0,6096,32,0}, {0,6160,32,0}, {0,6224,32,0}, {0,6288,32,0}, {0,6352,32,0}, {0,6416,32,0}, {4,0,0,0}, {4,0,0,0}, {2,1872,32,0}, {2,1936,32,0}, {2,2000,32,0}, {2,2064,32,0}, {2,2128,32,0}, {2,2192,32,0}, {2,2256,32,0}, {2,2320,32,0}, {2,2384,32,0}, {2,2448,32,0}, {2,2512,32,0}, {2,2576,32,0}, {2,2640,32,0}, {2,2704,32,0}, {2,2768,32,0}, {2,2832,32,0}, {0,2896,32,0}, {0,2960,32,0}, {0,3024,32,0}, {0,3088,32,0}, {0,3152,32,0}, {0,3216,32,0}, {0,3280,32,0}, {0,3344,32,0}};

__device__ __forceinline__ unsigned cvtpk(float lo, float hi) { f32x2 v = {lo, hi}; bf16x2_t b = __builtin_convertvector(v, bf16x2_t); return __builtin_bit_cast(unsigned, b); }
__device__ __forceinline__ unsigned pk4_fp8(float a, float b, float c, float d) { unsigned w = 0u; w = __builtin_amdgcn_cvt_pk_fp8_f32(a, b, w, false); w = __builtin_amdgcn_cvt_pk_fp8_f32(c, d, w, true); return w; }
__device__ __forceinline__ float bf2f(unsigned short b) { return __builtin_bit_cast(float, (unsigned)b << 16); }
__device__ __forceinline__ float bflo(unsigned w) { return __builtin_bit_cast(float, w << 16); }
__device__ __forceinline__ float bfhi(unsigned w) { return __builtin_bit_cast(float, w & 0xffff0000u); }
__device__ __forceinline__ float wave_sum(float v) {
#pragma unroll
    for (int o = 1; o < 64; o <<= 1) v += __shfl_xor(v, o);
    return v;
}
__device__ __forceinline__ int crow(int r, int hi) { return (r & 3) + 8 * (r >> 2) + 4 * hi; }
#define RLX_AGENT __ATOMIC_RELAXED, __HIP_MEMORY_SCOPE_AGENT
__device__ __forceinline__ int lane_id() { int l; asm volatile("v_mbcnt_lo_u32_b32 %0, -1, 0\n\tv_mbcnt_hi_u32_b32 %0, -1, %0" : "=v"(l)); return l; }

struct swap2 { float a, b; };
__device__ __forceinline__ swap2 pl32swap(float x, float y) { const auto r = __builtin_amdgcn_permlane32_swap(__float_as_uint(x), __float_as_uint(y), false, false); const unsigned u0 = r[0], u1 = r[1]; swap2 o; o.a = __uint_as_float(u0); o.b = __uint_as_float(u1); return o; }
__device__ __forceinline__ swap2 pl16swap(float x, float y) { const auto r = __builtin_amdgcn_permlane16_swap(__float_as_uint(x), __float_as_uint(y), false, false); const unsigned u0 = r[0], u1 = r[1]; swap2 o; o.a = __uint_as_float(u0); o.b = __uint_as_float(u1); return o; }

namespace pg8 {
constexpr int BM = 256, BK = 64, HALF = 128, HTB = HALF * BK * 2, STAGE_BYTES = 8 * HTB, NXCD = 8, WGM = 8;
__device__ __forceinline__ int lds_byte(int r, int c) { const int st = (r >> 4) * 2 + (c >> 5), rr = r & 15, cc = c & 31, ob = rr * 64 + cc * 2; return st * 1024 + (ob ^ (((ob >> 9) & 1) << 5)); }
__device__ __forceinline__ void stage_rc(int b, int& R, int& C) { const int st = b / 1024, sb = b % 1024, swz = sb ^ (((sb >> 9) & 1) << 5); R = (st >> 1) * 16 + swz / 64; C = (st & 1) * 32 + (swz % 64) / 2; }
__device__ __forceinline__ int perm32(int rho) { const int n = rho >> 4, i = rho & 15; return 8 * (i >> 2) + 4 * n + (i & 3); }

struct Unit { int pm, pn, e; const char* B; const int* list; int row0, cnt, orow0; };
__device__ __forceinline__ int a_row(const Unit& u, int r) {
    if (u.list) { int rr = u.row0 + r; rr = rr < u.cnt ? rr : u.cnt - 1; return u.list[rr]; }
    return u.row0 + r;
}

struct DenseOrder {
    int nM, nN, nwg, G, c, K; const char* Bt;
    __device__ void init(int M, int N, int K_, const void* Bt_, int G_, int c_) { nM = M / BM; nN = N / BM; nwg = nM * nN; G = G_; c = c_; K = K_; Bt = (const char*)Bt_; }
    __device__ bool next(int i, Unit& u) const {
        const long L = (long)i * G + c; if (L >= nwg) return false;
        int wgid = (int)L; { const int q = nwg / NXCD, r = nwg % NXCD, xcd = wgid % NXCD, off = wgid / NXCD; wgid = (xcd < r ? xcd * (q + 1) : r * (q + 1) + (xcd - r) * q) + off; }
        const int nig = WGM * nN, gid = wgid / nig, fm = gid * WGM, gsz = (nM - fm) < WGM ? (nM - fm) : WGM;
        u.pm = fm + ((wgid % nig) % gsz); u.pn = (wgid % nig) / gsz; u.e = 0;
        u.B = Bt + (size_t)u.pn * BM * K * 2; u.list = nullptr; u.row0 = u.pm * BM; u.cnt = 0; u.orow0 = u.pm * BM; return true;
    }
};

template <class Epi, class Sched, bool GATHER, bool FP8 = false>
__device__ __forceinline__ void gemm_phase(LAS unsigned char* lds, const bf16_t* Aptr, const int K, const Sched& S, const Epi& E, const int wv) {
    int tid_ = wv * 64 + lane_id(); asm volatile("" : "+v"(tid_));
    const int tid = tid_, wid = __builtin_amdgcn_readfirstlane(tid >> 6), lane = tid & 63, wr = wid >> 2, wc = wid & 3, fr = lane & 15, fq = lane >> 4;
    const int nt = K / BK;
    unsigned voffB[2], voffA[2];
#pragma unroll
    for (int i = 0; i < 2; ++i) { int sR, sC; stage_rc(tid * 16 + i * 8192, sR, sC); const int Rb = Epi::PERM ? ((sR & ~31) + perm32(sR & 31)) : sR; voffB[i] = (unsigned)(Rb * K + sC) * 2u; voffA[i] = (unsigned)(sR * K + sC) * 2u; }
    const size_t kstep = (size_t)(BK * 2);
    const size_t hstep = (size_t)HALF * K * 2;
    const unsigned ldsw = (unsigned)wid * 1024u;
    const int aoff = FP8 ? lds_byte(wr * 64 + fr, fq * 16) : lds_byte(wr * 64 + fr, fq * 8), boff = FP8 ? lds_byte(wc * 32 + fr, fq * 16) : lds_byte(wc * 32 + fr, fq * 8);
    const int aoff2 = FP8 ? lds_byte(wr * 64 + fr, fq * 16 + 8) : aoff + 1024, boff2 = FP8 ? lds_byte(wc * 32 + fr, fq * 16 + 8) : boff + 1024;
    const char* gA = (const char*)Aptr;
#define PG8_SA(b, h) (((b) * 2 + (h)) * HTB)
#define PG8_SB(b, h) ((4 + (b) * 2 + (h)) * HTB)
#define PG8_STAGE2(bufoff, gbase, o0, o1) do { \
        __builtin_amdgcn_global_load_lds((const unsigned*)((const char*)(gbase) + (o0)), (LAS unsigned*)(lds + (bufoff) + ldsw), 16, 0, 0); \
        __builtin_amdgcn_global_load_lds((const unsigned*)((const char*)(gbase) + (o1)), (LAS unsigned*)(lds + (bufoff) + ldsw + 8192), 16, 0, 0); } while (0)
#define PG8_STAGEB(bufoff, gbase) PG8_STAGE2(bufoff, gbase, voffB[0], voffB[1])
#define PG8_STAGEA(bufoff, gbase, h, useN) do { if constexpr (GATHER) { const u32x4 vo_ = *(const LAS u32x4*)(lds + STAGE_BYTES + ((((useN) ? ui + 1 : ui) & 1) ? 8192 : 0) + tid * 16); \
            if ((h) == 0) { PG8_STAGE2(bufoff, gbase, vo_.x, vo_.y); } else { PG8_STAGE2(bufoff, gbase, vo_.z, vo_.w); } } \
        else { const char* gb_ = (const char*)(gbase) + (size_t)((useN) ? nrow0 : crow0) * K * 2 + (h) * hstep; PG8_STAGE2(bufoff, gb_, voffA[0], voffA[1]); } } while (0)
#define PG8_LD16(p_) (*(const LAS u32x4*)(p_))
#define PG8_MK8(lo_, hi_) (v8i32_t){(int)lo_.x, (int)lo_.y, (int)lo_.z, (int)lo_.w, (int)hi_.x, (int)hi_.y, (int)hi_.z, (int)hi_.w}
#define PG8_LDA(dst, b, h) do { _Pragma("unroll") for (int m = 0; m < 4; ++m) { \
        if constexpr (FP8) { const u32x4 lo_ = PG8_LD16(lds + PG8_SA(b, h) + aoff + m * 2048), hi_ = PG8_LD16(lds + PG8_SA(b, h) + aoff2 + m * 2048); dst##8[m] = PG8_MK8(lo_, hi_); } \
        else { dst[m][0] = *(const LAS bf16x8*)(lds + PG8_SA(b, h) + aoff + m * 2048); dst[m][1] = *(const LAS bf16x8*)(lds + PG8_SA(b, h) + aoff2 + m * 2048); } } } while (0)
#define PG8_LDB(dst, b, h) do { _Pragma("unroll") for (int n = 0; n < 2; ++n) { \
        if constexpr (FP8) { const u32x4 lo_ = PG8_LD16(lds + PG8_SB(b, h) + boff + n * 2048), hi_ = PG8_LD16(lds + PG8_SB(b, h) + boff2 + n * 2048); dst##8[n] = PG8_MK8(lo_, hi_); } \
        else { dst[n][0] = *(const LAS bf16x8*)(lds + PG8_SB(b, h) + boff + n * 2048); dst[n][1] = *(const LAS bf16x8*)(lds + PG8_SB(b, h) + boff2 + n * 2048); } } } while (0)
#define PG8_MMA(ai, bj, At, Bt) do { __builtin_amdgcn_s_setprio(1); _Pragma("unroll") for (int m = 0; m < 4; ++m) _Pragma("unroll") for (int n = 0; n < 2; ++n) { \
        if constexpr (FP8) { asm("v_mfma_scale_f32_16x16x128_f8f6f4 %0, %1, %2, %0, %3, %4 op_sel_hi:[0,0,0]" : "+v"(acc[ai][bj][m][n]) : "v"(Bt##8[n]), "v"(At##8[m]), "v"(sc_w_), "v"(sc_a_)); } \
        else { _Pragma("unroll") for (int k = 0; k < 2; ++k) acc[ai][bj][m][n] = __builtin_amdgcn_mfma_f32_16x16x32_bf16(Bt[n][k], At[m][k], acc[ai][bj][m][n], 0, 0, 0); } } \
        __builtin_amdgcn_s_setprio(0); } while (0)
#define PG8_WAIT_V(n) asm volatile("s_waitcnt vmcnt(" #n ")" ::: "memory")
#define PG8_WAIT_L(n) asm volatile("s_waitcnt lgkmcnt(" #n ")" ::: "memory")
#define PG8_BAR __builtin_amdgcn_s_barrier()
#define PG8_SCHED __builtin_amdgcn_sched_barrier(0)
#define PG8_AOFFS(u, par) do { unsigned v_[2][2]; _Pragma("unroll") for (int i_ = 0; i_ < 2; ++i_) { int sR_, sC_; stage_rc(tid * 16 + i_ * 8192, sR_, sC_); _Pragma("unroll") for (int h_ = 0; h_ < 2; ++h_) v_[h_][i_] = (unsigned)(a_row(u, h_ * HALF + sR_) * K + sC_) * 2u; } \
        *(LAS u32x4*)(lds + STAGE_BYTES + (((par) & 1) ? 8192 : 0) + tid * 16) = (u32x4){v_[0][0], v_[0][1], v_[1][0], v_[1][1]}; } while (0)
    Unit cur, nxt; int ui = 0;
    if (!S.next(0, cur)) return;
    f32x4 acc[2][2][4][2];
#pragma unroll
    for (int a = 0; a < 2; ++a)
#pragma unroll
        for (int b = 0; b < 2; ++b)
#pragma unroll
            for (int m = 0; m < 4; ++m)
#pragma unroll
                for (int n = 0; n < 2; ++n) acc[a][b][m][n] = (f32x4){0.f, 0.f, 0.f, 0.f};
    const int sc_w_ = E.scale_w, sc_a_ = E.scale_a;
    bf16x8 At[4][2], B0[2][2], B1[2][2]; v8i32_t At8[4], B08[2], B18[2];
    int crow0 = cur.row0, nrow0 = cur.row0;
    if constexpr (GATHER) { PG8_AOFFS(cur, 0); }
    const char* cB = cur.B;
    PG8_STAGEB(PG8_SB(0, 0), cB); PG8_STAGEB(PG8_SB(0, 1), cB + hstep); PG8_STAGEA(PG8_SA(0, 0), gA, 0, false); PG8_STAGEA(PG8_SA(0, 1), gA, 1, false);
    if (wr == 1) PG8_BAR;
    PG8_WAIT_V(2); PG8_BAR;
    PG8_STAGEB(PG8_SB(1, 0), cB + kstep); PG8_STAGEA(PG8_SA(1, 0), gA + kstep, 0, false); PG8_STAGEB(PG8_SB(1, 1), cB + hstep + kstep);
    PG8_WAIT_V(6); PG8_BAR;
    for (;;) {
        const bool has_next = S.next(ui + 1, nxt);
        if constexpr (GATHER) { if (has_next) { PG8_AOFFS(nxt, ui + 1); } else { PG8_AOFFS(cur, ui + 1); } }
        nrow0 = has_next ? nxt.row0 : crow0;
        const char* nB = has_next ? nxt.B : cB;
#pragma clang loop unroll(disable)
        for (int t = 0; t < nt; t += 2) {
            const bool last = (t == nt - 2);
            const char* a1 = gA + (size_t)(t + 1) * kstep;
            const char* a2 = last ? gA : gA + (size_t)(t + 2) * kstep; const char* b2 = last ? nB : cB + (size_t)(t + 2) * kstep;
            const char* a3 = a2 + kstep; const char* b3 = b2 + kstep;
            PG8_LDB(B0, 0, 0); PG8_LDB(B1, 0, 1); PG8_SCHED; PG8_LDA(At, 0, 0); PG8_STAGEA(PG8_SA(1, 1), a1, 1, false);
            PG8_WAIT_V(8); PG8_WAIT_L(0); PG8_BAR; PG8_MMA(0, 0, At, B0); PG8_MMA(0, 1, At, B1); PG8_BAR; PG8_SCHED;
            PG8_LDA(At, 0, 1); PG8_STAGEB(PG8_SB(0, 0), b2); PG8_STAGEB(PG8_SB(0, 1), b2 + hstep); PG8_STAGEA(PG8_SA(0, 0), a2, 0, last);
            PG8_WAIT_V(8); PG8_WAIT_L(0); PG8_BAR; PG8_MMA(1, 0, At, B0); PG8_MMA(1, 1, At, B1); PG8_BAR; PG8_SCHED;
            PG8_LDB(B0, 1, 0); PG8_LDB(B1, 1, 1); PG8_SCHED; PG8_LDA(At, 1, 0); PG8_STAGEA(PG8_SA(0, 1), a2, 1, last);
            PG8_WAIT_V(8); PG8_WAIT_L(0); PG8_BAR; PG8_MMA(0, 0, At, B0); PG8_MMA(0, 1, At, B1); PG8_BAR; PG8_SCHED;
            PG8_LDA(At, 1, 1); PG8_STAGEB(PG8_SB(1, 0), b3); PG8_STAGEB(PG8_SB(1, 1), b3 + hstep); PG8_STAGEA(PG8_SA(1, 0), a3, 0, last);
            PG8_WAIT_V(8); PG8_WAIT_L(0); PG8_BAR; PG8_MMA(1, 0, At, B0); PG8_MMA(1, 1, At, B1); PG8_BAR; PG8_SCHED;
        }
        if (wr == 0) PG8_BAR;
        { Unit eu = cur; int el = lane;
          eu.pm = __builtin_amdgcn_readfirstlane(eu.pm); eu.pn = __builtin_amdgcn_readfirstlane(eu.pn); eu.e = __builtin_amdgcn_readfirstlane(eu.e);
          eu.cnt = __builtin_amdgcn_readfirstlane(eu.cnt); eu.orow0 = __builtin_amdgcn_readfirstlane(eu.orow0);
          asm volatile("" : "+s"(eu.pm), "+s"(eu.pn), "+s"(eu.e), "+s"(eu.cnt), "+s"(eu.orow0), "+v"(el));
          E(acc, eu, wr, wc, el & 15, el >> 4); }
        if (!has_next) break;
#pragma unroll
        for (int a = 0; a < 2; ++a)
#pragma unroll
            for (int b = 0; b < 2; ++b)
#pragma unroll
                for (int m = 0; m < 4; ++m)
#pragma unroll
                    for (int n = 0; n < 2; ++n) acc[a][b][m][n] = (f32x4){0.f, 0.f, 0.f, 0.f};
        cur = nxt; cB = nB; ++ui; crow0 = nrow0;
        if (wr == 1) PG8_BAR;
    }
    PG8_WAIT_V(0);
    PG8_BAR;
#undef PG8_SA
#undef PG8_SB
#undef PG8_STAGE2
#undef PG8_STAGEB
#undef PG8_STAGEA
#undef PG8_LDA
#undef PG8_LDB
#undef PG8_MMA
#undef PG8_LD16
#undef PG8_MK8
#undef PG8_WAIT_V
#undef PG8_WAIT_L
#undef PG8_BAR
#undef PG8_SCHED
#undef PG8_AOFFS
}
}

typedef f32x4 acc_t[2][2][4][2];
constexpr int SC_W = 0x79797979, SC_X = 0x7f7f7f7f, SC_H = 0x7b7b7b7b;

struct EpiProj {
    static constexpr bool PERM = true; static constexpr int scale_w = SC_W, scale_a = SC_X;
    bf16_t* P; const f32x2* r128; const f32x2* r64; float* kmsum; int pn_off;
    __device__ __forceinline__ void operator()(const acc_t& acc, const pg8::Unit& u, int wr, int wc, int fr, int fq) const {
        const int g = (u.pn + pn_off) * 4 + wc;
        const int mode = GRP[g][0], lo = GRP[g][1], ho = GRP[g][2], fb = GRP[g][3];
        if (mode == 4) return;
        const bool ksum = (lo >= C_CK && lo < C_CV);
        float cs[16];
#pragma unroll
        for (int k = 0; k < 16; ++k) cs[k] = 0.f;
#pragma unroll
        for (int ai = 0; ai < 2; ++ai)
#pragma unroll
            for (int m = 0; m < 4; ++m) {
                const int row = u.orow0 + ai * 128 + wr * 64 + m * 16 + fr;
                f32x4 l0 = acc[ai][0][m][0], l1 = acc[ai][0][m][1], h0 = acc[ai][1][m][0], h1 = acc[ai][1][m][1];
                if (mode == 1 || mode == 2) {
                    const f32x4* tb = (const f32x4*)((mode == 1 ? r128 + (size_t)row * 64 : r64 + (size_t)row * 32) + fb + 8 * fq);
                    const f32x4 t0 = tb[0], t1 = tb[1], t2 = tb[2], t3 = tb[3];
                    f32x4 nl0, nl1, nh0, nh1;
                    nl0[0] = l0[0] * t0[0] - h0[0] * t0[1]; nh0[0] = l0[0] * t0[1] + h0[0] * t0[0];
                    nl0[1] = l0[1] * t0[2] - h0[1] * t0[3]; nh0[1] = l0[1] * t0[3] + h0[1] * t0[2];
                    nl0[2] = l0[2] * t1[0] - h0[2] * t1[1]; nh0[2] = l0[2] * t1[1] + h0[2] * t1[0];
                    nl0[3] = l0[3] * t1[2] - h0[3] * t1[3]; nh0[3] = l0[3] * t1[3] + h0[3] * t1[2];
                    nl1[0] = l1[0] * t2[0] - h1[0] * t2[1]; nh1[0] = l1[0] * t2[1] + h1[0] * t2[0];
                    nl1[1] = l1[1] * t2[2] - h1[1] * t2[3]; nh1[1] = l1[1] * t2[3] + h1[1] * t2[2];
                    nl1[2] = l1[2] * t3[0] - h1[2] * t3[1]; nh1[2] = l1[2] * t3[1] + h1[2] * t3[0];
                    nl1[3] = l1[3] * t3[2] - h1[3] * t3[3]; nh1[3] = l1[3] * t3[3] + h1[3] * t3[2];
                    l0 = nl0; l1 = nl1; h0 = nh0; h1 = nh1;
                }
                if (ksum) {
#pragma unroll
                    for (int k = 0; k < 4; ++k) { cs[k] += l0[k]; cs[4 + k] += l1[k]; cs[8 + k] += h0[k]; cs[12 + k] += h1[k]; }
                }
                bf16_t* rp = P + (size_t)row * PP + lo + 8 * fq;
                u32x4 w; w.x = cvtpk(l0[0], l0[1]); w.y = cvtpk(l0[2], l0[3]); w.z = cvtpk(l1[0], l1[1]); w.w = cvtpk(l1[2], l1[3]);
                if (mode != 3) { *(u32x4*)rp = w; u32x4 v; v.x = cvtpk(h0[0], h0[1]); v.y = cvtpk(h0[2], h0[3]); v.z = cvtpk(h1[0], h1[1]); v.w = cvtpk(h1[2], h1[3]); *(u32x4*)(rp + ho) = v; }
                else if (fq < 2) *(u32x4*)rp = w;
            }
        if (ksum) {
#pragma unroll
            for (int k = 0; k < 16; ++k) { float v = cs[k]; v += __shfl_xor(v, 1); v += __shfl_xor(v, 2); v += __shfl_xor(v, 4); v += __shfl_xor(v, 8); cs[k] = v; }
            if (fr == 0) { float* dst = kmsum + (size_t)u.pm * 512 + (lo - C_CK) + 8 * fq;
#pragma unroll
                for (int k = 0; k < 8; ++k) { atomicAdd(dst + k, cs[k]); atomicAdd(dst + 64 + k, cs[8 + k]); } }
        }
    }
};

struct EpiOut {
    static constexpr bool PERM = true; static constexpr int scale_w = 0, scale_a = 0;
    const float* X; bf16_t* Y;
    __device__ __forceinline__ void operator()(const acc_t& acc, const pg8::Unit& u, int wr, int wc, int fr, int fq) const {
#pragma unroll
        for (int ai = 0; ai < 2; ++ai)
#pragma unroll
            for (int m = 0; m < 4; ++m) {
                const size_t off = (size_t)(u.orow0 + ai * 128 + wr * 64 + m * 16 + fr) * DM + u.pn * 256 + wc * 32 + 8 * fq;
#pragma unroll
                for (int bj = 0; bj < 2; ++bj) {
                    const f32x4 x0 = *(const f32x4*)(X + off + bj * 128), x1 = *(const f32x4*)(X + off + bj * 128 + 4);
                    const f32x4 a = x0 * ALPHA + acc[ai][bj][m][0], b = x1 * ALPHA + acc[ai][bj][m][1];
                    u32x4 w; w.x = cvtpk(a[0], a[1]); w.y = cvtpk(a[2], a[3]); w.z = cvtpk(b[0], b[1]); w.w = cvtpk(b[2], b[3]);
                    *(u32x4*)(Y + off + bj * 128) = w;
                }
            }
    }
};

struct EpiGU {
    static constexpr bool PERM = true; static constexpr int scale_w = SC_W, scale_a = SC_X;
    unsigned char* H;
    __device__ __forceinline__ void operator()(const acc_t& acc, const pg8::Unit& u, int wr, int wc, int fr, int fq) const {
#pragma unroll
        for (int ai = 0; ai < 2; ++ai)
#pragma unroll
            for (int m = 0; m < 4; ++m) {
                const size_t off = (size_t)(u.orow0 + ai * 128 + wr * 64 + m * 16 + fr) * DFF + u.pn * 128 + wc * 32 + 8 * fq;
                float hv[8];
#pragma unroll
                for (int n = 0; n < 2; ++n)
#pragma unroll
                    for (int j = 0; j < 4; ++j) { const float g = acc[ai][0][m][n][j], up = acc[ai][1][m][n][j]; hv[n * 4 + j] = 16.f * g * up / (1.f + __expf(-g)); }
                u32x2 w; w.x = pk4_fp8(hv[0], hv[1], hv[2], hv[3]); w.y = pk4_fp8(hv[4], hv[5], hv[6], hv[7]);
                *(u32x2*)(H + off) = w;
            }
    }
};

struct EpiDown {
    static constexpr bool PERM = true; static constexpr int scale_w = SC_W, scale_a = SC_H;
    bf16_t* Y; const float* sgate;
    __device__ __forceinline__ void operator()(const acc_t& acc, const pg8::Unit& u, int wr, int wc, int fr, int fq) const {
#pragma unroll
        for (int ai = 0; ai < 2; ++ai)
#pragma unroll
            for (int m = 0; m < 4; ++m) {
                const int r = ai * 128 + wr * 64 + m * 16 + fr, rk = u.pm * 256 + r;
                const float gt = rk < u.cnt ? sgate[u.e * 8192 + rk] : 0.f;
                const size_t off = (size_t)(u.orow0 + r) * DM + u.pn * 256 + wc * 32 + 8 * fq;
#pragma unroll
                for (int bj = 0; bj < 2; ++bj) {
                    const f32x4 a = acc[ai][bj][m][0] * gt, b = acc[ai][bj][m][1] * gt;
                    u32x4 w; w.x = cvtpk(a[0], a[1]); w.y = cvtpk(a[2], a[3]); w.z = cvtpk(b[0], b[1]); w.w = cvtpk(b[2], b[3]);
                    *(u32x4*)(Y + off + bj * 128) = w;
                }
            }
    }
};

struct MoeSched {
    const LAS int* tab; int G, c, K; const char* Bbase; size_t Bstride; const int* lists; int gather;
    __device__ bool next(int i, pg8::Unit& u) const {
#define RFL(x) __builtin_amdgcn_readfirstlane(x)
        const int L = i * G + c; if (L >= RFL(tab[32 + 16])) return false;
        int e = 0;
#pragma unroll
        for (int k = 1; k < 16; ++k) e += (L >= RFL(tab[32 + k])) ? 1 : 0;
        const int r = L - RFL(tab[32 + e]), cnt = RFL(tab[e]), mt = (cnt + 255) >> 8, nt = RFL(r / mt), mtile = r - nt * mt;
        u.pm = mtile; u.pn = nt; u.e = e; u.B = Bbase + (size_t)e * Bstride + (size_t)nt * 256 * K * 2;
        u.cnt = cnt; u.orow0 = RFL(tab[16 + e]) + mtile * 256;
        if (gather) { u.list = lists + e * 8192; u.row0 = mtile * 256; } else { u.list = nullptr; u.row0 = u.orow0; }
        return true;
#undef RFL
    }
};

struct FAState { f32x16 o[4]; float m, l; };
template <int NSTEP> struct KVRegs { u32x4 k[NSTEP]; u32x4 v[8]; };

__device__ __forceinline__ s16x4 vtr(const LAS char* p) { typedef short v4i16_t __attribute__((ext_vector_type(4)));
    return __builtin_bit_cast(s16x4, __builtin_amdgcn_ds_read_tr16_b64_v4i16((LAS v4i16_t*)p)); }

template <int NSTEP, class TF>
__device__ __forceinline__ void fa_load(KVRegs<NSTEP>& R, const bf16_t* P, const TF& tf, int t, int kcol, int vcol, int lane) {
#pragma unroll
    for (int i = 0; i < 8; ++i) { const bf16_t* rp = P + (size_t)tf.row(t, 4 * i + (lane >> 4)) * PP + (lane & 15) * 8; R.v[i] = *(const u32x4*)(rp + vcol);
        if constexpr (NSTEP == 8) R.k[i] = *(const u32x4*)(rp + kcol); }
    if constexpr (NSTEP == 4) {
#pragma unroll
        for (int i = 0; i < 4; ++i) R.k[i] = *(const u32x4*)(P + (size_t)tf.row(t, 8 * i + (lane >> 3)) * PP + kcol + (lane & 7) * 8); }
}

template <int NSTEP, bool QLDS, class TF>
__device__ __forceinline__ void fa_run(FAState& st, const bf16x8 (&q)[QLDS ? 1 : NSTEP], const LAS char* ql, const bf16_t* P, const TF& tf, int t_lo, int t_hi, LAS char* vl, float sc, int kcol, int vcol, int lane) {
    if (t_lo >= t_hi) return;
    constexpr int KP = NSTEP == 8 ? 272 : 144;
    const int hi = lane >> 5;
    const LAS char* vt = vl + (4 * hi + ((lane & 15) >> 2)) * VP + (16 * ((lane >> 4) & 1) + 4 * (lane & 3)) * 2;
    const LAS char* kt = vl + (lane & 31) * KP + hi * 16;
    KVRegs<NSTEP> R;
    fa_load<NSTEP>(R, P, tf, t_lo, kcol, vcol, lane);
    for (int t = t_lo; t < t_hi; ++t) {
        if constexpr (NSTEP == 8) {
#pragma unroll
            for (int i = 0; i < 8; ++i) *(LAS u32x4*)(vl + (4 * i + (lane >> 4)) * KP + (lane & 15) * 16) = R.k[i];
        } else {
#pragma unroll
            for (int i = 0; i < 4; ++i) *(LAS u32x4*)(vl + (8 * i + (lane >> 3)) * KP + (lane & 7) * 16) = R.k[i];
        }
        f32x16 s = {0.f, 0.f, 0.f, 0.f, 0.f, 0.f, 0.f, 0.f, 0.f, 0.f, 0.f, 0.f, 0.f, 0.f, 0.f, 0.f};
#pragma unroll
        for (int i = 0; i < NSTEP; ++i) { bf16x8 qf; if constexpr (QLDS) qf = *(const LAS bf16x8*)(ql + i * 1024 + lane * 16); else qf = q[i];
            const bf16x8 kf = *(const LAS bf16x8*)(kt + i * 32);
            s = __builtin_amdgcn_mfma_f32_32x32x16_bf16(kf, qf, s, 0, 0, 0); }
#pragma unroll
        for (int i = 0; i < 8; ++i) *(LAS u32x4*)(vl + (4 * i + (lane >> 4)) * VP + (lane & 15) * 16) = R.v[i];
        if (t + 1 < t_hi) fa_load<NSTEP>(R, P, tf, t + 1, kcol, vcol, lane);
        float tmax = NEG_INF;
#pragma unroll
        for (int r = 0; r < 16; ++r) { const float v = tf.valid(t, r, hi) ? s[r] * sc : NEG_INF; s[r] = v; tmax = fmaxf(tmax, v); }
        tmax = fmaxf(tmax, __shfl_xor(tmax, 32));
        const float mn = fmaxf(st.m, tmax), ms = (mn == NEG_INF) ? 0.f : mn;
        const float alpha = __builtin_amdgcn_exp2f(st.m - ms);
        float ps = 0.f;
#pragma unroll
        for (int r = 0; r < 16; ++r) { const float p = __builtin_amdgcn_exp2f(s[r] - ms); s[r] = p; ps += p; }
        st.l = st.l * alpha + ps; st.m = mn;
        if (!__all(alpha == 1.f)) {
#pragma unroll
            for (int d = 0; d < 4; ++d)
#pragma unroll
                for (int r = 0; r < 16; ++r) st.o[d][r] *= alpha;
        }
        u32x4 p0, p1;
        p0.x = cvtpk(s[0], s[1]); p0.y = cvtpk(s[2], s[3]); p0.z = cvtpk(s[4], s[5]); p0.w = cvtpk(s[6], s[7]);
        p1.x = cvtpk(s[8], s[9]); p1.y = cvtpk(s[10], s[11]); p1.z = cvtpk(s[12], s[13]); p1.w = cvtpk(s[14], s[15]);
        const bf16x8 pb0 = __builtin_bit_cast(bf16x8, p0), pb1 = __builtin_bit_cast(bf16x8, p1);
#pragma unroll
        for (int d = 0; d < 4; ++d) {
            const s16x4 a0 = vtr(vt + d * 64), a1 = vtr(vt + d * 64 + 8 * VP), b0 = vtr(vt + d * 64 + 16 * VP), b1 = vtr(vt + d * 64 + 24 * VP);
            const bf16x8 v0 = {a0[0], a0[1], a0[2], a0[3], a1[0], a1[1], a1[2], a1[3]}, v1 = {b0[0], b0[1], b0[2], b0[3], b1[0], b1[1], b1[2], b1[3]};
            st.o[d] = __builtin_amdgcn_mfma_f32_32x32x16_bf16(v0, pb0, st.o[d], 0, 0, 0);
            st.o[d] = __builtin_amdgcn_mfma_f32_32x32x16_bf16(v1, pb1, st.o[d], 0, 0, 0);
        }
    }
}
__device__ __forceinline__ void fa_init(FAState& st) {
#pragma unroll
    for (int d = 0; d < 4; ++d)
#pragma unroll
        for (int r = 0; r < 16; ++r) st.o[d][r] = 0.f;
    st.m = NEG_INF; st.l = 0.f;
}
__device__ __forceinline__ void fa_normalize(FAState& st) {
    const float lt = st.l + __shfl_xor(st.l, 32), inv = lt > 0.f ? 1.f / lt : 0.f;
#pragma unroll
    for (int d = 0; d < 4; ++d)
#pragma unroll
        for (int r = 0; r < 16; ++r) st.o[d][r] *= inv;
}
__device__ __forceinline__ void fa_store(const FAState& st, bf16_t* orow, int hi) {
#pragma unroll
    for (int d = 0; d < 4; ++d)
#pragma unroll
        for (int g = 0; g < 4; ++g) { u32x2 w; w.x = cvtpk(st.o[d][4 * g], st.o[d][4 * g + 1]); w.y = cvtpk(st.o[d][4 * g + 2], st.o[d][4 * g + 3]);
            *(u32x2*)(orow + 32 * d + 8 * g + 4 * hi) = w; }
}
template <int NSTEP>
__device__ __forceinline__ void fa_loadq(bf16x8 (&q)[NSTEP], const bf16_t* qrow, int hi, bool on) {
#pragma unroll
    for (int s = 0; s < NSTEP; ++s) { bf16x8 z = {0, 0, 0, 0, 0, 0, 0, 0}; q[s] = on ? *(const bf16x8*)(qrow + 16 * s + 8 * hi) : z; }
}

template <int NSTEP>
__device__ __forceinline__ void fa_loadq_lds(LAS char* ql, const bf16_t* qrow, int hi, bool on, int lane) {
#pragma unroll
    for (int s = 0; s < NSTEP; ++s) { bf16x8 z = {0, 0, 0, 0, 0, 0, 0, 0}; *(LAS bf16x8*)(ql + s * 1024 + lane * 16) = on ? *(const bf16x8*)(qrow + 16 * s + 8 * hi) : z; }
}
constexpr int QL_OFF = 8 * VT_BYTES, QL_BYTES = 8192, AUX_OFF = 147456;


constexpr int E1_STAGE = 32768, E1_NS = 3;
template <int NSTEP, class TF>
__device__ __forceinline__ void e1_run(FAState& st, const bf16x8 (&q)[NSTEP], const bf16_t* Kg, const bf16_t* Vg, const int nkt, LAS char* ring, const float sc, const int kc0, const TF& tf, const int lane, const int wid) {
    const int hi = lane >> 5, r32 = lane & 31;
    unsigned doff[2];
#pragma unroll
    for (int i = 0; i < 2; ++i) { const int row = 8 * wid + 4 * i + (lane >> 4), sw = ((row & 3) << 2) | ((row >> 2) & 3); doff[i] = (unsigned)(row * PP + 8 * ((lane & 15) ^ sw)) * 2u; }
    const unsigned ldsw = (unsigned)wid * 2048u;
#define E1_DMAK(kt_, stg_) do { const char* kb_ = (const char*)(Kg + (size_t)(kt_) * 64 * PP); LAS char* sb_ = ring + (stg_) * E1_STAGE + ldsw; \
        __builtin_amdgcn_global_load_lds((const unsigned*)(kb_ + doff[0]), (LAS unsigned*)(sb_), 16, 0, 0); __builtin_amdgcn_global_load_lds((const unsigned*)(kb_ + doff[1]), (LAS unsigned*)(sb_ + 1024), 16, 0, 0); } while (0)
#define E1_DMAV(kt_, stg_) do { const char* vb_ = (const char*)(Vg + (size_t)(kt_) * 64 * PP); LAS char* sb_ = ring + (stg_) * E1_STAGE + ldsw; \
        __builtin_amdgcn_global_load_lds((const unsigned*)(vb_ + doff[0]), (LAS unsigned*)(sb_ + 16384), 16, 0, 0); __builtin_amdgcn_global_load_lds((const unsigned*)(vb_ + doff[1]), (LAS unsigned*)(sb_ + 16384 + 1024), 16, 0, 0); } while (0)
    const int swk = ((r32 & 3) << 2) | ((r32 >> 2) & 3);
    const int koff0 = 256 * r32 + 16 * ((kc0 + hi) ^ swk);
    int voff0[2];
    { const int qq = (lane & 15) >> 2, p = lane & 3, cl = 2 * ((lane >> 4) & 1) + (p >> 1);
#pragma unroll
      for (int rd = 0; rd < 2; ++rd) voff0[rd] = 16384 + 256 * (8 * rd + 4 * hi + qq) + 16 * (4 * qq + (cl ^ ((2 * rd + hi) & 3))) + 8 * (p & 1); }
    if (nkt <= 0) return;
    E1_DMAK(0, 0);
    if (nkt > 1) E1_DMAK(1, 1);
    E1_DMAV(0, 0);
    const f32x16 zero16 = {0.f, 0.f, 0.f, 0.f, 0.f, 0.f, 0.f, 0.f, 0.f, 0.f, 0.f, 0.f, 0.f, 0.f, 0.f, 0.f};
    const bf16x8 zb = {0, 0, 0, 0, 0, 0, 0, 0};
    bf16x8 pb0 = zb, pb1 = zb, pb2 = zb, pb3 = zb;
    int pend = 0, stg = 0, stp = 2;
#pragma clang loop unroll(disable)
    for (int kt = 0; kt <= nkt; ++kt) {
        if (kt + 1 < nkt) asm volatile("s_waitcnt vmcnt(4)" ::: "memory"); else if (kt < nkt) asm volatile("s_waitcnt vmcnt(2)" ::: "memory"); else asm volatile("s_waitcnt vmcnt(0)" ::: "memory");
        __builtin_amdgcn_s_barrier();
        const int sn = stg + 1 >= E1_NS ? 0 : stg + 1;
        if (kt + 2 < nkt) E1_DMAK(kt + 2, stp);
        if (kt + 1 < nkt) E1_DMAV(kt + 1, sn);
        const LAS char* sb = ring + stg * E1_STAGE;
        const bool in = kt < nkt, act0 = in && tf.active(kt, 0), act1 = in && tf.active(kt, 1);
        int act = __builtin_amdgcn_readfirstlane((act0 || act1) ? 1 : 0); asm volatile("" : "+s"(act));
        f32x16 c0 = zero16, c1 = zero16;
        float tmax = NEG_INF, ms = 0.f, alpha = 1.f, ps = 0.f;
        bool mk0 = false, mk1 = false;
        auto mw = tf.fetch(in ? kt : 0);
        if (act) {
            mk0 = tf.masked(kt, 0); mk1 = tf.masked(kt, 1) || !act1;
            int kof = koff0; asm volatile("" : "+v"(kof));
#pragma unroll
            for (int i = 0; i < NSTEP; ++i) { const bf16x8 kf0 = *(const LAS bf16x8*)(sb + (kof ^ (32 * i))), kf1 = *(const LAS bf16x8*)(sb + 8192 + (kof ^ (32 * i)));
                c0 = __builtin_amdgcn_mfma_f32_32x32x16_bf16(kf0, q[i], c0, 0, 0, 0); c1 = __builtin_amdgcn_mfma_f32_32x32x16_bf16(kf1, q[i], c1, 0, 0, 0); }
        }
        const unsigned vb0 = (unsigned)(uintptr_t)(ring + stp * E1_STAGE) + (unsigned)voff0[0], vb1 = (unsigned)(uintptr_t)(ring + stp * E1_STAGE) + (unsigned)voff0[1];
        s16x4 ta[16], tb[16];
#define E1_TRP(j_, off_) do { const unsigned ad0 = vb0 ^ (64u * ((j_) >> 2)), ad1 = vb1 ^ (64u * ((j_) >> 2)); \
            asm volatile("ds_read_b64_tr_b16 %0, %1 offset:" #off_ : "=&v"(ta[j_]) : "v"(ad0) : "memory"); asm volatile("ds_read_b64_tr_b16 %0, %1 offset:" #off_ : "=&v"(tb[j_]) : "v"(ad1) : "memory"); } while (0)
#define E1_PVM(j_, pb_, w_) do { asm volatile("s_waitcnt lgkmcnt(" #w_ ")" ::: "memory"); __builtin_amdgcn_sched_barrier(0); \
            st.o[(j_) >> 2] = __builtin_amdgcn_mfma_f32_32x32x16_bf16((bf16x8){ta[j_][0], ta[j_][1], ta[j_][2], ta[j_][3], tb[j_][0], tb[j_][1], tb[j_][2], tb[j_][3]}, pb_, st.o[(j_) >> 2], 0, 0, 0); \
            __builtin_amdgcn_sched_barrier(0); } while (0)
#define E1_MAX0 do { if (mk0) { _Pragma("unroll") for (int r = 0; r < 16; ++r) { const float v = (act0 && tf.valid(kt, 0, r, hi, mw)) ? c0[r] : NEG_INF; c0[r] = v; tmax = fmaxf(tmax, v); } } \
            else { _Pragma("unroll") for (int r = 0; r < 16; ++r) { const float v = act0 ? c0[r] : NEG_INF; c0[r] = v; tmax = fmaxf(tmax, v); } } __builtin_amdgcn_sched_barrier(0); } while (0)
#define E1_MAX1 do { if (mk1) { _Pragma("unroll") for (int r = 0; r < 16; ++r) { const float v = (act1 && tf.valid(kt, 1, r, hi, mw)) ? c1[r] : NEG_INF; c1[r] = v; tmax = fmaxf(tmax, v); } } \
            else { _Pragma("unroll") for (int r = 0; r < 16; ++r) tmax = fmaxf(tmax, c1[r]); } __builtin_amdgcn_sched_barrier(0); } while (0)
#define E1_RED do { const swap2 rr = pl32swap(tmax, tmax); tmax = fmaxf(rr.a, rr.b) * sc; const float mn = fmaxf(st.m, tmax); ms = (mn == NEG_INF) ? 0.f : mn; \
            alpha = __builtin_amdgcn_exp2f(st.m - ms); st.m = mn; __builtin_amdgcn_sched_barrier(0); } while (0)
#define E1_EXP(c_, lo_) do { _Pragma("unroll") for (int r = (lo_); r < (lo_) + 8; ++r) { const float p = __builtin_amdgcn_exp2f(__builtin_fmaf(c_[r], sc, -ms)); c_[r] = p; ps += p; } __builtin_amdgcn_sched_barrier(0); } while (0)
        __builtin_amdgcn_sched_barrier(0);
        if (pend) { asm volatile("s_waitcnt lgkmcnt(0)" ::: "memory"); __builtin_amdgcn_sched_barrier(0); E1_TRP(0, 0); E1_TRP(1, 4096); E1_TRP(2, 8192); E1_TRP(3, 12288);
                    E1_PVM(0, pb0, 6); E1_TRP(4, 0); E1_PVM(1, pb1, 6); E1_TRP(5, 4096); }
        if (act) E1_MAX0;
        if (pend) { E1_PVM(2, pb2, 6); E1_TRP(6, 8192); E1_PVM(3, pb3, 6); E1_TRP(7, 12288); }
        if (act) E1_MAX1;
        if (pend) { E1_PVM(4, pb0, 6); E1_TRP(8, 0); E1_PVM(5, pb1, 6); E1_TRP(9, 4096); }
        if (act) E1_RED;
        if (pend) { E1_PVM(6, pb2, 6); E1_TRP(10, 8192); E1_PVM(7, pb3, 6); E1_TRP(11, 12288); }
        if (act) E1_EXP(c0, 0);
        if (pend) { E1_PVM(8, pb0, 6); E1_TRP(12, 0); E1_PVM(9, pb1, 6); E1_TRP(13, 4096); }
        if (act) E1_EXP(c0, 8);
        if (pend) { E1_PVM(10, pb2, 6); E1_TRP(14, 8192); E1_PVM(11, pb3, 6); E1_TRP(15, 12288); }
        if (act) E1_EXP(c1, 0);
        if (pend) { E1_PVM(12, pb0, 6); E1_PVM(13, pb1, 4); }
        if (act) E1_EXP(c1, 8);
        if (pend) { E1_PVM(14, pb2, 2); E1_PVM(15, pb3, 0); }
#undef E1_TRP
#undef E1_PVM
#undef E1_MAX0
#undef E1_MAX1
#undef E1_RED
#undef E1_EXP
        if (act) {
            st.l = st.l * alpha + ps;
            if (!__all(alpha == 1.f)) {
#pragma unroll
                for (int d = 0; d < 4; ++d)
#pragma unroll
                    for (int r = 0; r < 16; ++r) st.o[d][r] *= alpha;
            }
            u32x4 w0, w1, w2, w3;
            w0.x = cvtpk(c0[0], c0[1]); w0.y = cvtpk(c0[2], c0[3]); w0.z = cvtpk(c0[4], c0[5]); w0.w = cvtpk(c0[6], c0[7]);
            w1.x = cvtpk(c0[8], c0[9]); w1.y = cvtpk(c0[10], c0[11]); w1.z = cvtpk(c0[12], c0[13]); w1.w = cvtpk(c0[14], c0[15]);
            w2.x = cvtpk(c1[0], c1[1]); w2.y = cvtpk(c1[2], c1[3]); w2.z = cvtpk(c1[4], c1[5]); w2.w = cvtpk(c1[6], c1[7]);
            w3.x = cvtpk(c1[8], c1[9]); w3.y = cvtpk(c1[10], c1[11]); w3.z = cvtpk(c1[12], c1[13]); w3.w = cvtpk(c1[14], c1[15]);
            pb0 = __builtin_bit_cast(bf16x8, w0); pb1 = __builtin_bit_cast(bf16x8, w1); pb2 = __builtin_bit_cast(bf16x8, w2); pb3 = __builtin_bit_cast(bf16x8, w3);
        }
        asm volatile("s_waitcnt lgkmcnt(0)" ::: "memory");
        pend = act; stp = stg; stg = sn;
    }
#undef E1_DMAK
#undef E1_DMAV
}

struct Args {
    const float* x; const int* pos; const float* w_in; const float* w_out; const float* dlam; const float* dng; const float* lmg; const float* lmb;
    const float* rw; const float* rb; const float* wg; const float* wu; const float* wd; const float* lfg; const float* lfb;
    float* out; unsigned char* ws; int ph_lo, ph_hi;
};

struct TFDiffE1 { int q0, qpos;
    __device__ __forceinline__ bool active(int kt, int sub) const { return 64 * kt + 32 * sub <= q0; }
    __device__ __forceinline__ bool masked(int kt, int sub) const { return 64 * kt + 32 * sub == q0; }
    __device__ __forceinline__ int fetch(int) const { return 0; }
    __device__ __forceinline__ bool valid(int kt, int sub, int r, int hi, int) const { return 64 * kt + 32 * sub + crow(r, hi) <= qpos; } };

__device__ __forceinline__ void diff_unit(const Args& A, int layer, int b, int hh, int qb, LAS char* lds, const int wv) {
    int tid_ = wv * 64 + lane_id(); asm volatile("" : "+v"(tid_));
    const int tid = tid_, lane = tid & 63, wid = __builtin_amdgcn_readfirstlane(tid >> 6), sub = wid & 3, map = wid >> 2, hi = lane >> 5;
    const bf16_t* P = (const bf16_t*)(A.ws + WS_PROJ); bf16_t* MIX = (bf16_t*)(A.ws + WS_MIX);
    const int q0 = qb * 128 + sub * 32, qpos = q0 + (lane & 31), tok = b * SEQ + qpos;
    bf16x8 q[4]; fa_loadq<4>(q, P + (size_t)tok * PP + C_BQ + hh * 128 + map * 64, hi, true);
    FAState st; fa_init(st);
    TFDiffE1 tf{q0, qpos};
    e1_run<4>(st, q, P + (size_t)(b * SEQ) * PP + C_BK + hh * 128, P + (size_t)(b * SEQ) * PP + C_BV + hh * 128, 2 * qb + 2, lds, 0.125f * LOG2E, 8 * map, tf, lane, wid);
    __syncthreads();
    fa_normalize(st);
    LAS float* xch = (LAS float*)lds + sub * 4096;
    if (map == 1) {
#pragma unroll
        for (int d = 0; d < 4; ++d)
#pragma unroll
            for (int r = 0; r < 16; ++r) xch[(d * 16 + r) * 64 + lane] = st.o[d][r];
    }
    __syncthreads();
    if (map == 0) {
        int ly_ = layer; asm volatile("" : "+s"(ly_)); const int layer = ly_;
        const float* dl = A.dlam + layer * 256;
        const float s1 = wave_sum(dl[lane] * dl[64 + lane]), s2 = wave_sum(dl[128 + lane] * dl[192 + lane]);
        float c08 = 0.8f; asm volatile("" : "+v"(c08));
        const float lam_init = c08 - 0.6f * expf(-0.3f * (float)layer);
        const float lam = expf(s1) - expf(s2) + lam_init;
        float ss = 0.f;
#pragma unroll
        for (int d = 0; d < 4; ++d)
#pragma unroll
            for (int r = 0; r < 16; ++r) { const float o = st.o[d][r] - lam * xch[(d * 16 + r) * 64 + lane]; st.o[d][r] = o; ss += o * o; }
        ss += __shfl_xor(ss, 32);
        const float rinv = rsqrtf(ss * (1.f / 128.f) + LN_EPS) * (1.f - lam_init);
        const float* g = A.dng + layer * 128;
#pragma unroll
        for (int d = 0; d < 4; ++d)
#pragma unroll
            for (int r = 0; r < 16; ++r) st.o[d][r] *= rinv * g[32 * d + crow(r, hi)];
        fa_store(st, MIX + (size_t)tok * DM + 512 + hh * 128, hi);
    }
}

struct TFMobaE1 { int j, q0, qpos; unsigned selmask, wavemask;
    __device__ __forceinline__ bool active(int kt, int sub) const { const int n = kt >> 2; return n < j ? ((wavemask >> n) & 1u) != 0u : (64 * kt + 32 * sub <= q0); }
    __device__ __forceinline__ bool masked(int kt, int sub) const { const int n = kt >> 2; return n < j ? true : (64 * kt + 32 * sub == q0); }
    __device__ __forceinline__ int fetch(int) const { return 0; }
    __device__ __forceinline__ bool valid(int kt, int sub, int r, int hi, int) const { const int n = kt >> 2; return n < j ? ((selmask >> n) & 1u) != 0u : (64 * kt + 32 * sub + crow(r, hi) <= qpos); } };

__device__ __forceinline__ void moba_unit(const Args& A, int layer, int b, int hh, int j, LAS char* lds, const int wv) {
    int tid_ = wv * 64 + lane_id(); asm volatile("" : "+v"(tid_));
    const int tid = tid_, lane = tid & 63, wid = __builtin_amdgcn_readfirstlane(tid >> 6), hi = lane >> 5;
    const bf16_t* P = (const bf16_t*)(A.ws + WS_PROJ); bf16_t* MIX = (bf16_t*)(A.ws + WS_MIX);
    LAS float* km = (LAS float*)(lds + AUX_OFF);
    { const float* kms = (const float*)(A.ws + WS_CTL + KM_OFF) + (size_t)((layer * NB + b) * 16) * 512 + hh * 128;
      for (int i = tid; i < j * 128; i += 512) km[i] = kms[(size_t)(i >> 7) * 512 + (i & 127)] * (1.f / 256.f); }
    __syncthreads();
    const int q0 = j * 256 + wid * 32, qpos = q0 + (lane & 31), tok = b * SEQ + qpos;
    const bf16_t* qrow = P + (size_t)tok * PP + C_CQ + hh * 128;
    float gate[16];
#pragma unroll
    for (int n = 0; n < 16; ++n) gate[n] = 0.f;
#pragma unroll 1
    for (int c = 0; c < 16; ++c) {
        const u32x4 qw = *(const u32x4*)(qrow + 8 * c);
        const float qf[8] = {bflo(qw.x), bfhi(qw.x), bflo(qw.y), bfhi(qw.y), bflo(qw.z), bfhi(qw.z), bflo(qw.w), bfhi(qw.w)};
#pragma unroll
        for (int n = 0; n < 16; ++n) {
            const f32x4 k0 = *(const LAS f32x4*)(km + n * 128 + 8 * c), k1 = *(const LAS f32x4*)(km + n * 128 + 8 * c + 4);
            gate[n] += qf[0] * k0[0] + qf[1] * k0[1] + qf[2] * k0[2] + qf[3] * k0[3] + qf[4] * k1[0] + qf[5] * k1[1] + qf[6] * k1[2] + qf[7] * k1[3];
        }
    }
    unsigned selmask = 0u;
#pragma unroll
    for (int pick = 0; pick < 3; ++pick) {
        float best = NEG_INF; int bi = -1;
#pragma unroll
        for (int n = 0; n < 16; ++n) { const bool ok = (n < j) && !((selmask >> n) & 1u) && (gate[n] > best || bi < 0); if (ok) { best = gate[n]; bi = n; } }
        if (bi >= 0) selmask |= 1u << bi;
    }
    unsigned wavemask = 0u;
#pragma unroll
    for (int n = 0; n < 16; ++n) wavemask |= (__any((selmask >> n) & 1u) ? 1u : 0u) << n;
    bf16x8 q[8]; fa_loadq<8>(q, qrow, hi, true);
    FAState st; fa_init(st);
    TFMobaE1 tf{j, q0, qpos, selmask, wavemask};
    e1_run<8>(st, q, P + (size_t)(b * SEQ) * PP + C_CK + hh * 128, P + (size_t)(b * SEQ) * PP + C_CV + hh * 128, 4 * j + 4, lds, 0.08838834764831845f * LOG2E, 0, tf, lane, wid);
    fa_normalize(st);
    int tok2 = b * SEQ + j * 256 + wid * 32 + (lane_id() & 31); asm volatile("" : "+v"(tok2));
    fa_store(st, MIX + (size_t)tok2 * DM + 1024 + hh * 128, hi);
}

struct TFDil { int rowbase, base, stride, add, uq, want, q4;
    __device__ __forceinline__ int row(int t, int key) const { int u = base + 32 * t + key; u = u < 0 ? 0 : u; int s = stride * u + add; s = s > SEQ - 1 ? SEQ - 1 : s; return rowbase + s; }
    __device__ __forceinline__ bool valid(int t, int r, int hi) const { const int u = base + 32 * t + crow(r, hi), d = uq - u; return u >= 0 && d >= 0 && d <= 128 && (want < 0 || q4 == want); } };

__device__ __forceinline__ void dil_unit(const Args& A, int b, int hh, int blk, LAS char* lds, const int wv) {
    int tid_ = wv * 64 + lane_id(); asm volatile("" : "+v"(tid_));
    const int tid = tid_, lane = tid & 63, wid = __builtin_amdgcn_readfirstlane(tid >> 6), hi = lane >> 5;
    const bf16_t* P = (const bf16_t*)(A.ws + WS_PROJ); bf16_t* MIX = (bf16_t*)(A.ws + WS_MIX);
    const int t0 = blk * 256 + (wid >> 2) * 128, r4 = wid & 3, c = lane & 31, i = c & 7, q4 = c >> 3;
    const int tq = t0 + 16 * i + 4 * q4 + r4, tok = b * SEQ + tq;
    bf16x8 q[8]; fa_loadq<8>(q, P + (size_t)tok * PP + C_DQ + hh * 128, hi, true); const LAS char* ql = nullptr;
    FAState st; fa_init(st);
    const float sc = 0.08838834764831845f * LOG2E;
    LAS char* vl = lds + wid * VT_BYTES;
    const int kc = C_DK + hh * 128, vc = C_DV + hh * 128;
    { TFDil tf{b * SEQ, t0 - 128, 1, 0, tq, -1, q4}; fa_run<8, false>(st, q, ql, P, tf, t0 >= 128 ? 0 : 4, 8, vl, sc, kc, vc, lane); }
    { const int u0 = t0 >> 2; int ts = (128 - u0 + 31) >> 5; ts = ts < 0 ? 0 : ts;
      TFDil tf{b * SEQ, u0 - 128, 4, r4, u0 + 4 * i + q4, -1, q4}; fa_run<8, false>(st, q, ql, P, tf, ts, 5, vl, sc, kc, vc, lane); }
    { const int u0 = t0 >> 4; int ts = (128 - u0 + 31) >> 5; ts = ts < 0 ? 0 : ts;
      for (int w4 = 0; w4 < 4; ++w4) { TFDil tf{b * SEQ, u0 - 128, 16, r4 + 4 * w4, u0 + i, w4, q4}; fa_run<8, false>(st, q, ql, P, tf, ts, 5, vl, sc, kc, vc, lane); } }
    fa_normalize(st);
    fa_store(st, MIX + (size_t)tok * DM + 1536 + hh * 128, hi);
}

struct TFDsaE1 { const LAS char* mb;
    __device__ __forceinline__ bool active(int, int) const { return true; }
    __device__ __forceinline__ bool masked(int, int) const { return true; }
    __device__ __forceinline__ unsigned fetch(int kt) const { return *(const LAS unsigned*)(mb + 512 * kt); }
    __device__ __forceinline__ bool valid(int, int sub, int r, int, unsigned mw) const { return ((mw >> (8 * (r & 3) + 4 * sub + (r >> 2))) & 1u) != 0u; } };

__device__ __forceinline__ unsigned ord16(unsigned h) { return (h & 0x8000u) ? (~h & 0xffffu) : (h | 0x8000u); }

__device__ __forceinline__ void dsa_unit(const Args& A, int layer, int b, int t0, LAS char* lds, const int wv, const int level) {
    int tid_ = wv * 64 + lane_id(); asm volatile("" : "+v"(tid_));
    const int tid = tid_, lane = tid & 63, wid = __builtin_amdgcn_readfirstlane(tid >> 6), hi = lane >> 5;
    const bf16_t* P = (const bf16_t*)(A.ws + WS_PROJ); bf16_t* MIX = (bf16_t*)(A.ws + WS_MIX);
    LAS unsigned short* sco = (LAS unsigned short*)lds;
    LAS char* kst = lds + 131072;
    unsigned* dsac = (unsigned*)(A.ws + WS_CTL) + CW_DSAC + 128 * layer + 64 * b + (t0 >> 6);
    const int nkeys = t0 + 16, nchunk = (nkeys + 127) >> 7;
    {
        const int r = lane & 31;
        const int tokq = b * SEQ + t0 + 2 * wid + (r >> 4);
        bf16x8 aq[4];
#pragma unroll
        for (int s = 0; s < 4; ++s) aq[s] = *(const bf16x8*)(P + (size_t)tokq * PP + C_IQ + (r & 15) * 64 + 16 * s + 8 * hi);
        float wgt[16];
#pragma unroll
        for (int rr = 0; rr < 16; ++rr) { const int head = (rr & 3) + 8 * ((rr >> 2) & 1) + 4 * hi;
            wgt[rr] = bf2f(P[(size_t)(b * SEQ + t0 + 2 * wid + (rr >> 3)) * PP + C_IW + head]) * 0.03125f; }
        const int tlim = (t0 + 2 * wid + 1) >> 5;
        const int k0_ = tid >> 3, c0_ = tid & 7;
        const bf16_t* src = P + (size_t)(b * SEQ) * PP + C_IK + c0_ * 8;
        u32x4 pa0, pa1, pb0, pb1;
#define DSA_STAGE_LOAD(d0_, d1_, ch_) do { int ka_ = 128 * (ch_) + k0_, kb_ = ka_ + 64; ka_ = ka_ > SEQ - 1 ? SEQ - 1 : ka_; kb_ = kb_ > SEQ - 1 ? SEQ - 1 : kb_; \
            d0_ = *(const u32x4*)(src + (size_t)ka_ * PP); d1_ = *(const u32x4*)(src + (size_t)kb_ * PP); } while (0)
#define DSA_CHUNK(s0_, s1_, ch_) do { \
            __syncthreads(); \
            *(LAS u32x4*)(kst + k0_ * 128 + ((c0_ ^ ((k0_ >> 1) & 7)) << 4)) = s0_; \
            *(LAS u32x4*)(kst + (k0_ + 64) * 128 + ((c0_ ^ (((k0_ + 64) >> 1) & 7)) << 4)) = s1_; \
            __syncthreads(); \
            if ((ch_) + 2 < nchunk) DSA_STAGE_LOAD(s0_, s1_, (ch_) + 2); \
            _Pragma("unroll") for (int tt = 0; tt < 4; ++tt) { \
                const int kt = 4 * (ch_) + tt; \
                if (kt <= tlim) { \
                    const int kr = 32 * tt + r; \
                    f32x16 cacc = {0.f, 0.f, 0.f, 0.f, 0.f, 0.f, 0.f, 0.f, 0.f, 0.f, 0.f, 0.f, 0.f, 0.f, 0.f, 0.f}; \
                    _Pragma("unroll") for (int s = 0; s < 4; ++s) { const bf16x8 kb = *(const LAS bf16x8*)(kst + kr * 128 + (((2 * s + hi) ^ ((kr >> 1) & 7)) << 4)); \
                        cacc = __builtin_amdgcn_mfma_f32_32x32x16_bf16(aq[s], kb, cacc, 0, 0, 0); } \
                    float p0 = 0.f, p1 = 0.f; \
                    _Pragma("unroll") for (int rr = 0; rr < 8; ++rr) { p0 += wgt[rr] * fmaxf(cacc[rr], 0.f); p1 += wgt[8 + rr] * fmaxf(cacc[8 + rr], 0.f); } \
                    const swap2 sw = pl32swap(p0, p1); const float tot = sw.a + sw.b; \
                    const _Float16 hsc = (_Float16)tot; \
                    sco[(2 * wid + hi) * 4096 + 32 * kt + r] = __builtin_bit_cast(unsigned short, hsc); \
                } } } while (0)
        DSA_STAGE_LOAD(pa0, pa1, 0);
        if (nchunk > 1) DSA_STAGE_LOAD(pb0, pb1, 1);
        for (int ch = 0; ch < nchunk; ch += 2) {
            DSA_CHUNK(pa0, pa1, ch);
            if (ch + 1 < nchunk) DSA_CHUNK(pb0, pb1, ch + 1);
        }
#undef DSA_CHUNK
#undef DSA_STAGE_LOAD
    }
    __syncthreads();
    if (level < 2) return;
#pragma unroll 1
    for (int qq = 0; qq < 2; ++qq) {
        const int qi = 2 * wid + qq, tq = t0 + qi, nv = tq + 1;
        unsigned long long* bmq = (unsigned long long*)(A.ws + WS_BM) + (size_t)(b * SEQ + tq) * 64;
        if (nv <= 256) { const int cntl = tq >= lane ? ((tq - lane) >> 3) + 1 : 0;
            if (lane < 8) __hip_atomic_store(bmq + lane, (1ull << cntl) - 1ull, RLX_AGENT);
            continue; }
        const int nch = (nv + 511) >> 9;
        typedef unsigned short u16x2 __attribute__((ext_vector_type(2)));
        unsigned v[32];
#pragma unroll
        for (int i = 0; i < 8; ++i) {
            if (i < nch) { const u32x4 f = *(const LAS u32x4*)(sco + qi * 4096 + i * 512 + 8 * lane);
                const unsigned w[4] = {f.x, f.y, f.z, f.w};
#pragma unroll
                for (int d = 0; d < 4; ++d) { const int k0 = i * 512 + 8 * lane + 2 * d;
                    const unsigned neg = (w[d] >> 15) & 0x00010001u, ordw = w[d] ^ ((neg * 0xffffu) | 0x80008000u);
                    const unsigned vm = (k0 <= tq ? 0x0000ffffu : 0u) | (k0 + 1 <= tq ? 0xffff0000u : 0u);
                    v[i * 4 + d] = ordw & vm; } }
            else {
#pragma unroll
                for (int d = 0; d < 4; ++d) v[i * 4 + d] = 0u; }
        }
        const unsigned one2u = 0x00010001u;
        unsigned x = 0u;
        for (int bit = 15; bit >= 0; --bit) {
            const unsigned cand = x | (1u << bit), cm1 = (cand - 1u) * 0x00010001u;
            unsigned c2u = 0u;
#pragma unroll
            for (int i = 0; i < 8; ++i) if (i < nch) {
#pragma unroll
                for (int d = 0; d < 4; ++d) { unsigned t_; asm("v_pk_sub_u16 %0, %1, %2 clamp" : "=v"(t_) : "v"(v[i * 4 + d]), "v"(cm1)); asm("v_pk_min_u16 %0, %1, %2" : "=v"(t_) : "v"(t_), "v"(one2u)); asm("v_pk_add_u16 %0, %1, %2" : "=v"(c2u) : "v"(c2u), "v"(t_)); } }
            const int cl = (int)(c2u & 0xffffu) + (int)(c2u >> 16);
            int cnt = 0;
#pragma unroll
            for (int bb = 0; bb < 7; ++bb) cnt += __popcll(__ballot((cl >> bb) & 1)) << bb;
            if (cnt >= 256) x = cand;
            if (cnt == 256) break;
        }
        int gtot = 0;
        { const unsigned xs = x * 0x00010001u; unsigned c2u = 0u;
#pragma unroll
          for (int i = 0; i < 8; ++i) if (i < nch) {
#pragma unroll
              for (int d = 0; d < 4; ++d) { unsigned t_; asm("v_pk_sub_u16 %0, %1, %2 clamp" : "=v"(t_) : "v"(v[i * 4 + d]), "v"(xs)); asm("v_pk_min_u16 %0, %1, %2" : "=v"(t_) : "v"(t_), "v"(one2u)); asm("v_pk_add_u16 %0, %1, %2" : "=v"(c2u) : "v"(c2u), "v"(t_)); } }
          const int cg = (int)(c2u & 0xffffu) + (int)(c2u >> 16);
#pragma unroll
          for (int bb = 0; bb < 7; ++bb) gtot += __popcll(__ballot((cg >> bb) & 1)) << bb; }
        int be = gtot;
        unsigned long long myw = 0ull;
#pragma unroll
        for (int i = 0; i < 8; ++i) if (i < nch) {
#pragma unroll
            for (int e = 0; e < 8; ++e) {
                const unsigned vv = (e & 1) ? (v[i * 4 + (e >> 1)] >> 16) : (v[i * 4 + (e >> 1)] & 0xffffu);
                const bool g = vv > x, eq = vv == x;
                const unsigned long long mg = __ballot(g), me = __ballot(eq);
                const int pe = be + (int)__builtin_amdgcn_mbcnt_hi((unsigned)(me >> 32), __builtin_amdgcn_mbcnt_lo((unsigned)me, 0u));
                const unsigned long long wj = mg | __ballot(eq && pe < 256);
                if (lane == 8 * i + e) myw = wj;
                be += __popcll(me);
            }
        }
        if (lane < 8 * nch) __hip_atomic_store(bmq + lane, myw, RLX_AGENT);
    }
    asm volatile("s_waitcnt vmcnt(0)" ::: "memory");
    __syncthreads();
    if (tid == 0) __hip_atomic_fetch_add(dsac, 1u, RLX_AGENT);
}

__device__ __forceinline__ void dsa_att_unit(const Args& A, int layer, int b, int g, LAS char* lds, const int wv) {
    int tid_ = wv * 64 + lane_id(); asm volatile("" : "+v"(tid_));
    const int tid = tid_, lane = tid & 63, wid = __builtin_amdgcn_readfirstlane(tid >> 6), hi = lane >> 5;
    const bf16_t* P = (const bf16_t*)(A.ws + WS_PROJ); bf16_t* MIX = (bf16_t*)(A.ws + WS_MIX);
    unsigned* ctl = (unsigned*)(A.ws + WS_CTL);
    if (tid == 0) {
        unsigned sp = 0u;
        while (__hip_atomic_load(ctl + CW_DSAC + 128 * layer + 64 * b + g, RLX_AGENT) < 4u) { __builtin_amdgcn_s_sleep(2);
            if ((++sp & 255u) == 0u) { if (__hip_atomic_load(ctl + CW_BAR + XB_TMO, RLX_AGENT)) break; if (sp > XB_SPIN_CAP) { atomicAdd(ctl + CW_BAR + XB_TMO, 1u); break; } } }
    }
    __syncthreads();
    __builtin_amdgcn_fence(__ATOMIC_ACQUIRE, "agent");
    LAS char* bml = lds + E1_NS * E1_STAGE;
    { const int qi = tid >> 3, e = tid & 7; const unsigned long long* src = (const unsigned long long*)(A.ws + WS_BM) + (size_t)(b * SEQ + 64 * g + qi) * 64 + e;
      for (int i = 0; 8 * i <= g; ++i) { const unsigned long long w = src[8 * i];
#pragma unroll
          for (int j = 0; j < 8; ++j) *(LAS unsigned char*)(bml + 512 * (8 * i + j) + 8 * qi + e) = (unsigned char)(w >> (8 * j)); } }
    const int c = lane & 31, qi = 8 * wid + (c >> 2), tok = b * SEQ + 64 * g + qi;
    bf16x8 q[8]; fa_loadq<8>(q, P + (size_t)tok * PP + C_AQ + (c & 3) * 128, hi, true);
    FAState st; fa_init(st);
    TFDsaE1 tf{bml + 8 * qi + 4 * hi};
    __syncthreads();
    e1_run<8>(st, q, P + (size_t)(b * SEQ) * PP + C_AK, P + (size_t)(b * SEQ) * PP + C_AV, g + 1, lds, 0.08838834764831845f * LOG2E, 0, tf, lane, wid);
    fa_normalize(st);
    fa_store(st, MIX + (size_t)tok * DM + (c & 3) * 128, hi);
}

#define XB_XCNT(j)  (256  + 64 * (j))
#define XB_XSUB(j)  (1280 + 64 * (j))
#define XB_XGEN(j)  (2304 + 64 * (j))
#define XB_TOP      3328
#define XB_TOPGEN   3392
__device__ __forceinline__ unsigned xb_ld(unsigned* p)              { return __hip_atomic_load(p, __ATOMIC_RELAXED, __HIP_MEMORY_SCOPE_AGENT); }
__device__ __forceinline__ unsigned xb_add(unsigned* p, unsigned v) { return __hip_atomic_fetch_add(p, v, __ATOMIC_RELAXED, __HIP_MEMORY_SCOPE_AGENT); }
__device__ __forceinline__ unsigned xb_xcc_id() { return (unsigned)__builtin_amdgcn_s_getreg((3 << 11) | 20) & 0xFu; }
#define XB_SPIN(cond, bar) do { unsigned _sp = 0; while (cond) { __builtin_amdgcn_s_sleep(1); \
    if ((++_sp & 255u) == 0u) { if (xb_ld(&(bar)[XB_TMO])) break; if (_sp > XB_SPIN_CAP) { atomicAdd(&(bar)[XB_TMO], 1u); break; } } } } while (0)
struct XcdBarrier { unsigned* bar; unsigned x; volatile LAS unsigned* st; };
__device__ __forceinline__ XcdBarrier xcd_barrier_post(unsigned* bar, volatile LAS unsigned* st, bool leader) {
    XcdBarrier b; b.bar = bar; b.x = xb_xcc_id(); b.st = st;
    if (leader) (void)xb_add(&bar[XB_XCNT(b.x)], 1u);
    return b;
}
__device__ __forceinline__ void xcd_barrier_complete(unsigned* bar, unsigned x, unsigned& nloc, unsigned& nx) {
    const unsigned G = gridDim.x * gridDim.y * gridDim.z;
    unsigned sum, cnt, mine, sp = 0u;
    for (;;) {
        sum = 0u; cnt = 0u; mine = 0u;
#pragma unroll
        for (unsigned j = 0; j < 16; ++j) { const unsigned c = xb_ld(&bar[XB_XCNT(j)]); sum += c; cnt += (c > 0u) ? 1u : 0u; mine = (j == x) ? c : mine; }
        if (sum == G) break;
        __builtin_amdgcn_s_sleep(1);
        if ((++sp & 255u) == 0u) { if (xb_ld(&bar[XB_TMO])) break; if (sp > XB_SPIN_CAP) { atomicAdd(&bar[XB_TMO], 1u); break; } }
    }
    nloc = mine > 0u ? mine : 1u; nx = cnt > 0u ? cnt : 1u;
}
__device__ __forceinline__ void xcd_barrier(const XcdBarrier& b, bool leader) {
    asm volatile("s_waitcnt vmcnt(0)" ::: "memory");
    __syncthreads();
    if (leader) {
        unsigned* bar = b.bar;
        __builtin_amdgcn_s_waitcnt(0);
        unsigned nloc = b.st[0], nx = b.st[1];
        if (nloc == 0u) { xcd_barrier_complete(bar, b.x, nloc, nx); b.st[0] = nloc; b.st[1] = nx; }
        const unsigned old = xb_add(&bar[XB_XSUB(b.x)], 1u);
        const unsigned gen = old / nloc;
        if (old + 1u == (gen + 1u) * nloc) {
            __builtin_amdgcn_fence(__ATOMIC_RELEASE, "agent");
            asm volatile("s_waitcnt vmcnt(0)" ::: "memory");
            const unsigned og = xb_add(&bar[XB_TOP], 1u);
            const unsigned tg = og / nx;
            if (og + 1u == (tg + 1u) * nx) xb_add(&bar[XB_TOPGEN], 1u);
            else XB_SPIN(xb_ld(&bar[XB_TOPGEN]) == tg, bar);
            __builtin_amdgcn_fence(__ATOMIC_ACQUIRE, "agent");
            xb_add(&bar[XB_XGEN(b.x)], 1u);
            asm volatile("s_waitcnt vmcnt(0)" ::: "memory");
        } else {
            XB_SPIN(xb_ld(&bar[XB_XGEN(b.x)]) == gen, bar);
            __builtin_amdgcn_fence(__ATOMIC_ACQUIRE, "agent");
            asm volatile("s_waitcnt vmcnt(0)" ::: "memory");
        }
    }
    __syncthreads();
}

struct Frame { LAS unsigned char* lds; LAS int* lctl; int wave, vcu, G; };

constexpr int NT8 = 20, NTB = 6;
constexpr size_t WIN_LAYER = 26 * MiB, WIN_BF = 10 * MiB;
struct TItem { const float* W; bf16_t* WT; int ldw, ldt, ncols, f8; };
__device__ __forceinline__ TItem decode_item(const Args& A, int it) {
    constexpr int I_IN = 208 * 32, I_OUT = 64 * 32, I_G = 32 * 32, I_D = 64 * 16;
    constexpr int N_IN = DEPTH * I_IN, N_OUT = DEPTH * I_OUT, N_GU = DEPTH * NE * 2 * I_G;
    TItem t; int r = it;
    if (r < N_IN) { const int l = r / I_IN; r -= l * I_IN; const int cb = r >> 5, kb = r & 31, bj = (cb >> 2) & 1;
        const int tile = cb >> 3, wc = cb & 3, grp = tile * 4 + wc;
        const int mode = GRP[grp][0], lo = GRP[grp][1], ho = GRP[grp][2];
        int ncols = 32, n0 = lo + (bj ? ho : 0);
        if (mode == 4) { ncols = 0; n0 = 0; } else if (mode == 3) { ncols = bj ? 0 : 16; n0 = lo; }
        t.W = A.w_in + (size_t)l * DM * PP + (size_t)(kb * 64) * PP + n0; t.ldw = PP; t.ncols = ncols; t.ldt = DM;
        if (tile < NT8) { t.f8 = 1; t.WT = (bf16_t*)(A.ws + WS_WIN + l * WIN_LAYER + (size_t)(cb * 32) * DM + kb * 64); }
        else { t.f8 = 0; t.WT = (bf16_t*)(A.ws + WS_WIN + l * WIN_LAYER + WIN_BF) + (size_t)((cb - NT8 * 8) * 32) * DM + kb * 64; }
        return t; }
    r -= N_IN;
    if (r < N_OUT) { const int l = r / I_OUT; r -= l * I_OUT; const int nb = r >> 5, kb = r & 31;
        t.W = A.w_out + (size_t)l * DM * DM + (size_t)(kb * 64) * DM + nb * 32; t.ldw = DM; t.ncols = 32; t.f8 = 0;
        t.WT = (bf16_t*)(A.ws + WS_WOUT) + (size_t)l * DM * DM + (size_t)(nb * 32) * DM + kb * 64; t.ldt = DM; return t; }
    r -= N_OUT;
    if (r < N_GU) { const int le = r / (2 * I_G); r -= le * 2 * I_G; const int up = r / I_G; r -= up * I_G; const int nb = r >> 5, kb = r & 31, n0 = nb * 32;
        t.W = (up ? A.wu : A.wg) + (size_t)le * DM * DFF + (size_t)(kb * 64) * DFF + n0; t.ldw = DFF; t.ncols = 32; t.f8 = 1;
        t.WT = (bf16_t*)((unsigned char*)(A.ws + WS_WGU) + (size_t)le * DM * DM + (size_t)(256 * (n0 >> 7) + (n0 & 127) + 128 * up) * DM + kb * 64); t.ldt = DM; return t; }
    r -= N_GU;
    { const int le = r / I_D; r -= le * I_D; const int nb = r >> 4, kb = r & 15;
      t.W = A.wd + (size_t)le * DFF * DM + (size_t)(kb * 64) * DM + nb * 32; t.ldw = DM; t.ncols = 32; t.f8 = 1;
      t.WT = (bf16_t*)((unsigned char*)(A.ws + WS_WD) + (size_t)le * DM * DFF + (size_t)(nb * 32) * DFF + kb * 64); t.ldt = DFF; return t; }
}
__device__ __forceinline__ void titem_load(const TItem& t, f32x4 (&v)[8], int lane) {
    const int c4 = (lane & 7) * 4; const bool on = c4 < t.ncols;
#pragma unroll
    for (int i = 0; i < 8; ++i) { const float* p = t.W + (size_t)((lane >> 3) + 8 * i) * t.ldw + c4; v[i] = on ? *(const f32x4*)p : (f32x4){0.f, 0.f, 0.f, 0.f}; }
}
__device__ __forceinline__ void titem_store(const TItem& t, const f32x4 (&v)[8], LAS float* scr, int lane) {
    const int c4 = (lane & 7) * 4;
#pragma unroll
    for (int i = 0; i < 8; ++i) { LAS float* d = scr + ((lane >> 3) + 8 * i) * 33 + c4; d[0] = v[i][0]; d[1] = v[i][1]; d[2] = v[i][2]; d[3] = v[i][3]; }
    asm volatile("s_waitcnt lgkmcnt(0)" ::: "memory");
    const int c = lane & 7;
#pragma unroll
    for (int j = 0; j < 4; ++j) { const int n = (lane >> 3) + 8 * j; const LAS float* s = scr + (8 * c) * 33 + n;
        if (t.f8) { u32x2 o; o.x = pk4_fp8(64.f * s[0 * 33], 64.f * s[1 * 33], 64.f * s[2 * 33], 64.f * s[3 * 33]); o.y = pk4_fp8(64.f * s[4 * 33], 64.f * s[5 * 33], 64.f * s[6 * 33], 64.f * s[7 * 33]);
            *(u32x2*)((unsigned char*)t.WT + (size_t)n * t.ldt + 8 * c) = o; }
        else { u32x4 o; o.x = cvtpk(s[0 * 33], s[1 * 33]); o.y = cvtpk(s[2 * 33], s[3 * 33]); o.z = cvtpk(s[4 * 33], s[5 * 33]); o.w = cvtpk(s[6 * 33], s[7 * 33]);
            *(u32x4*)(t.WT + (size_t)n * t.ldt + 8 * c) = o; } }
    asm volatile("s_waitcnt lgkmcnt(0)" ::: "memory");
}

constexpr int FILL_E1 = 2048, FILL_E2 = FILL_E1 + 32768, FILL_E3 = FILL_E2 + 16384, FILL_E4 = FILL_E3 + 6656, FILL_E5 = FILL_E4 + 2048, FILL_E6 = FILL_E5 + 32768, FILL_E7 = FILL_E6 + 16384;
constexpr int CW_FILL = 2048, CW_DONE = 2112;
__device__ __forceinline__ int fill_to_item(int i) {
    constexpr int N_IN = 2 * 6656, N_OUT = 2 * 2048, N_GU = 2 * 32768;
    if (i < FILL_E1) return N_IN + i;
    if (i < FILL_E2) return N_IN + N_OUT + (i - FILL_E1);
    if (i < FILL_E3) return N_IN + N_OUT + N_GU + (i - FILL_E2);
    if (i < FILL_E4) return 6656 + (i - FILL_E3);
    if (i < FILL_E5) return N_IN + 2048 + (i - FILL_E4);
    if (i < FILL_E6) return N_IN + N_OUT + 32768 + (i - FILL_E5);
    return N_IN + N_OUT + N_GU + 16384 + (i - FILL_E6);
}
__device__ __forceinline__ void fill_run(const Args& A, Frame& F, int must, bool opp, int ph) {
    unsigned* ctl = (unsigned*)(A.ws + WS_CTL);
    unsigned* qh = ctl + CW_FILL; unsigned* done = ctl + CW_DONE + 64 * ph;
    const int lane = lane_id();
    __syncthreads();
    if (opp && F.wave == 0 && lane == 0) __hip_atomic_fetch_add(done, 1u, RLX_AGENT);
    LAS float* scr = (LAS float*)(F.lds + F.wave * 16384);
    for (;;) {
        __syncthreads();
        if (F.wave == 0 && lane == 0) {
            int base = FILL_E7; const int head = (int)__hip_atomic_load(qh, RLX_AGENT);
            bool go = head < FILL_E7;
            if (go && head >= must) go = opp && (int)__hip_atomic_load(done, RLX_AGENT) < F.G;
            if (go) base = (int)__hip_atomic_fetch_add(qh, 16u, RLX_AGENT);
            F.lctl[1] = base;
        }
        __syncthreads();
        const int base = F.lctl[1];
        if (base >= FILL_E7) break;
        const int i0 = base + 2 * F.wave, i1 = i0 + 1;
        f32x4 va[8], vb[8]; TItem ta, tb;
        if (i0 < FILL_E7) { ta = decode_item(A, fill_to_item(i0)); titem_load(ta, va, lane); }
        if (i1 < FILL_E7) { tb = decode_item(A, fill_to_item(i1)); titem_load(tb, vb, lane); }
#ifndef PROBE_FILL2
#define PROBE_FILL2 0
#endif
        if (i0 < FILL_E7) titem_store(ta, va, scr, lane);
        if (i1 < FILL_E7) titem_store(tb, vb, scr, lane);
        if (PROBE_FILL2) {
            if (i0 < FILL_E7) { titem_load(ta, va, lane); } if (i1 < FILL_E7) { titem_load(tb, vb, lane); }
            if (i0 < FILL_E7) titem_store(ta, va, scr, lane); if (i1 < FILL_E7) titem_store(tb, vb, scr, lane); }
    }
}

__device__ __forceinline__ void phase_prologue(const Args& A, Frame& F) {
    LAS float* scr = (LAS float*)(F.lds + F.wave * 16384);
    const int lane = lane_id(), tid = F.wave * 64 + lane;
    const int gw = F.vcu * 8 + F.wave, NGW = F.G * 8;
    constexpr int NITEMS = 208 * 32;
    {
        f32x4 va[8], vb[8]; TItem ta, tb;
        int it = gw;
        if (it < NITEMS) { ta = decode_item(A, it); titem_load(ta, va, lane); }
        while (it < NITEMS) {
            const int it1 = it + NGW, it2 = it + 2 * NGW;
            if (it1 < NITEMS) { tb = decode_item(A, it1); titem_load(tb, vb, lane); }
            titem_store(ta, va, scr, lane);
            if (it1 >= NITEMS) break;
            if (it2 < NITEMS) { ta = decode_item(A, it2); titem_load(ta, va, lane); }
            titem_store(tb, vb, scr, lane);
            it = it2;
        }
    }
    { const int gt = F.vcu * 512 + tid, NT = F.G * 512; bf16_t* XB = (bf16_t*)(A.ws + WS_XB);
      for (size_t i = gt; i < (size_t)T * DM / 8; i += NT) { const f32x4 a = ((const f32x4*)A.x)[2 * i], c = ((const f32x4*)A.x)[2 * i + 1];
          u32x4 w; w.x = cvtpk(a[0], a[1]); w.y = cvtpk(a[2], a[3]); w.z = cvtpk(c[0], c[1]); w.w = cvtpk(c[2], c[3]); ((u32x4*)XB)[i] = w;
          u32x2 q8; q8.x = pk4_fp8(a[0], a[1], a[2], a[3]); q8.y = pk4_fp8(c[0], c[1], c[2], c[3]); ((u32x2*)(A.ws + WS_XQ))[i] = q8; } }
    { const int gt = F.vcu * 512 + tid, NT = F.G * 512; f32x2* r128 = (f32x2*)(A.ws + WS_R128); f32x2* r64 = (f32x2*)(A.ws + WS_R64);
      for (int i = gt; i < T * 64; i += NT) { const int tk = i >> 6, f = i & 63; const float inv = powf(10000.f, -(float)(2 * f) / 128.f), ang = (float)A.pos[tk] * inv; r128[i] = (f32x2){cosf(ang), sinf(ang)}; }
      for (int i = gt; i < T * 32; i += NT) { const int tk = i >> 5, f = i & 31; const float inv = powf(10000.f, -(float)(2 * f) / 64.f), ang = (float)A.pos[tk] * inv; r64[i] = (f32x2){cosf(ang), sinf(ang)}; } }
}

__device__ __forceinline__ void phase_proj(const Args& A, Frame& F, int layer) {
    float* kms = (float*)(A.ws + WS_CTL + KM_OFF) + (size_t)layer * NB * 16 * 512;
    {
        pg8::DenseOrder S; S.init(T, NT8 * 256, DM / 2, A.ws + WS_WIN + layer * WIN_LAYER, F.G, (int)blockIdx.x);
        EpiProj E{(bf16_t*)(A.ws + WS_PROJ), (const f32x2*)(A.ws + WS_R128), (const f32x2*)(A.ws + WS_R64), kms, 0};
        pg8::gemm_phase<EpiProj, pg8::DenseOrder, false, true>(F.lds, (const bf16_t*)(A.ws + WS_XQ), DM / 2, S, E, F.wave);
    }
    {
        pg8::DenseOrder S; S.init(T, NTB * 256, DM, A.ws + WS_WIN + layer * WIN_LAYER + WIN_BF, F.G, (int)blockIdx.x);
        EpiProj E{(bf16_t*)(A.ws + WS_PROJ), (const f32x2*)(A.ws + WS_R128), (const f32x2*)(A.ws + WS_R64), kms, NT8};
        pg8::gemm_phase<EpiProj, pg8::DenseOrder, false, false>(F.lds, (const bf16_t*)(A.ws + WS_XB), DM, S, E, F.wave);
    }
}

constexpr int N_MIX_UNITS = 1152;
__device__ __forceinline__ void phase_mixers(const Args& A, Frame& F, int layer, int rep) {
    unsigned* qh = (unsigned*)(A.ws + WS_CTL) + CW_QUEUE + 64 * layer + 16 * rep;
    LAS char* lds = (LAS char*)F.lds;
    for (;;) {
        __syncthreads();
        if (F.wave == 0 && lane_id() == 0) F.lctl[0] = (int)__hip_atomic_fetch_add(qh, 1u, RLX_AGENT);
        __syncthreads();
        const int u = F.lctl[0];
        if (u >= N_MIX_UNITS) break;
#ifndef UNIT_ONLY
#define UNIT_ONLY (rep == 0 ? 31 : PROBE_MIX)
#endif
#ifndef PROBE_DSA
#define PROBE_DSA 3
#endif
#ifndef PROBE_MIX
#define PROBE_MIX 31
#endif
        int kind, p0, p1;
        if (u < 512)       { kind = 2; p0 = 31 - (u >> 4); p1 = u & 15; }
        else if (u < 576)  { kind = 1; p0 = (u - 512) & 7; p1 = 15 - ((u - 512) >> 3); }
        else if (u < 640)  { kind = 0; p0 = (u - 576) & 7; p1 = 31 - ((u - 576) >> 3); }
        else if (u < 768)  { kind = 3; p0 = u - 640; p1 = 0; }
        else if (u < 832)  { kind = 4; p0 = (u - 768) & 1; p1 = 63 - ((u - 768) >> 1); }
        else if (u < 864)  { kind = 1; p0 = (u - 832) & 7; p1 = 7 - ((u - 832) >> 3); }
        else if (u < 928)  { kind = 0; p0 = (u - 864) & 7; p1 = 23 - ((u - 864) >> 3); }
        else if (u < 960)  { kind = 1; p0 = (u - 928) & 7; p1 = 3 - ((u - 928) >> 3); }
        else { const int v = u - 960, L = 15 - v / 12, w = v % 12;
            if (w < 8) { kind = 0; p0 = w; p1 = L; } else { kind = 4; p0 = (w - 8) & 1; p1 = 2 * L + 1 - ((w - 8) >> 1); } }
        if (kind == 0) { if (UNIT_ONLY & 1) diff_unit(A, layer, p0 >> 2, p0 & 3, p1, lds, F.wave); continue; }
        if (kind == 1) { if (UNIT_ONLY & 2) moba_unit(A, layer, p0 >> 2, p0 & 3, p1, lds, F.wave); continue; }
        if (kind == 2) { if (UNIT_ONLY & 4) dsa_unit(A, layer, p1 >> 3, 128 * p0 + 16 * (p1 & 7), lds, F.wave, rep == 0 ? 3 : PROBE_DSA); continue; }
        if (kind == 4) { if (UNIT_ONLY & 16) dsa_att_unit(A, layer, p0, p1, lds, F.wave); continue; }
        { if (UNIT_ONLY & 8) dil_unit(A, p0 >> 6, (p0 >> 4) & 3, p0 & 15, lds, F.wave); }
    }
}

__device__ __forceinline__ void phase_outproj(const Args& A, Frame& F, int layer) {
    pg8::DenseOrder S; S.init(T, DM, DM, (const bf16_t*)(A.ws + WS_WOUT) + (size_t)layer * DM * DM, F.G, (int)blockIdx.x);
    EpiOut E{layer == 0 ? A.x : (const float*)(A.ws + WS_XF2), (bf16_t*)(A.ws + WS_Y1)};
    pg8::gemm_phase<EpiOut, pg8::DenseOrder, false>(F.lds, (const bf16_t*)(A.ws + WS_MIX), DM, S, E, F.wave);
}

__device__ __forceinline__ void route_token(const float (&lg)[16], const float* rb, LAS int* lcnt, float* tok_gate, int* tok_e, int* tok_rank, int tk, int lane) {
    float aff[16], sc[16];
#pragma unroll
    for (int e = 0; e < 16; ++e) { aff[e] = 1.f / (1.f + expf(-lg[e])); sc[e] = aff[e] + rb[e]; }
    float gbest = NEG_INF; int gi = 0;
#pragma unroll
    for (int k = 0; k < 4; ++k) {
        const float a = sc[4 * k], b = sc[4 * k + 1], c = sc[4 * k + 2], d = sc[4 * k + 3];
        const float m1 = fmaxf(fmaxf(a, b), fmaxf(c, d));
        const float lo1 = fminf(a, b), hi1 = fmaxf(a, b), lo2 = fminf(c, d), hi2 = fmaxf(c, d);
        const float m2 = fmaxf(fminf(hi1, hi2), fmaxf(lo1, lo2));
        const float gs = m1 + m2;
        if (gs > gbest) { gbest = gs; gi = k; }
    }
    float s0 = sc[0], s1 = sc[1], s2_ = sc[2], s3 = sc[3], a0 = aff[0], a1 = aff[1], a2 = aff[2], a3 = aff[3];
#pragma unroll
    for (int k = 1; k < 4; ++k) if (gi == k) { s0 = sc[4 * k]; s1 = sc[4 * k + 1]; s2_ = sc[4 * k + 2]; s3 = sc[4 * k + 3]; a0 = aff[4 * k]; a1 = aff[4 * k + 1]; a2 = aff[4 * k + 2]; a3 = aff[4 * k + 3]; }
    int i1 = 0; float b1 = s0;
    if (s1 > b1) { b1 = s1; i1 = 1; } if (s2_ > b1) { b1 = s2_; i1 = 2; } if (s3 > b1) { b1 = s3; i1 = 3; }
    int i2 = -1; float b2 = NEG_INF;
    if (i1 != 0 && (i2 < 0 || s0 > b2)) { b2 = s0; i2 = 0; }
    if (i1 != 1 && (i2 < 0 || s1 > b2)) { b2 = s1; i2 = 1; }
    if (i1 != 2 && (i2 < 0 || s2_ > b2)) { b2 = s2_; i2 = 2; }
    if (i1 != 3 && (i2 < 0 || s3 > b2)) { b2 = s3; i2 = 3; }
    const float g1 = i1 == 0 ? a0 : i1 == 1 ? a1 : i1 == 2 ? a2 : a3, g2 = i2 == 0 ? a0 : i2 == 1 ? a1 : i2 == 2 ? a2 : a3;
    if (lane == 0) {
        const int e1 = gi * 4 + i1, e2 = gi * 4 + i2; const float gsum = g1 + g2;
        const int r1 = __hip_atomic_fetch_add(lcnt + e1, 1, __ATOMIC_RELAXED, __HIP_MEMORY_SCOPE_WORKGROUP), r2 = __hip_atomic_fetch_add(lcnt + e2, 1, __ATOMIC_RELAXED, __HIP_MEMORY_SCOPE_WORKGROUP);
        tok_e[2 * tk] = e1; tok_e[2 * tk + 1] = e2; tok_rank[2 * tk] = r1; tok_rank[2 * tk + 1] = r2; tok_gate[2 * tk] = g1 / gsum; tok_gate[2 * tk + 1] = g2 / gsum;
    }
}
__device__ __forceinline__ void phase_ln1_router(const Args& A, Frame& F, int layer) {
    const int lane = lane_id(), tid = F.wave * 64 + lane;
    LAS f32x4* wl = (LAS f32x4*)F.lds;
    for (int i = tid; i < 4 * 8 * 4 * 64; i += 512) { const int l = i & 63, c = (i >> 6) & 3, j = (i >> 8) & 7, q = i >> 11; wl[i] = *(const f32x4*)(A.rw + (size_t)(256 * j + 4 * l + c) * 16 + 4 * q); }
    if (tid < 16) F.lctl[96 + tid] = 0;
    __syncthreads();
    bf16_t* Y1 = (bf16_t*)(A.ws + WS_Y1); unsigned char* X1Q = (unsigned char*)(A.ws + WS_X1B);
    int* tok_e = (int*)(A.ws + WS_ROUTE + RT_TOKE); int* tok_rank = (int*)(A.ws + WS_ROUTE + RT_RANK); float* tok_gate = (float*)(A.ws + WS_ROUTE + RT_TOKG);
    LAS int* lcnt = F.lctl + 96;
    const float* g = A.lmg + layer * DM; const float* bb = A.lmb + layer * DM;
    constexpr int TPW = 2;
    u32x2 nx[TPW][8];
    { const int tkf = (F.vcu * 8 + F.wave) * TPW;
#pragma unroll
      for (int u = 0; u < TPW; ++u)
#pragma unroll
          for (int j = 0; j < 8; ++j) nx[u][j] = *(const u32x2*)(Y1 + (size_t)(tkf + u) * DM + 256 * j + 4 * lane); }
#pragma clang loop unroll(disable)
    for (int tk0 = (F.vcu * 8 + F.wave) * TPW; tk0 < T; tk0 += F.G * 8 * TPW) {
        f32x4 v[TPW][8]; float mean[TPW], rstd[TPW];
#pragma unroll
        for (int u = 0; u < TPW; ++u)
#pragma unroll
            for (int j = 0; j < 8; ++j) { const u32x2 y = nx[u][j]; v[u][j][0] = bflo(y.x); v[u][j][1] = bfhi(y.x); v[u][j][2] = bflo(y.y); v[u][j][3] = bfhi(y.y); }
        { const int tkn = tk0 + F.G * 8 * TPW;
          if (tkn < T) {
#pragma unroll
              for (int u = 0; u < TPW; ++u)
#pragma unroll
                  for (int j = 0; j < 8; ++j) nx[u][j] = *(const u32x2*)(Y1 + (size_t)(tkn + u) * DM + 256 * j + 4 * lane); } }
#pragma unroll
        for (int u = 0; u < TPW; ++u) { float s = 0.f;
#pragma unroll
            for (int j = 0; j < 8; ++j) s += (v[u][j][0] + v[u][j][1]) + (v[u][j][2] + v[u][j][3]);
            mean[u] = s; }
#pragma unroll
        for (int o = 1; o < 64; o <<= 1)
#pragma unroll
            for (int u = 0; u < TPW; ++u) mean[u] += __shfl_xor(mean[u], o);
#pragma unroll
        for (int u = 0; u < TPW; ++u) { mean[u] *= (1.f / DM); float s2 = 0.f;
#pragma unroll
            for (int j = 0; j < 8; ++j) { v[u][j] = v[u][j] - mean[u]; s2 += (v[u][j][0] * v[u][j][0] + v[u][j][1] * v[u][j][1]) + (v[u][j][2] * v[u][j][2] + v[u][j][3] * v[u][j][3]); }
            rstd[u] = s2; }
#pragma unroll
        for (int o = 1; o < 64; o <<= 1)
#pragma unroll
            for (int u = 0; u < TPW; ++u) rstd[u] += __shfl_xor(rstd[u], o);
#pragma unroll
        for (int u = 0; u < TPW; ++u) rstd[u] = rsqrtf(rstd[u] * (1.f / DM) + LN_EPS);
        float lg[TPW][16];
#pragma unroll
        for (int u = 0; u < TPW; ++u)
#pragma unroll
            for (int e = 0; e < 16; ++e) lg[u][e] = 0.f;
#pragma unroll
        for (int j = 0; j < 8; ++j) {
            const f32x4 gg = *(const f32x4*)(g + 256 * j + 4 * lane), b4 = *(const f32x4*)(bb + 256 * j + 4 * lane);
#pragma unroll
            for (int u = 0; u < TPW; ++u) {
                v[u][j] = v[u][j] * rstd[u] * gg + b4;
                { u32x2 w; w.x = cvtpk(v[u][j][0], v[u][j][1]); w.y = cvtpk(v[u][j][2], v[u][j][3]); *(u32x2*)(Y1 + (size_t)(tk0 + u) * DM + 256 * j + 4 * lane) = w; }
                *(unsigned*)(X1Q + (size_t)(tk0 + u) * DM + 256 * j + 4 * lane) = pk4_fp8(v[u][j][0], v[u][j][1], v[u][j][2], v[u][j][3]);
            }
#pragma unroll
            for (int c = 0; c < 4; ++c) {
#pragma unroll
                for (int q = 0; q < 4; ++q) { const f32x4 w4 = wl[((q * 8 + j) * 4 + c) * 64 + lane];
#pragma unroll
                    for (int u = 0; u < TPW; ++u) { lg[u][4 * q] += v[u][j][c] * w4[0]; lg[u][4 * q + 1] += v[u][j][c] * w4[1]; lg[u][4 * q + 2] += v[u][j][c] * w4[2]; lg[u][4 * q + 3] += v[u][j][c] * w4[3]; } }
                __builtin_amdgcn_sched_barrier(0);
            }
        }
#pragma unroll
        for (int o = 1; o < 64; o <<= 1)
#pragma unroll
            for (int u = 0; u < TPW; ++u)
#pragma unroll
                for (int e = 0; e < 16; ++e) lg[u][e] += __shfl_xor(lg[u][e], o);
#pragma unroll
        for (int u = 0; u < TPW; ++u) route_token(lg[u], A.rb, lcnt, tok_gate, tok_e, tok_rank, tk0 + u, lane);
    }
    __syncthreads();
    { const int t2 = F.wave * 64 + lane_id();
      if (t2 < 16) ((int*)(A.ws + WS_ROUTE + RT_BLK))[F.vcu * 16 + t2] = lcnt[t2]; }
}
__device__ __forceinline__ void route_finish(const Args& A, Frame& F, int layer) {
    const int lane = lane_id(), tid = F.wave * 64 + lane;
    LAS int* tab = (LAS int*)F.lds;
    const int* blk = (const int*)(A.ws + WS_ROUTE + RT_BLK);
    for (int i = tid; i < F.G * 16; i += 512) tab[i] = blk[i];
    __syncthreads();
    if (tid < 16) { int base = 0, tot = 0;
        for (int b = 0; b < F.G; ++b) { const int c = tab[b * 16 + tid]; tot += c; if (b < F.vcu) base += c; }
        F.lctl[112 + tid] = base;
        if (F.vcu == 0) ((unsigned*)(A.ws + WS_CTL) + CW_CNT + 64 * layer)[tid] = (unsigned)tot; }
    __syncthreads();
    const int* tok_e = (const int*)(A.ws + WS_ROUTE + RT_TOKE); int* tok_rank = (int*)(A.ws + WS_ROUTE + RT_RANK); const float* tok_gate = (const float*)(A.ws + WS_ROUTE + RT_TOKG);
    int* tok_list = (int*)(A.ws + WS_ROUTE + RT_LIST); float* sgate = (float*)(A.ws + WS_ROUTE + RT_GATE);
    if (tid < 64) {
        const int k = tid & 1, u = (tid >> 1) & 1, w = (tid >> 2) & 7, it = tid >> 5;
        const int tk = (F.vcu * 8 + w) * 2 + u + F.G * 16 * it;
        if (tk < T) { const int e = tok_e[2 * tk + k], r = F.lctl[112 + e] + tok_rank[2 * tk + k];
            tok_rank[2 * tk + k] = r; tok_list[e * 8192 + r] = tk; sgate[e * 8192 + r] = tok_gate[2 * tk + k]; } }
}

__device__ __forceinline__ void moe_table(const Args& A, Frame& F, int layer) {
    __syncthreads();
    if (F.wave == 0 && lane_id() == 0) {
        const unsigned* cnt = (const unsigned*)(A.ws + WS_CTL) + CW_CNT + 64 * layer;
        int ps = 0, ub = 0;
        for (int e = 0; e < 16; ++e) { const int c = (int)__hip_atomic_load(cnt + e, RLX_AGENT), mt = (c + 255) >> 8;
            F.lctl[16 + e] = c; F.lctl[32 + e] = ps; F.lctl[48 + e] = ub; ps += mt * 256; ub += mt * 8; }
        F.lctl[48 + 16] = ub;
    }
    __syncthreads();
}
__device__ __forceinline__ void phase_moe_gu(const Args& A, Frame& F, int layer) {
    moe_table(A, F, layer);
    MoeSched S{F.lctl + 16, F.G, F.vcu, DM / 2, (const char*)(A.ws + WS_WGU) + (size_t)layer * NE * DM * DM, (size_t)DM * DM, (const int*)(A.ws + WS_ROUTE + RT_LIST), 1};
    EpiGU E{(unsigned char*)(A.ws + WS_H)};
    pg8::gemm_phase<EpiGU, MoeSched, true, true>(F.lds, (const bf16_t*)(A.ws + WS_X1B), DM / 2, S, E, F.wave);
}
__device__ __forceinline__ void phase_moe_down(const Args& A, Frame& F, int layer) {
    moe_table(A, F, layer);
    MoeSched S{F.lctl + 16, F.G, F.vcu, DFF / 2, (const char*)(A.ws + WS_WD) + (size_t)layer * NE * DM * DFF, (size_t)DM * DFF, nullptr, 0};
    EpiDown E{(bf16_t*)(A.ws + WS_YS), (const float*)(A.ws + WS_ROUTE + RT_GATE)};
    pg8::gemm_phase<EpiDown, MoeSched, false, true>(F.lds, (const bf16_t*)(A.ws + WS_H), DFF / 2, S, E, F.wave);
}

__device__ __forceinline__ void phase_final_ln(const Args& A, Frame& F, int layer) {
    moe_table(A, F, layer);
    const int lane = lane_id();
    const bf16_t* X1 = (const bf16_t*)(A.ws + WS_Y1); const bf16_t* YS = (const bf16_t*)(A.ws + WS_YS);
    const int* tok_e = (const int*)(A.ws + WS_ROUTE + RT_TOKE); const int* tok_rank = (const int*)(A.ws + WS_ROUTE + RT_RANK);
    const float* g = A.lfg + layer * DM; const float* bb = A.lfb + layer * DM;
    float* XO = layer == DEPTH - 1 ? A.out : (float*)(A.ws + WS_XF2); bf16_t* XB = (bf16_t*)(A.ws + WS_XB);
    constexpr int TPW = 4;
    for (int tk0 = (F.vcu * 8 + F.wave) * TPW; tk0 < T; tk0 += F.G * 8 * TPW) {
        f32x4 v[TPW][8]; float mean[TPW], rstd[TPW]; size_t s1[TPW], s2[TPW];
#pragma unroll
        for (int u = 0; u < TPW; ++u) { const int tk = tk0 + u; const int e1 = tok_e[2 * tk], e2 = tok_e[2 * tk + 1];
            s1[u] = (size_t)(F.lctl[32 + e1] + tok_rank[2 * tk]) * DM; s2[u] = (size_t)(F.lctl[32 + e2] + tok_rank[2 * tk + 1]) * DM; }
#pragma unroll
        for (int u = 0; u < TPW; ++u) {
#pragma unroll
            for (int j = 0; j < 8; ++j) { const int k = 256 * j + 4 * lane; const u32x2 xw = *(const u32x2*)(X1 + (size_t)(tk0 + u) * DM + k); const float x[4] = {bflo(xw.x), bfhi(xw.x), bflo(xw.y), bfhi(xw.y)};
                const u32x2 ya = *(const u32x2*)(YS + s1[u] + k), yb = *(const u32x2*)(YS + s2[u] + k);
                v[u][j][0] = x[0] * ALPHA + (bflo(ya.x) + bflo(yb.x)); v[u][j][1] = x[1] * ALPHA + (bfhi(ya.x) + bfhi(yb.x));
                v[u][j][2] = x[2] * ALPHA + (bflo(ya.y) + bflo(yb.y)); v[u][j][3] = x[3] * ALPHA + (bfhi(ya.y) + bfhi(yb.y)); } }
#pragma unroll
        for (int u = 0; u < TPW; ++u) { float s = 0.f;
#pragma unroll
            for (int j = 0; j < 8; ++j) s += (v[u][j][0] + v[u][j][1]) + (v[u][j][2] + v[u][j][3]);
            mean[u] = s; }
#pragma unroll
        for (int o = 1; o < 64; o <<= 1)
#pragma unroll
            for (int u = 0; u < TPW; ++u) mean[u] += __shfl_xor(mean[u], o);
#pragma unroll
        for (int u = 0; u < TPW; ++u) { mean[u] *= (1.f / DM); float q2 = 0.f;
#pragma unroll
            for (int j = 0; j < 8; ++j) { v[u][j] = v[u][j] - mean[u]; q2 += (v[u][j][0] * v[u][j][0] + v[u][j][1] * v[u][j][1]) + (v[u][j][2] * v[u][j][2] + v[u][j][3] * v[u][j][3]); }
            rstd[u] = q2; }
#pragma unroll
        for (int o = 1; o < 64; o <<= 1)
#pragma unroll
            for (int u = 0; u < TPW; ++u) rstd[u] += __shfl_xor(rstd[u], o);
#pragma unroll
        for (int u = 0; u < TPW; ++u) rstd[u] = rsqrtf(rstd[u] * (1.f / DM) + LN_EPS);
#pragma unroll
        for (int j = 0; j < 8; ++j) { const int k = 256 * j + 4 * lane; const f32x4 gg = *(const f32x4*)(g + k), b4 = *(const f32x4*)(bb + k);
#pragma unroll
            for (int u = 0; u < TPW; ++u) { const f32x4 o = v[u][j] * rstd[u] * gg + b4; *(f32x4*)(XO + (size_t)(tk0 + u) * DM + k) = o;
                if (layer != DEPTH - 1) { u32x2 w; w.x = cvtpk(o[0], o[1]); w.y = cvtpk(o[2], o[3]); *(u32x2*)(XB + (size_t)(tk0 + u) * DM + k) = w;
                    *(unsigned*)(A.ws + WS_XQ + (size_t)(tk0 + u) * DM + k) = pk4_fp8(o[0], o[1], o[2], o[3]); } } }
    }
}

constexpr int N_PHASES = 1 + 7 * DEPTH;
__global__ void __launch_bounds__(512, 2) fwd(Args A_karg) {
    extern __shared__ __attribute__((aligned(16))) unsigned char lds_raw[];
    Frame F; F.lds = (LAS unsigned char*)lds_raw; F.lctl = (LAS int*)(F.lds + LDS_CTL_OFF);
    const int wave0 = __builtin_amdgcn_readfirstlane((int)threadIdx.x >> 6); F.wave = wave0;
    F.G = gridDim.x; { const int bx = blockIdx.x; F.vcu = (F.G % 8 == 0) ? (bx % 8) * (F.G / 8) + bx / 8 : bx; }
    const int vcu0 = F.vcu;
    const int lo = A_karg.ph_lo, hi = A_karg.ph_hi;
#ifndef USE_CG_SYNC
#define USE_CG_SYNC 0
#endif
    const bool leader = (wave0 == 0 && lane_id() == 0);
    if (leader) { F.lctl[8] = 0; F.lctl[9] = 0; }
    __syncthreads();
    XcdBarrier xbar; xbar.bar = nullptr; xbar.x = 0; xbar.st = nullptr;
    if (!USE_CG_SYNC && hi - lo > 1) xbar = xcd_barrier_post((unsigned*)(A_karg.ws + WS_CTL) + CW_BAR, (volatile LAS unsigned*)(F.lctl + 8), leader);
    typedef const __attribute__((address_space(4))) Args* kargp_t;
    int ph = lo, rep = 0;
    while (ph < hi) {
        kargp_t kp = (kargp_t)__builtin_amdgcn_kernarg_segment_ptr(); asm volatile("" : "+s"(kp));
        Args A; A.x = kp->x; A.pos = kp->pos; A.w_in = kp->w_in; A.w_out = kp->w_out; A.dlam = kp->dlam; A.dng = kp->dng; A.lmg = kp->lmg; A.lmb = kp->lmb; A.rw = kp->rw; A.rb = kp->rb;
        A.wg = kp->wg; A.wu = kp->wu; A.wd = kp->wd; A.lfg = kp->lfg; A.lfb = kp->lfb; A.out = kp->out; A.ws = kp->ws; A.ph_lo = lo; A.ph_hi = hi;
        { int w_ = wave0, c_ = vcu0, g_ = (int)gridDim.x; asm volatile("" : "+s"(w_), "+s"(c_), "+s"(g_)); F.wave = w_; F.vcu = c_; F.G = g_; }
#ifdef PHASE_ONLY
        { const int layer = ph & 1;
          if (PHASE_ONLY == 0) phase_prologue(A, F);
          if (PHASE_ONLY == 1) phase_proj(A, F, layer);
          if (PHASE_ONLY == 2) phase_mixers(A, F, layer, 0);
          if (PHASE_ONLY == 3) phase_outproj(A, F, layer);
          if (PHASE_ONLY == 4) phase_ln1_router(A, F, layer);
          if (PHASE_ONLY == 5) phase_moe_gu(A, F, layer);
          if (PHASE_ONLY == 6) phase_moe_down(A, F, layer);
          if (PHASE_ONLY == 7) phase_final_ln(A, F, layer);
          ++ph; continue; }
#endif
#ifndef PROBE_REP
#define PROBE_REP 0
#endif
        const int kind = ph == 0 ? 0 : 1 + (ph - 1) % 7;
        if (ph == 0) phase_prologue(A, F);
        else {
            const int layer = (ph - 1) / 7, k = (ph - 1) % 7;
            if (k == 0) phase_proj(A, F, layer);
            else if (k == 1) phase_mixers(A, F, layer, rep);
            else if (k == 2) phase_outproj(A, F, layer);
            else if (k == 3) phase_ln1_router(A, F, layer);
            else if (k == 4) phase_moe_gu(A, F, layer);
            else if (k == 5) phase_moe_down(A, F, layer);
            else phase_final_ln(A, F, layer);
        }
        if (ph > 0 && (ph - 1) % 7 == 3 && rep == 0) {
            if (USE_CG_SYNC) cg::this_grid().sync(); else xcd_barrier(xbar, wave0 == 0 && lane_id() == 0);
            route_finish(A, F, (ph - 1) / 7);
        }
        {
            const int k7 = ph == 0 ? -1 : (ph - 1) % 7, lay = ph == 0 ? 0 : (ph - 1) / 7;
            int must = 0; bool opp = false;
            if (k7 == 0) { opp = true; }
            else if (k7 == 1) { must = lay == 0 ? FILL_E1 : FILL_E5; opp = true; }
            else if (k7 == 3) { must = lay == 0 ? FILL_E2 : FILL_E6; }
            else if (k7 == 4) { must = lay == 0 ? FILL_E3 : FILL_E7; opp = true; }
            else if (k7 == 5) { opp = true; }
            else if (k7 == 6) { must = lay == 0 ? FILL_E4 : FILL_E7; }
            if (ph > 0 && rep == 0 && (must > 0 || opp)) fill_run(A, F, must, opp, ph);
        }
        if (rep == 0 && ((PROBE_REP >> kind) & 1)) rep = 1; else { rep = 0; ++ph; }
#ifndef PROBE_SYNC
#define PROBE_SYNC 1
#endif
        if (ph < hi) { for (int k_ = 0; k_ < PROBE_SYNC; ++k_) { if (USE_CG_SYNC) cg::this_grid().sync(); else xcd_barrier(xbar, wave0 == 0 && lane_id() == 0); } }
    }
}

extern "C" void kernel_launch(void* const* d_in, const int* in_sizes, int n_in, void* d_out, int out_size, void* d_ws, size_t ws_size, hipStream_t stream) {
    static int grid = 0;
    if (grid == 0) {
        if (n_in != 15 || ws_size < WS_END) { fprintf(stderr, "kernel_launch: unexpected inputs (n_in %d, ws %zu)\n", n_in, ws_size); grid = -1; return; }
        int dev = 0, cus = 0, per_cu = 0;
        hipGetDevice(&dev); hipDeviceGetAttribute(&cus, hipDeviceAttributeMultiprocessorCount, dev);
        hipFuncSetAttribute((const void*)fwd, hipFuncAttributeMaxDynamicSharedMemorySize, LDS_BYTES);
        hipOccupancyMaxActiveBlocksPerMultiprocessor(&per_cu, (const void*)fwd, 512, LDS_BYTES);
        if (per_cu < 1) { fprintf(stderr, "kernel_launch: occupancy query says %d blocks per CU\n", per_cu); per_cu = 1; }
        (void)hipGetLastError();
        grid = cus;
    }
    if (grid < 0) return;
    hipMemsetAsync((char*)d_ws + WS_CTL, 0, CTL_BYTES, stream);
    Args a{};
    a.x = (const float*)d_in[0]; a.pos = (const int*)d_in[1]; a.w_in = (const float*)d_in[2]; a.w_out = (const float*)d_in[3]; a.dlam = (const float*)d_in[4]; a.dng = (const float*)d_in[5];
    a.lmg = (const float*)d_in[6]; a.lmb = (const float*)d_in[7]; a.rw = (const float*)d_in[8]; a.rb = (const float*)d_in[9]; a.wg = (const float*)d_in[10]; a.wu = (const float*)d_in[11];
    a.wd = (const float*)d_in[12]; a.lfg = (const float*)d_in[13]; a.lfb = (const float*)d_in[14]; a.out = (float*)d_out; a.ws = (unsigned char*)d_ws;
#if MK_N_LAUNCHES == 1
    a.ph_lo = 0; a.ph_hi = N_PHASES;
    void* args[] = {&a};
    hipError_t e = hipLaunchCooperativeKernel((const void*)fwd, dim3(grid), dim3(512), args, LDS_BYTES, stream);
    if (e != hipSuccess) fprintf(stderr, "cooperative launch failed: %s (grid %d)\n", hipGetErrorString(e), grid);
#else
    for (int ph = 0; ph < N_PHASES; ++ph) { a.ph_lo = ph; a.ph_hi = ph + 1; hipLaunchKernelGGL(fwd, dim3(grid), dim3(512), LDS_BYTES, stream, a); }
#endif
}
```

```cpp
#include <hip/hip_runtime.h>
#include <hip/hip_cooperative_groups.h>
#include <cstdio>
#include <cstdint>
namespace cg = cooperative_groups;

#ifndef MK_N_LAUNCHES
#define MK_N_LAUNCHES 1
#endif

#define LAS __attribute__((address_space(3)))
typedef unsigned short bf16_t;
typedef short bf16x8 __attribute__((ext_vector_type(8)));
typedef short s16x4 __attribute__((ext_vector_type(4)));
typedef float f32x2 __attribute__((ext_vector_type(2)));
typedef float f32x4 __attribute__((ext_vector_type(4)));
typedef float f32x16 __attribute__((ext_vector_type(16)));
typedef unsigned u32x2 __attribute__((ext_vector_type(2)));
typedef unsigned u32x4 __attribute__((ext_vector_type(4)));
typedef __bf16 bf16x2_t __attribute__((ext_vector_type(2)));
typedef int v8i32_t __attribute__((ext_vector_type(8)));

constexpr int NB = 2, SEQ = 4096, T = NB * SEQ, DM = 2048, DEPTH = 2;
constexpr int PP = 6480;
constexpr int NPROJ = 6656;
constexpr int C_AQ = 0, C_AK = 512, C_AV = 640, C_IQ = 768, C_IK = 1792, C_IW = 1856, C_BQ = 1872, C_BK = 2384, C_BV = 2896,
              C_CQ = 3408, C_CK = 3920, C_CV = 4432, C_DQ = 4944, C_DK = 5456, C_DV = 5968;
constexpr int NE = 16, DFF = 1024, HROWS = 20480;
constexpr float LN_EPS = 1e-5f;
constexpr float ALPHA = 1.41421356237309515f;
constexpr float LOG2E = 1.4426950408889634f;
constexpr float NEG_INF = -__builtin_huge_valf();

constexpr size_t MiB = 1u << 20;
constexpr size_t WS_CTL = 0, CTL_BYTES = 1 * MiB;
constexpr size_t WS_WIN = 1 * MiB;
constexpr size_t WS_WOUT = 53 * MiB;
constexpr size_t WS_WGU = 69 * MiB;
constexpr size_t WS_WD = 325 * MiB;
constexpr size_t WS_XB = 453 * MiB;
constexpr size_t WS_PROJ = 485 * MiB;
constexpr size_t WS_MIX = 587 * MiB;
constexpr size_t WS_Y1 = 619 * MiB;
constexpr size_t WS_XF2 = 683 * MiB;
constexpr size_t WS_X1B = 747 * MiB;
constexpr size_t WS_XQ = 763 * MiB;
constexpr size_t WS_H = 780 * MiB;
constexpr size_t WS_YS = 820 * MiB;
constexpr size_t WS_R128 = 900 * MiB;
constexpr size_t WS_R64 = 904 * MiB;
constexpr size_t WS_ROUTE = 906 * MiB;
constexpr size_t WS_BM = 910 * MiB;
constexpr size_t WS_END = 914 * MiB;
constexpr size_t RT_TOKE = 0, RT_RANK = 65536, RT_LIST = 131072, RT_GATE = 131072 + 524288;
constexpr size_t RT_TOKG = 2 * MiB, RT_BLK = 2 * MiB + 65536;
constexpr int CW_QUEUE = 64;
constexpr int CW_CNT = 1024;
constexpr int CW_BAR = 4096;
#define XB_TMO      128
#define XB_SPIN_CAP (1u << 22)
constexpr int CW_DSAC = 8192;
constexpr size_t KM_OFF = 262144;

constexpr int LDS_CTL_OFF = 155648;
constexpr int LDS_BYTES = 156672;
constexpr int VP = 320;
constexpr int VT_BYTES = 32 * VP;

__constant__ short GRP[104][4] = {
{1,0,64,0}, {1,32,64,32}, {1,128,64,0}, {1,160,64,32}, {1,256,64,0}, {1,288,64,32}, {1,384,64,0}, {1,416,64,32}, {1,512,64,0}, {1,544,64,32}, {0,640,32,0}, {0,704,32,0}, {2,768,32,0}, {2,832,32,0}, {2,896,32,0}, {2,960,32,0}, {2,1024,32,0}, {2,1088,32,0}, {2,1152,32,0}, {2,1216,32,0}, {2,1280,32,0}, {2,1344,32,0}, {2,1408,32,0}, {2,1472,32,0}, {2,1536,32,0}, {2,1600,32,0}, {2,1664,32,0}, {2,1728,32,0}, {2,1792,32,0}, {3,1856,0,0}, {1,3408,64,0}, {1,3440,64,32}, {1,3536,64,0}, {1,3568,64,32}, {1,3664,64,0}, {1,3696,64,32}, {1,3792,64,0}, {1,3824,64,32}, {1,3920,64,0}, {1,3952,64,32}, {1,4048,64,0}, {1,4080,64,32}, {1,4176,64,0}, {1,4208,64,32}, {1,4304,64,0}, {1,4336,64,32}, {0,4432,32,0}, {0,4496,32,0}, {0,4560,32,0}, {0,4624,32,0}, {0,4688,32,0}, {0,4752,32,0}, {0,4816,32,0}, {0,4880,32,0}, {1,4944,64,0}, {1,4976,64,32}, {1,5072,64,0}, {1,5104,64,32}, {1,5200,64,0}, {1,5232,64,32}, {1,5328,64,0}, {1,5360,64,32}, {1,5456,64,0}, {1,5488,64,32}, {1,5584,64,0}, {1,5616,64,32}, {1,5712,64,0}, {1,5744,64,32}, {1,5840,64,0}, {1,5872,64,32}, {0,5968,32,0}, {0,6032,32,0}, {0,6096,32,0}, {0,6160,32,0}, {0,6224,32,0}, {0,6288,32,0}, {0,6352,32,0}, {0,6416,32,0}, {4,0,0,0}, {4,0,0,0}, {2,1872,32,0}, {2,1936,32,0}, {2,2000,32,0}, {2,2064,32,0}, {2,2128,32,0}, {2,2192,32,0}, {2,2256,32,0}, {2,2320,32,0}, {2,2384,32,0}, {2,2448,32,0}, {2,2512,32,0}, {2,2576,32,0}, {2,2640,32,0}, {2,2704,32,0}, {2,2768,32,0}, {2,2832,32,0}, {0,2896,32,0}, {0,2960,32,0}, {0,3024,32,0}, {0,3088,32,0}, {0,3152,32,0}, {0,3216,32,0}, {0,3280,32,0}, {0,3344,32,0}};

__device__ __forceinline__ unsigned cvtpk(float lo, float hi) { f32x2 v = {lo, hi}; bf16x2_t b = __builtin_convertvector(v, bf16x2_t); return __builtin_bit_cast(unsigned, b); }
__device__ __forceinline__ unsigned pk4_fp8(float a, float b, float c, float d) { unsigned w = 0u; w = __builtin_amdgcn_cvt_pk_fp8_f32(a, b, w, false); w = __builtin_amdgcn_cvt_pk_fp8_f32(c, d, w, true); return w; }
__device__ __forceinline__ float bf2f(unsigned short b) { return __builtin_bit_cast(float, (unsigned)b << 16); }
__device__ __forceinline__ float bflo(unsigned w) { return __builtin_bit_cast(float, w << 16); }
__device__ __forceinline__ float bfhi(unsigned w) { return __builtin_bit_cast(float, w & 0xffff0000u); }
__device__ __forceinline__ int crow(int r, int hi) { return (r & 3) + 8 * (r >> 2) + 4 * hi; }
#define RLX_AGENT __ATOMIC_RELAXED, __HIP_MEMORY_SCOPE_AGENT
__device__ __forceinline__ int lane_id() { int l; asm volatile("v_mbcnt_lo_u32_b32 %0, -1, 0\n\tv_mbcnt_hi_u32_b32 %0, -1, %0" : "=v"(l)); return l; }

struct swap2 { float a, b; };
__device__ __forceinline__ swap2 pl32swap(float x, float y) { const auto r = __builtin_amdgcn_permlane32_swap(__float_as_uint(x), __float_as_uint(y), false, false); const unsigned u0 = r[0], u1 = r[1]; swap2 o; o.a = __uint_as_float(u0); o.b = __uint_as_float(u1); return o; }
template <int M> __device__ __forceinline__ float shx_f(float v) { return __int_as_float(__builtin_amdgcn_ds_swizzle(__float_as_int(v), (M << 10) | 0x1f)); }
__device__ __forceinline__ float xsum32(float v) { const swap2 r = pl32swap(v, v); return r.a + r.b; }
__device__ __forceinline__ float xmax32(float v) { const swap2 r = pl32swap(v, v); return fmaxf(r.a, r.b); }
__device__ __forceinline__ float allsum(float v) { v += shx_f<1>(v); v += shx_f<2>(v); v += shx_f<4>(v); v += shx_f<8>(v); v += shx_f<16>(v); return xsum32(v); }
__device__ __forceinline__ float wave_sum(float v) { return allsum(v); }
__device__ __forceinline__ swap2 pl16swap(float x, float y) { const auto r = __builtin_amdgcn_permlane16_swap(__float_as_uint(x), __float_as_uint(y), false, false); const unsigned u0 = r[0], u1 = r[1]; swap2 o; o.a = __uint_as_float(u0); o.b = __uint_as_float(u1); return o; }

namespace pg8 {
constexpr int BM = 256, BK = 64, HALF = 128, HTB = HALF * BK * 2, STAGE_BYTES = 8 * HTB, NXCD = 8, WGM = 8;
__device__ __forceinline__ int lds_byte(int r, int c) { const int st = (r >> 4) * 2 + (c >> 5), rr = r & 15, cc = c & 31, ob = rr * 64 + cc * 2; return st * 1024 + (ob ^ (((ob >> 9) & 1) << 5)); }
__device__ __forceinline__ void stage_rc(int b, int& R, int& C) { const int st = b / 1024, sb = b % 1024, swz = sb ^ (((sb >> 9) & 1) << 5); R = (st >> 1) * 16 + swz / 64; C = (st & 1) * 32 + (swz % 64) / 2; }
__device__ __forceinline__ int perm32(int rho) { const int n = rho >> 4, i = rho & 15; return 8 * (i >> 2) + 4 * n + (i & 3); }

struct Unit { int pm, pn, e; const char* B; const int* list; int row0, cnt, orow0; };
__device__ __forceinline__ int a_row(const Unit& u, int r) {
    if (u.list) { int rr = u.row0 + r; rr = rr < u.cnt ? rr : u.cnt - 1; return u.list[rr]; }
    return u.row0 + r;
}

struct DenseOrder {
    int nM, nN, nwg, G, c, K; const char* Bt;
    __device__ void init(int M, int N, int K_, const void* Bt_, int G_, int c_) { nM = M / BM; nN = N / BM; nwg = nM * nN; G = G_; c = c_; K = K_; Bt = (const char*)Bt_; }
    __device__ bool next(int i, Unit& u) const {
        const long L = (long)i * G + c; if (L >= nwg) return false;
        int wgid = (int)L; { const int q = nwg / NXCD, r = nwg % NXCD, xcd = wgid % NXCD, off = wgid / NXCD; wgid = (xcd < r ? xcd * (q + 1) : r * (q + 1) + (xcd - r) * q) + off; }
        const int nig = WGM * nN, gid = wgid / nig, fm = gid * WGM, gsz = (nM - fm) < WGM ? (nM - fm) : WGM;
        u.pm = fm + ((wgid % nig) % gsz); u.pn = (wgid % nig) / gsz; u.e = 0;
        u.B = Bt + (size_t)u.pn * BM * K * 2; u.list = nullptr; u.row0 = u.pm * BM; u.cnt = 0; u.orow0 = u.pm * BM; return true;
    }
};

template <class Epi, class Sched, bool GATHER, bool FP8 = false>
__device__ __forceinline__ void gemm_phase(LAS unsigned char* lds, const bf16_t* Aptr, const int K, const Sched& S, const Epi& E, const int wv) {
    int tid_ = wv * 64 + lane_id(); asm volatile("" : "+v"(tid_));
    const int tid = tid_, wid = __builtin_amdgcn_readfirstlane(tid >> 6), lane = tid & 63, wr = wid >> 2, wc = wid & 3, fr = lane & 15, fq = lane >> 4;
    const int nt = K / BK;
    unsigned voffB[2], voffA[2];
#pragma unroll
    for (int i = 0; i < 2; ++i) { int sR, sC; stage_rc(tid * 16 + i * 8192, sR, sC); const int Rb = Epi::PERM ? ((sR & ~31) + perm32(sR & 31)) : sR; voffB[i] = (unsigned)(Rb * K + sC) * 2u; voffA[i] = (unsigned)(sR * K + sC) * 2u; }
    const size_t kstep = (size_t)(BK * 2);
    const size_t hstep = (size_t)HALF * K * 2;
    const unsigned ldsw = (unsigned)wid * 1024u;
    const int aoff = FP8 ? lds_byte(wr * 64 + fr, fq * 16) : lds_byte(wr * 64 + fr, fq * 8), boff = FP8 ? lds_byte(wc * 32 + fr, fq * 16) : lds_byte(wc * 32 + fr, fq * 8);
    const int aoff2 = FP8 ? lds_byte(wr * 64 + fr, fq * 16 + 8) : aoff + 1024, boff2 = FP8 ? lds_byte(wc * 32 + fr, fq * 16 + 8) : boff + 1024;
    const char* gA = (const char*)Aptr;
#define PG8_SA(b, h) (((b) * 2 + (h)) * HTB)
#define PG8_SB(b, h) ((4 + (b) * 2 + (h)) * HTB)
#define PG8_STAGE2(bufoff, gbase, o0, o1) do { \
        __builtin_amdgcn_global_load_lds((const unsigned*)((const char*)(gbase) + (o0)), (LAS unsigned*)(lds + (bufoff) + ldsw), 16, 0, 0); \
        __builtin_amdgcn_global_load_lds((const unsigned*)((const char*)(gbase) + (o1)), (LAS unsigned*)(lds + (bufoff) + ldsw + 8192), 16, 0, 0); } while (0)
#define PG8_STAGEB(bufoff, gbase) PG8_STAGE2(bufoff, gbase, voffB[0], voffB[1])
#define PG8_STAGEA(bufoff, gbase, h, useN) do { if constexpr (GATHER) { const u32x4 vo_ = *(const LAS u32x4*)(lds + STAGE_BYTES + ((((useN) ? ui + 1 : ui) & 1) ? 8192 : 0) + tid * 16); \
            if ((h) == 0) { PG8_STAGE2(bufoff, gbase, vo_.x, vo_.y); } else { PG8_STAGE2(bufoff, gbase, vo_.z, vo_.w); } } \
        else { const char* gb_ = (const char*)(gbase) + (size_t)((useN) ? nrow0 : crow0) * K * 2 + (h) * hstep; PG8_STAGE2(bufoff, gb_, voffA[0], voffA[1]); } } while (0)
#define PG8_LD16(p_) (*(const LAS u32x4*)(p_))
#define PG8_MK8(lo_, hi_) (v8i32_t){(int)lo_.x, (int)lo_.y, (int)lo_.z, (int)lo_.w, (int)hi_.x, (int)hi_.y, (int)hi_.z, (int)hi_.w}
#define PG8_LDA(dst, b, h) do { _Pragma("unroll") for (int m = 0; m < 4; ++m) { \
        if constexpr (FP8) { const u32x4 lo_ = PG8_LD16(lds + PG8_SA(b, h) + aoff + m * 2048), hi_ = PG8_LD16(lds + PG8_SA(b, h) + aoff2 + m * 2048); dst##8[m] = PG8_MK8(lo_, hi_); } \
        else { dst[m][0] = *(const LAS bf16x8*)(lds + PG8_SA(b, h) + aoff + m * 2048); dst[m][1] = *(const LAS bf16x8*)(lds + PG8_SA(b, h) + aoff2 + m * 2048); } } } while (0)
#define PG8_LDB(dst, b, h) do { _Pragma("unroll") for (int n = 0; n < 2; ++n) { \
        if constexpr (FP8) { const u32x4 lo_ = PG8_LD16(lds + PG8_SB(b, h) + boff + n * 2048), hi_ = PG8_LD16(lds + PG8_SB(b, h) + boff2 + n * 2048); dst##8[n] = PG8_MK8(lo_, hi_); } \
        else { dst[n][0] = *(const LAS bf16x8*)(lds + PG8_SB(b, h) + boff + n * 2048); dst[n][1] = *(const LAS bf16x8*)(lds + PG8_SB(b, h) + boff2 + n * 2048); } } } while (0)
#define PG8_MMA(ai, bj, At, Bt) do { __builtin_amdgcn_s_setprio(1); _Pragma("unroll") for (int m = 0; m < 4; ++m) _Pragma("unroll") for (int n = 0; n < 2; ++n) { \
        if constexpr (FP8) { asm("v_mfma_scale_f32_16x16x128_f8f6f4 %0, %1, %2, %0, %3, %4 op_sel_hi:[0,0,0]" : "+v"(acc[ai][bj][m][n]) : "v"(Bt##8[n]), "v"(At##8[m]), "v"(sc_w_), "v"(sc_a_)); } \
        else { _Pragma("unroll") for (int k = 0; k < 2; ++k) acc[ai][bj][m][n] = __builtin_amdgcn_mfma_f32_16x16x32_bf16(Bt[n][k], At[m][k], acc[ai][bj][m][n], 0, 0, 0); } } \
        __builtin_amdgcn_s_setprio(0); } while (0)
#define PG8_WAIT_V(n) asm volatile("s_waitcnt vmcnt(" #n ")" ::: "memory")
#define PG8_WAIT_L(n) asm volatile("s_waitcnt lgkmcnt(" #n ")" ::: "memory")
#define PG8_BAR __builtin_amdgcn_s_barrier()
#define PG8_SCHED __builtin_amdgcn_sched_barrier(0)
#define PG8_AOFFS(u, par) do { unsigned v_[2][2]; _Pragma("unroll") for (int i_ = 0; i_ < 2; ++i_) { int sR_, sC_; stage_rc(tid * 16 + i_ * 8192, sR_, sC_); _Pragma("unroll") for (int h_ = 0; h_ < 2; ++h_) v_[h_][i_] = (unsigned)(a_row(u, h_ * HALF + sR_) * K + sC_) * 2u; } \
        *(LAS u32x4*)(lds + STAGE_BYTES + (((par) & 1) ? 8192 : 0) + tid * 16) = (u32x4){v_[0][0], v_[0][1], v_[1][0], v_[1][1]}; } while (0)
    Unit cur, nxt; int ui = 0;
    if (!S.next(0, cur)) return;
    f32x4 acc[2][2][4][2];
#pragma unroll
    for (int a = 0; a < 2; ++a)
#pragma unroll
        for (int b = 0; b < 2; ++b)
#pragma unroll
            for (int m = 0; m < 4; ++m)
#pragma unroll
                for (int n = 0; n < 2; ++n) acc[a][b][m][n] = (f32x4){0.f, 0.f, 0.f, 0.f};
    const int sc_w_ = E.scale_w, sc_a_ = E.scale_a;
    bf16x8 At[4][2], B0[2][2], B1[2][2]; v8i32_t At8[4], B08[2], B18[2];
    int crow0 = cur.row0, nrow0 = cur.row0;
    if constexpr (GATHER) { PG8_AOFFS(cur, 0); }
    const char* cB = cur.B;
    PG8_STAGEB(PG8_SB(0, 0), cB); PG8_STAGEB(PG8_SB(0, 1), cB + hstep); PG8_STAGEA(PG8_SA(0, 0), gA, 0, false); PG8_STAGEA(PG8_SA(0, 1), gA, 1, false);
    if (wr == 1) PG8_BAR;
    PG8_WAIT_V(2); PG8_BAR;
    PG8_STAGEB(PG8_SB(1, 0), cB + kstep); PG8_STAGEA(PG8_SA(1, 0), gA + kstep, 0, false); PG8_STAGEB(PG8_SB(1, 1), cB + hstep + kstep);
    PG8_WAIT_V(6); PG8_BAR;
    for (;;) {
        const bool has_next = S.next(ui + 1, nxt);
        if constexpr (GATHER) { if (has_next) { PG8_AOFFS(nxt, ui + 1); } else { PG8_AOFFS(cur, ui + 1); } }
        nrow0 = has_next ? nxt.row0 : crow0;
        const char* nB = has_next ? nxt.B : cB;
#pragma clang loop unroll(disable)
        for (int t = 0; t < nt; t += 2) {
            const bool last = (t == nt - 2);
            const char* a1 = gA + (size_t)(t + 1) * kstep;
            const char* a2 = last ? gA : gA + (size_t)(t + 2) * kstep; const char* b2 = last ? nB : cB + (size_t)(t + 2) * kstep;
            const char* a3 = a2 + kstep; const char* b3 = b2 + kstep;
            PG8_LDB(B0, 0, 0); PG8_LDB(B1, 0, 1); PG8_SCHED; PG8_LDA(At, 0, 0); PG8_STAGEA(PG8_SA(1, 1), a1, 1, false);
            PG8_WAIT_V(8); PG8_WAIT_L(0); PG8_BAR; PG8_MMA(0, 0, At, B0); PG8_MMA(0, 1, At, B1); PG8_BAR; PG8_SCHED;
            PG8_LDA(At, 0, 1); PG8_STAGEB(PG8_SB(0, 0), b2); PG8_STAGEB(PG8_SB(0, 1), b2 + hstep); PG8_STAGEA(PG8_SA(0, 0), a2, 0, last);
            PG8_WAIT_V(8); PG8_WAIT_L(0); PG8_BAR; PG8_MMA(1, 0, At, B0); PG8_MMA(1, 1, At, B1); PG8_BAR; PG8_SCHED;
            PG8_LDB(B0, 1, 0); PG8_LDB(B1, 1, 1); PG8_SCHED; PG8_LDA(At, 1, 0); PG8_STAGEA(PG8_SA(0, 1), a2, 1, last);
            PG8_WAIT_V(8); PG8_WAIT_L(0); PG8_BAR; PG8_MMA(0, 0, At, B0); PG8_MMA(0, 1, At, B1); PG8_BAR; PG8_SCHED;
            PG8_LDA(At, 1, 1); PG8_STAGEB(PG8_SB(1, 0), b3); PG8_STAGEB(PG8_SB(1, 1), b3 + hstep); PG8_STAGEA(PG8_SA(1, 0), a3, 0, last);
            PG8_WAIT_V(8); PG8_WAIT_L(0); PG8_BAR; PG8_MMA(1, 0, At, B0); PG8_MMA(1, 1, At, B1); PG8_BAR; PG8_SCHED;
        }
        if (wr == 0) PG8_BAR;
        { Unit eu = cur; int el = lane;
          eu.pm = __builtin_amdgcn_readfirstlane(eu.pm); eu.pn = __builtin_amdgcn_readfirstlane(eu.pn); eu.e = __builtin_amdgcn_readfirstlane(eu.e);
          eu.cnt = __builtin_amdgcn_readfirstlane(eu.cnt); eu.orow0 = __builtin_amdgcn_readfirstlane(eu.orow0);
          asm volatile("" : "+s"(eu.pm), "+s"(eu.pn), "+s"(eu.e), "+s"(eu.cnt), "+s"(eu.orow0), "+v"(el));
          E(acc, eu, wr, wc, el & 15, el >> 4); }
        if (!has_next) break;
#pragma unroll
        for (int a = 0; a < 2; ++a)
#pragma unroll
            for (int b = 0; b < 2; ++b)
#pragma unroll
                for (int m = 0; m < 4; ++m)
#pragma unroll
                    for (int n = 0; n < 2; ++n) acc[a][b][m][n] = (f32x4){0.f, 0.f, 0.f, 0.f};
        cur = nxt; cB = nB; ++ui; crow0 = nrow0;
        if (wr == 1) PG8_BAR;
    }
    PG8_WAIT_V(0);
    PG8_BAR;
#undef PG8_SA
#undef PG8_SB
#undef PG8_STAGE2
#undef PG8_STAGEB
#undef PG8_STAGEA
#undef PG8_LDA
#undef PG8_LDB
#undef PG8_MMA
#undef PG8_LD16
#undef PG8_MK8
#undef PG8_WAIT_V
#undef PG8_WAIT_L
#undef PG8_BAR
#undef PG8_SCHED
#undef PG8_AOFFS
}
}

typedef f32x4 acc_t[2][2][4][2];
constexpr int SC_W = 0x79797979, SC_X = 0x7f7f7f7f, SC_H = 0x7b7b7b7b;

struct EpiProj {
    static constexpr bool PERM = true; static constexpr int scale_w = SC_W, scale_a = SC_X;
    bf16_t* P; const f32x2* r128; const f32x2* r64; float* kmsum; int pn_off;
    __device__ __forceinline__ void operator()(const acc_t& acc, const pg8::Unit& u, int wr, int wc, int fr, int fq) const {
        const int g = (u.pn + pn_off) * 4 + wc;
        const int mode = GRP[g][0], lo = GRP[g][1], ho = GRP[g][2], fb = GRP[g][3];
        if (mode == 4) return;
        const bool ksum = (lo >= C_CK && lo < C_CV);
        float cs[16];
#pragma unroll
        for (int k = 0; k < 16; ++k) cs[k] = 0.f;
#pragma unroll
        for (int ai = 0; ai < 2; ++ai)
#pragma unroll
            for (int m = 0; m < 4; ++m) {
                const int row = u.orow0 + ai * 128 + wr * 64 + m * 16 + fr;
                f32x4 l0 = acc[ai][0][m][0], l1 = acc[ai][0][m][1], h0 = acc[ai][1][m][0], h1 = acc[ai][1][m][1];
                if (mode == 1 || mode == 2) {
                    const f32x4* tb = (const f32x4*)((mode == 1 ? r128 + (size_t)row * 64 : r64 + (size_t)row * 32) + fb + 8 * fq);
                    const f32x4 t0 = tb[0], t1 = tb[1], t2 = tb[2], t3 = tb[3];
                    f32x4 nl0, nl1, nh0, nh1;
                    nl0[0] = l0[0] * t0[0] - h0[0] * t0[1]; nh0[0] = l0[0] * t0[1] + h0[0] * t0[0];
                    nl0[1] = l0[1] * t0[2] - h0[1] * t0[3]; nh0[1] = l0[1] * t0[3] + h0[1] * t0[2];
                    nl0[2] = l0[2] * t1[0] - h0[2] * t1[1]; nh0[2] = l0[2] * t1[1] + h0[2] * t1[0];
                    nl0[3] = l0[3] * t1[2] - h0[3] * t1[3]; nh0[3] = l0[3] * t1[3] + h0[3] * t1[2];
                    nl1[0] = l1[0] * t2[0] - h1[0] * t2[1]; nh1[0] = l1[0] * t2[1] + h1[0] * t2[0];
                    nl1[1] = l1[1] * t2[2] - h1[1] * t2[3]; nh1[1] = l1[1] * t2[3] + h1[1] * t2[2];
                    nl1[2] = l1[2] * t3[0] - h1[2] * t3[1]; nh1[2] = l1[2] * t3[1] + h1[2] * t3[0];
                    nl1[3] = l1[3] * t3[2] - h1[3] * t3[3]; nh1[3] = l1[3] * t3[3] + h1[3] * t3[2];
                    l0 = nl0; l1 = nl1; h0 = nh0; h1 = nh1;
                }
                if (ksum) {
#pragma unroll
                    for (int k = 0; k < 4; ++k) { cs[k] += l0[k]; cs[4 + k] += l1[k]; cs[8 + k] += h0[k]; cs[12 + k] += h1[k]; }
                }
                bf16_t* rp = P + (size_t)row * PP + lo + 8 * fq;
                u32x4 w; w.x = cvtpk(l0[0], l0[1]); w.y = cvtpk(l0[2], l0[3]); w.z = cvtpk(l1[0], l1[1]); w.w = cvtpk(l1[2], l1[3]);
                if (mode != 3) { *(u32x4*)rp = w; u32x4 v; v.x = cvtpk(h0[0], h0[1]); v.y = cvtpk(h0[2], h0[3]); v.z = cvtpk(h1[0], h1[1]); v.w = cvtpk(h1[2], h1[3]); *(u32x4*)(rp + ho) = v; }
                else if (fq < 2) *(u32x4*)rp = w;
            }
        if (ksum) {
#pragma unroll
            for (int k = 0; k < 16; ++k) { float v = cs[k]; v += shx_f<1>(v); v += shx_f<2>(v); v += shx_f<4>(v); v += shx_f<8>(v); cs[k] = v; }
            if (fr == 0) { float* dst = kmsum + (size_t)u.pm * 512 + (lo - C_CK) + 8 * fq;
#pragma unroll
                for (int k = 0; k < 8; ++k) { atomicAdd(dst + k, cs[k]); atomicAdd(dst + 64 + k, cs[8 + k]); } }
        }
    }
};

struct EpiOut {
    static constexpr bool PERM = true; static constexpr int scale_w = 0, scale_a = 0;
    const float* X; bf16_t* Y;
    __device__ __forceinline__ void operator()(const acc_t& acc, const pg8::Unit& u, int wr, int wc, int fr, int fq) const {
#pragma unroll
        for (int ai = 0; ai < 2; ++ai)
#pragma unroll
            for (int m = 0; m < 4; ++m) {
                const size_t off = (size_t)(u.orow0 + ai * 128 + wr * 64 + m * 16 + fr) * DM + u.pn * 256 + wc * 32 + 8 * fq;
#pragma unroll
                for (int bj = 0; bj < 2; ++bj) {
                    const f32x4 x0 = *(const f32x4*)(X + off + bj * 128), x1 = *(const f32x4*)(X + off + bj * 128 + 4);
                    const f32x4 a = x0 * ALPHA + acc[ai][bj][m][0], b = x1 * ALPHA + acc[ai][bj][m][1];
                    u32x4 w; w.x = cvtpk(a[0], a[1]); w.y = cvtpk(a[2], a[3]); w.z = cvtpk(b[0], b[1]); w.w = cvtpk(b[2], b[3]);
                    *(u32x4*)(Y + off + bj * 128) = w;
                }
            }
    }
};

struct EpiGU {
    static constexpr bool PERM = true; static constexpr int scale_w = SC_W, scale_a = SC_X;
    unsigned char* H;
    __device__ __forceinline__ void operator()(const acc_t& acc, const pg8::Unit& u, int wr, int wc, int fr, int fq) const {
#pragma unroll
        for (int ai = 0; ai < 2; ++ai)
#pragma unroll
            for (int m = 0; m < 4; ++m) {
                const size_t off = (size_t)(u.orow0 + ai * 128 + wr * 64 + m * 16 + fr) * DFF + u.pn * 128 + wc * 32 + 8 * fq;
                float hv[8];
#pragma unroll
                for (int n = 0; n < 2; ++n)
#pragma unroll
                    for (int j = 0; j < 4; ++j) { const float g = acc[ai][0][m][n][j], up = acc[ai][1][m][n][j]; hv[n * 4 + j] = 16.f * g * up / (1.f + __expf(-g)); }
                u32x2 w; w.x = pk4_fp8(hv[0], hv[1], hv[2], hv[3]); w.y = pk4_fp8(hv[4], hv[5], hv[6], hv[7]);
                *(u32x2*)(H + off) = w;
            }
    }
};

struct EpiDown {
    static constexpr bool PERM = true; static constexpr int scale_w = SC_W, scale_a = SC_H;
    bf16_t* Y; const float* sgate;
    __device__ __forceinline__ void operator()(const acc_t& acc, const pg8::Unit& u, int wr, int wc, int fr, int fq) const {
#pragma unroll
        for (int ai = 0; ai < 2; ++ai)
#pragma unroll
            for (int m = 0; m < 4; ++m) {
                const int r = ai * 128 + wr * 64 + m * 16 + fr, rk = u.pm * 256 + r;
                const float gt = rk < u.cnt ? sgate[u.e * 8192 + rk] : 0.f;
                const size_t off = (size_t)(u.orow0 + r) * DM + u.pn * 256 + wc * 32 + 8 * fq;
#pragma unroll
                for (int bj = 0; bj < 2; ++bj) {
                    const f32x4 a = acc[ai][bj][m][0] * gt, b = acc[ai][bj][m][1] * gt;
                    u32x4 w; w.x = cvtpk(a[0], a[1]); w.y = cvtpk(a[2], a[3]); w.z = cvtpk(b[0], b[1]); w.w = cvtpk(b[2], b[3]);
                    *(u32x4*)(Y + off + bj * 128) = w;
                }
            }
    }
};

struct MoeSched {
    const LAS int* tab; int G, c, K; const char* Bbase; size_t Bstride; const int* lists; int gather;
    __device__ bool next(int i, pg8::Unit& u) const {
#define RFL(x) __builtin_amdgcn_readfirstlane(x)
        const int L = i * G + c; if (L >= RFL(tab[32 + 16])) return false;
        int e = 0;
#pragma unroll
        for (int k = 1; k < 16; ++k) e += (L >= RFL(tab[32 + k])) ? 1 : 0;
        const int r = L - RFL(tab[32 + e]), cnt = RFL(tab[e]), mt = (cnt + 255) >> 8, nt = RFL(r / mt), mtile = r - nt * mt;
        u.pm = mtile; u.pn = nt; u.e = e; u.B = Bbase + (size_t)e * Bstride + (size_t)nt * 256 * K * 2;
        u.cnt = cnt; u.orow0 = RFL(tab[16 + e]) + mtile * 256;
        if (gather) { u.list = lists + e * 8192; u.row0 = mtile * 256; } else { u.list = nullptr; u.row0 = u.orow0; }
        return true;
#undef RFL
    }
};

struct FAState { f32x16 o[4]; float m, l; };
template <int NSTEP> struct KVRegs { u32x4 k[NSTEP]; u32x4 v[8]; };

__device__ __forceinline__ s16x4 vtr(const LAS char* p) { typedef short v4i16_t __attribute__((ext_vector_type(4)));
    return __builtin_bit_cast(s16x4, __builtin_amdgcn_ds_read_tr16_b64_v4i16((LAS v4i16_t*)p)); }

template <int NSTEP, class TF>
__device__ __forceinline__ void fa_load(KVRegs<NSTEP>& R, const bf16_t* P, const TF& tf, int t, int kcol, int vcol, int lane) {
#pragma unroll
    for (int i = 0; i < 8; ++i) { const bf16_t* rp = P + (size_t)tf.row(t, 4 * i + (lane >> 4)) * PP + (lane & 15) * 8; R.v[i] = *(const u32x4*)(rp + vcol);
        if constexpr (NSTEP == 8) R.k[i] = *(const u32x4*)(rp + kcol); }
    if constexpr (NSTEP == 4) {
#pragma unroll
        for (int i = 0; i < 4; ++i) R.k[i] = *(const u32x4*)(P + (size_t)tf.row(t, 8 * i + (lane >> 3)) * PP + kcol + (lane & 7) * 8); }
}

template <int NSTEP, bool QLDS, class TF>
__device__ __forceinline__ void fa_run(FAState& st, const bf16x8 (&q)[QLDS ? 1 : NSTEP], const LAS char* ql, const bf16_t* P, const TF& tf, int t_lo, int t_hi, LAS char* vl, float sc, int kcol, int vcol, int lane) {
    if (t_lo >= t_hi) return;
    constexpr int KP = NSTEP == 8 ? 272 : 144;
    const int hi = lane >> 5;
    const LAS char* vt = vl + (4 * hi + ((lane & 15) >> 2)) * VP + (16 * ((lane >> 4) & 1) + 4 * (lane & 3)) * 2;
    const LAS char* kt = vl + (lane & 31) * KP + hi * 16;
    KVRegs<NSTEP> R;
    fa_load<NSTEP>(R, P, tf, t_lo, kcol, vcol, lane);
    for (int t = t_lo; t < t_hi; ++t) {
        if constexpr (NSTEP == 8) {
#pragma unroll
            for (int i = 0; i < 8; ++i) *(LAS u32x4*)(vl + (4 * i + (lane >> 4)) * KP + (lane & 15) * 16) = R.k[i];
        } else {
#pragma unroll
            for (int i = 0; i < 4; ++i) *(LAS u32x4*)(vl + (8 * i + (lane >> 3)) * KP + (lane & 7) * 16) = R.k[i];
        }
        f32x16 s = {0.f, 0.f, 0.f, 0.f, 0.f, 0.f, 0.f, 0.f, 0.f, 0.f, 0.f, 0.f, 0.f, 0.f, 0.f, 0.f};
#pragma unroll
        for (int i = 0; i < NSTEP; ++i) { bf16x8 qf; if constexpr (QLDS) qf = *(const LAS bf16x8*)(ql + i * 1024 + lane * 16); else qf = q[i];
            const bf16x8 kf = *(const LAS bf16x8*)(kt + i * 32);
            s = __builtin_amdgcn_mfma_f32_32x32x16_bf16(kf, qf, s, 0, 0, 0); }
#pragma unroll
        for (int i = 0; i < 8; ++i) *(LAS u32x4*)(vl + (4 * i + (lane >> 4)) * VP + (lane & 15) * 16) = R.v[i];
        if (t + 1 < t_hi) fa_load<NSTEP>(R, P, tf, t + 1, kcol, vcol, lane);
        float tmax = NEG_INF;
#pragma unroll
        for (int r = 0; r < 16; ++r) { const float v = tf.valid(t, r, hi) ? s[r] * sc : NEG_INF; s[r] = v; tmax = fmaxf(tmax, v); }
        tmax = xmax32(tmax);
        const float mn = fmaxf(st.m, tmax), ms = (mn == NEG_INF) ? 0.f : mn;
        const float alpha = __builtin_amdgcn_exp2f(st.m - ms);
        float ps = 0.f;
#pragma unroll
        for (int r = 0; r < 16; ++r) { const float p = __builtin_amdgcn_exp2f(s[r] - ms); s[r] = p; ps += p; }
        st.l = st.l * alpha + ps; st.m = mn;
        if (!__all(alpha == 1.f)) {
#pragma unroll
            for (int d = 0; d < 4; ++d)
#pragma unroll
                for (int r = 0; r < 16; ++r) st.o[d][r] *= alpha;
        }
        u32x4 p0, p1;
        p0.x = cvtpk(s[0], s[1]); p0.y = cvtpk(s[2], s[3]); p0.z = cvtpk(s[4], s[5]); p0.w = cvtpk(s[6], s[7]);
        p1.x = cvtpk(s[8], s[9]); p1.y = cvtpk(s[10], s[11]); p1.z = cvtpk(s[12], s[13]); p1.w = cvtpk(s[14], s[15]);
        const bf16x8 pb0 = __builtin_bit_cast(bf16x8, p0), pb1 = __builtin_bit_cast(bf16x8, p1);
#pragma unroll
        for (int d = 0; d < 4; ++d) {
            const s16x4 a0 = vtr(vt + d * 64), a1 = vtr(vt + d * 64 + 8 * VP), b0 = vtr(vt + d * 64 + 16 * VP), b1 = vtr(vt + d * 64 + 24 * VP);
            const bf16x8 v0 = {a0[0], a0[1], a0[2], a0[3], a1[0], a1[1], a1[2], a1[3]}, v1 = {b0[0], b0[1], b0[2], b0[3], b1[0], b1[1], b1[2], b1[3]};
            st.o[d] = __builtin_amdgcn_mfma_f32_32x32x16_bf16(v0, pb0, st.o[d], 0, 0, 0);
            st.o[d] = __builtin_amdgcn_mfma_f32_32x32x16_bf16(v1, pb1, st.o[d], 0, 0, 0);
        }
    }
}
__device__ __forceinline__ void fa_init(FAState& st) {
#pragma unroll
    for (int d = 0; d < 4; ++d)
#pragma unroll
        for (int r = 0; r < 16; ++r) st.o[d][r] = 0.f;
    st.m = NEG_INF; st.l = 0.f;
}
__device__ __forceinline__ void fa_normalize(FAState& st) {
    const float lt = xsum32(st.l), inv = lt > 0.f ? 1.f / lt : 0.f;
#pragma unroll
    for (int d = 0; d < 4; ++d)
#pragma unroll
        for (int r = 0; r < 16; ++r) st.o[d][r] *= inv;
}
__device__ __forceinline__ void fa_store(const FAState& st, bf16_t* orow, int hi) {
#pragma unroll
    for (int d = 0; d < 4; ++d)
#pragma unroll
        for (int g = 0; g < 4; ++g) { u32x2 w; w.x = cvtpk(st.o[d][4 * g], st.o[d][4 * g + 1]); w.y = cvtpk(st.o[d][4 * g + 2], st.o[d][4 * g + 3]);
            *(u32x2*)(orow + 32 * d + 8 * g + 4 * hi) = w; }
}
template <int NSTEP>
__device__ __forceinline__ void fa_loadq(bf16x8 (&q)[NSTEP], const bf16_t* qrow, int hi, bool on) {
#pragma unroll
    for (int s = 0; s < NSTEP; ++s) { bf16x8 z = {0, 0, 0, 0, 0, 0, 0, 0}; q[s] = on ? *(const bf16x8*)(qrow + 16 * s + 8 * hi) : z; }
}

template <int NSTEP>
__device__ __forceinline__ void fa_loadq_lds(LAS char* ql, const bf16_t* qrow, int hi, bool on, int lane) {
#pragma unroll
    for (int s = 0; s < NSTEP; ++s) { bf16x8 z = {0, 0, 0, 0, 0, 0, 0, 0}; *(LAS bf16x8*)(ql + s * 1024 + lane * 16) = on ? *(const bf16x8*)(qrow + 16 * s + 8 * hi) : z; }
}
constexpr int QL_OFF = 8 * VT_BYTES, QL_BYTES = 8192, AUX_OFF = 147456;


constexpr int E1_STAGE = 32768, E1_NS = 3;
template <int NSTEP, class TF>
__device__ __forceinline__ void e1_run(FAState& st, const bf16x8 (&q)[NSTEP], const bf16_t* Kg, const bf16_t* Vg, const int nkt, LAS char* ring, const float sc, const int kc0, const TF& tf, const int lane, const int wid) {
    const int hi = lane >> 5, r32 = lane & 31;
    unsigned doff[2];
#pragma unroll
    for (int i = 0; i < 2; ++i) { const int row = 8 * wid + 4 * i + (lane >> 4), sw = ((row & 3) << 2) | ((row >> 2) & 3); doff[i] = (unsigned)(row * PP + 8 * ((lane & 15) ^ sw)) * 2u; }
    const unsigned ldsw = (unsigned)wid * 2048u;
#define E1_DMAK(kt_, stg_) do { const char* kb_ = (const char*)(Kg + (size_t)(kt_) * 64 * PP); LAS char* sb_ = ring + (stg_) * E1_STAGE + ldsw; \
        __builtin_amdgcn_global_load_lds((const unsigned*)(kb_ + doff[0]), (LAS unsigned*)(sb_), 16, 0, 0); __builtin_amdgcn_global_load_lds((const unsigned*)(kb_ + doff[1]), (LAS unsigned*)(sb_ + 1024), 16, 0, 0); } while (0)
#define E1_DMAV(kt_, stg_) do { const char* vb_ = (const char*)(Vg + (size_t)(kt_) * 64 * PP); LAS char* sb_ = ring + (stg_) * E1_STAGE + ldsw; \
        __builtin_amdgcn_global_load_lds((const unsigned*)(vb_ + doff[0]), (LAS unsigned*)(sb_ + 16384), 16, 0, 0); __builtin_amdgcn_global_load_lds((const unsigned*)(vb_ + doff[1]), (LAS unsigned*)(sb_ + 16384 + 1024), 16, 0, 0); } while (0)
    const int swk = ((r32 & 3) << 2) | ((r32 >> 2) & 3);
    const int koff0 = 256 * r32 + 16 * ((kc0 + hi) ^ swk);
    int voff0[2];
    { const int qq = (lane & 15) >> 2, p = lane & 3, cl = 2 * ((lane >> 4) & 1) + (p >> 1);
#pragma unroll
      for (int rd = 0; rd < 2; ++rd) voff0[rd] = 16384 + 256 * (8 * rd + 4 * hi + qq) + 16 * (4 * qq + (cl ^ ((2 * rd + hi) & 3))) + 8 * (p & 1); }
    if (nkt <= 0) return;
    E1_DMAK(0, 0);
    if (nkt > 1) E1_DMAK(1, 1);
    E1_DMAV(0, 0);
    const f32x16 zero16 = {0.f, 0.f, 0.f, 0.f, 0.f, 0.f, 0.f, 0.f, 0.f, 0.f, 0.f, 0.f, 0.f, 0.f, 0.f, 0.f};
    const bf16x8 zb = {0, 0, 0, 0, 0, 0, 0, 0};
    bf16x8 pb0 = zb, pb1 = zb, pb2 = zb, pb3 = zb;
    int pend = 0, stg = 0, stp = 2;
#pragma clang loop unroll(disable)
    for (int kt = 0; kt <= nkt; ++kt) {
        if (kt + 1 < nkt) asm volatile("s_waitcnt vmcnt(4)" ::: "memory"); else if (kt < nkt) asm volatile("s_waitcnt vmcnt(2)" ::: "memory"); else asm volatile("s_waitcnt vmcnt(0)" ::: "memory");
        __builtin_amdgcn_s_barrier();
        const int sn = stg + 1 >= E1_NS ? 0 : stg + 1;
        if (kt + 2 < nkt) E1_DMAK(kt + 2, stp);
        if (kt + 1 < nkt) E1_DMAV(kt + 1, sn);
        const LAS char* sb = ring + stg * E1_STAGE;
        const bool in = kt < nkt, act0 = in && tf.active(kt, 0), act1 = in && tf.active(kt, 1);
        int act = __builtin_amdgcn_readfirstlane((act0 || act1) ? 1 : 0); asm volatile("" : "+s"(act));
        f32x16 c0 = zero16, c1 = zero16;
        float tmax = NEG_INF, ms = 0.f, alpha = 1.f, ps = 0.f;
        bool mk0 = false, mk1 = false;
        auto mw = tf.fetch(in ? kt : 0);
        if (act) {
            mk0 = tf.masked(kt, 0); mk1 = tf.masked(kt, 1) || !act1;
            int kof = koff0; asm volatile("" : "+v"(kof));
#pragma unroll
            for (int i = 0; i < NSTEP; ++i) { const bf16x8 kf0 = *(const LAS bf16x8*)(sb + (kof ^ (32 * i))), kf1 = *(const LAS bf16x8*)(sb + 8192 + (kof ^ (32 * i)));
                c0 = __builtin_amdgcn_mfma_f32_32x32x16_bf16(kf0, q[i], c0, 0, 0, 0); c1 = __builtin_amdgcn_mfma_f32_32x32x16_bf16(kf1, q[i], c1, 0, 0, 0); }
        }
        const unsigned vb0 = (unsigned)(uintptr_t)(ring + stp * E1_STAGE) + (unsigned)voff0[0], vb1 = (unsigned)(uintptr_t)(ring + stp * E1_STAGE) + (unsigned)voff0[1];
        s16x4 ta[16], tb[16];
#define E1_TRP(j_, off_) do { const unsigned ad0 = vb0 ^ (64u * ((j_) >> 2)), ad1 = vb1 ^ (64u * ((j_) >> 2)); \
            asm volatile("ds_read_b64_tr_b16 %0, %1 offset:" #off_ : "=&v"(ta[j_]) : "v"(ad0) : "memory"); asm volatile("ds_read_b64_tr_b16 %0, %1 offset:" #off_ : "=&v"(tb[j_]) : "v"(ad1) : "memory"); } while (0)
#define E1_PVM(j_, pb_, w_) do { asm volatile("s_waitcnt lgkmcnt(" #w_ ")" ::: "memory"); __builtin_amdgcn_sched_barrier(0); \
            st.o[(j_) >> 2] = __builtin_amdgcn_mfma_f32_32x32x16_bf16((bf16x8){ta[j_][0], ta[j_][1], ta[j_][2], ta[j_][3], tb[j_][0], tb[j_][1], tb[j_][2], tb[j_][3]}, pb_, st.o[(j_) >> 2], 0, 0, 0); \
            __builtin_amdgcn_sched_barrier(0); } while (0)
#define E1_MAX0 do { if (mk0) { _Pragma("unroll") for (int r = 0; r < 16; ++r) { const float v = (act0 && tf.valid(kt, 0, r, hi, mw)) ? c0[r] : NEG_INF; c0[r] = v; tmax = fmaxf(tmax, v); } } \
            else { _Pragma("unroll") for (int r = 0; r < 16; ++r) { const float v = act0 ? c0[r] : NEG_INF; c0[r] = v; tmax = fmaxf(tmax, v); } } __builtin_amdgcn_sched_barrier(0); } while (0)
#define E1_MAX1 do { if (mk1) { _Pragma("unroll") for (int r = 0; r < 16; ++r) { const float v = (act1 && tf.valid(kt, 1, r, hi, mw)) ? c1[r] : NEG_INF; c1[r] = v; tmax = fmaxf(tmax, v); } } \
            else { _Pragma("unroll") for (int r = 0; r < 16; ++r) tmax = fmaxf(tmax, c1[r]); } __builtin_amdgcn_sched_barrier(0); } while (0)
#define E1_RED do { const swap2 rr = pl32swap(tmax, tmax); tmax = fmaxf(rr.a, rr.b) * sc; const float mn = fmaxf(st.m, tmax); ms = (mn == NEG_INF) ? 0.f : mn; \
            alpha = __builtin_amdgcn_exp2f(st.m - ms); st.m = mn; __builtin_amdgcn_sched_barrier(0); } while (0)
#define E1_EXP(c_, lo_) do { _Pragma("unroll") for (int r = (lo_); r < (lo_) + 8; ++r) { const float p = __builtin_amdgcn_exp2f(__builtin_fmaf(c_[r], sc, -ms)); c_[r] = p; ps += p; } __builtin_amdgcn_sched_barrier(0); } while (0)
        __builtin_amdgcn_sched_barrier(0);
        if (pend) { asm volatile("s_waitcnt lgkmcnt(0)" ::: "memory"); __builtin_amdgcn_sched_barrier(0); E1_TRP(0, 0); E1_TRP(1, 4096); E1_TRP(2, 8192); E1_TRP(3, 12288);
                    E1_PVM(0, pb0, 6); E1_TRP(4, 0); E1_PVM(1, pb1, 6); E1_TRP(5, 4096); }
        if (act) E1_MAX0;
        if (pend) { E1_PVM(2, pb2, 6); E1_TRP(6, 8192); E1_PVM(3, pb3, 6); E1_TRP(7, 12288); }
        if (act) E1_MAX1;
        if (pend) { E1_PVM(4, pb0, 6); E1_TRP(8, 0); E1_PVM(5, pb1, 6); E1_TRP(9, 4096); }
        if (act) E1_RED;
        if (pend) { E1_PVM(6, pb2, 6); E1_TRP(10, 8192); E1_PVM(7, pb3, 6); E1_TRP(11, 12288); }
        if (act) E1_EXP(c0, 0);
        if (pend) { E1_PVM(8, pb0, 6); E1_TRP(12, 0); E1_PVM(9, pb1, 6); E1_TRP(13, 4096); }
        if (act) E1_EXP(c0, 8);
        if (pend) { E1_PVM(10, pb2, 6); E1_TRP(14, 8192); E1_PVM(11, pb3, 6); E1_TRP(15, 12288); }
        if (act) E1_EXP(c1, 0);
        if (pend) { E1_PVM(12, pb0, 6); E1_PVM(13, pb1, 4); }
        if (act) E1_EXP(c1, 8);
        if (pend) { E1_PVM(14, pb2, 2); E1_PVM(15, pb3, 0); }
#undef E1_TRP
#undef E1_PVM
#undef E1_MAX0
#undef E1_MAX1
#undef E1_RED
#undef E1_EXP
        if (act) {
            st.l = st.l * alpha + ps;
            if (!__all(alpha == 1.f)) {
#pragma unroll
                for (int d = 0; d < 4; ++d)
#pragma unroll
                    for (int r = 0; r < 16; ++r) st.o[d][r] *= alpha;
            }
            u32x4 w0, w1, w2, w3;
            w0.x = cvtpk(c0[0], c0[1]); w0.y = cvtpk(c0[2], c0[3]); w0.z = cvtpk(c0[4], c0[5]); w0.w = cvtpk(c0[6], c0[7]);
            w1.x = cvtpk(c0[8], c0[9]); w1.y = cvtpk(c0[10], c0[11]); w1.z = cvtpk(c0[12], c0[13]); w1.w = cvtpk(c0[14], c0[15]);
            w2.x = cvtpk(c1[0], c1[1]); w2.y = cvtpk(c1[2], c1[3]); w2.z = cvtpk(c1[4], c1[5]); w2.w = cvtpk(c1[6], c1[7]);
            w3.x = cvtpk(c1[8], c1[9]); w3.y = cvtpk(c1[10], c1[11]); w3.z = cvtpk(c1[12], c1[13]); w3.w = cvtpk(c1[14], c1[15]);
            pb0 = __builtin_bit_cast(bf16x8, w0); pb1 = __builtin_bit_cast(bf16x8, w1); pb2 = __builtin_bit_cast(bf16x8, w2); pb3 = __builtin_bit_cast(bf16x8, w3);
        }
        asm volatile("s_waitcnt lgkmcnt(0)" ::: "memory");
        pend = act; stp = stg; stg = sn;
    }
#undef E1_DMAK
#undef E1_DMAV
}

struct Args {
    const float* x; const int* pos; const float* w_in; const float* w_out; const float* dlam; const float* dng; const float* lmg; const float* lmb;
    const float* rw; const float* rb; const float* wg; const float* wu; const float* wd; const float* lfg; const float* lfb;
    float* out; unsigned char* ws; int ph_lo, ph_hi;
};

struct TFDiffE1 { int q0, qpos;
    __device__ __forceinline__ bool active(int kt, int sub) const { return 64 * kt + 32 * sub <= q0; }
    __device__ __forceinline__ bool masked(int kt, int sub) const { return 64 * kt + 32 * sub == q0; }
    __device__ __forceinline__ int fetch(int) const { return 0; }
    __device__ __forceinline__ bool valid(int kt, int sub, int r, int hi, int) const { return 64 * kt + 32 * sub + crow(r, hi) <= qpos; } };

__device__ __forceinline__ void diff_unit(const Args& A, int layer, int b, int hh, int qb, LAS char* lds, const int wv) {
    int tid_ = wv * 64 + lane_id(); asm volatile("" : "+v"(tid_));
    const int tid = tid_, lane = tid & 63, wid = __builtin_amdgcn_readfirstlane(tid >> 6), sub = wid & 3, map = wid >> 2, hi = lane >> 5;
    const bf16_t* P = (const bf16_t*)(A.ws + WS_PROJ); bf16_t* MIX = (bf16_t*)(A.ws + WS_MIX);
    const int q0 = qb * 128 + sub * 32, qpos = q0 + (lane & 31), tok = b * SEQ + qpos;
    bf16x8 q[4]; fa_loadq<4>(q, P + (size_t)tok * PP + C_BQ + hh * 128 + map * 64, hi, true);
    FAState st; fa_init(st);
    TFDiffE1 tf{q0, qpos};
    e1_run<4>(st, q, P + (size_t)(b * SEQ) * PP + C_BK + hh * 128, P + (size_t)(b * SEQ) * PP + C_BV + hh * 128, 2 * qb + 2, lds, 0.125f * LOG2E, 8 * map, tf, lane, wid);
    __syncthreads();
    fa_normalize(st);
    LAS float* xch = (LAS float*)lds + sub * 4096;
    if (map == 1) {
#pragma unroll
        for (int d = 0; d < 4; ++d)
#pragma unroll
            for (int r = 0; r < 16; ++r) xch[(d * 16 + r) * 64 + lane] = st.o[d][r];
    }
    __syncthreads();
    if (map == 0) {
        int ly_ = layer; asm volatile("" : "+s"(ly_)); const int layer = ly_;
        const float* dl = A.dlam + layer * 256;
        const float s1 = wave_sum(dl[lane] * dl[64 + lane]), s2 = wave_sum(dl[128 + lane] * dl[192 + lane]);
        float c08 = 0.8f; asm volatile("" : "+v"(c08));
        const float lam_init = c08 - 0.6f * expf(-0.3f * (float)layer);
        const float lam = expf(s1) - expf(s2) + lam_init;
        float ss = 0.f;
#pragma unroll
        for (int d = 0; d < 4; ++d)
#pragma unroll
            for (int r = 0; r < 16; ++r) { const float o = st.o[d][r] - lam * xch[(d * 16 + r) * 64 + lane]; st.o[d][r] = o; ss += o * o; }
        ss = xsum32(ss);
        const float rinv = rsqrtf(ss * (1.f / 128.f) + LN_EPS) * (1.f - lam_init);
        const float* g = A.dng + layer * 128;
#pragma unroll
        for (int d = 0; d < 4; ++d)
#pragma unroll
            for (int r = 0; r < 16; ++r) st.o[d][r] *= rinv * g[32 * d + crow(r, hi)];
        fa_store(st, MIX + (size_t)tok * DM + 512 + hh * 128, hi);
    }
}

struct TFMobaE1 { int j, q0, qpos; unsigned selmask, wavemask;
    __device__ __forceinline__ bool active(int kt, int sub) const { const int n = kt >> 2; return n < j ? ((wavemask >> n) & 1u) != 0u : (64 * kt + 32 * sub <= q0); }
    __device__ __forceinline__ bool masked(int kt, int sub) const { const int n = kt >> 2; return n < j ? true : (64 * kt + 32 * sub == q0); }
    __device__ __forceinline__ int fetch(int) const { return 0; }
    __device__ __forceinline__ bool valid(int kt, int sub, int r, int hi, int) const { const int n = kt >> 2; return n < j ? ((selmask >> n) & 1u) != 0u : (64 * kt + 32 * sub + crow(r, hi) <= qpos); } };

__device__ __forceinline__ void moba_unit(const Args& A, int layer, int b, int hh, int j, LAS char* lds, const int wv) {
    int tid_ = wv * 64 + lane_id(); asm volatile("" : "+v"(tid_));
    const int tid = tid_, lane = tid & 63, wid = __builtin_amdgcn_readfirstlane(tid >> 6), hi = lane >> 5;
    const bf16_t* P = (const bf16_t*)(A.ws + WS_PROJ); bf16_t* MIX = (bf16_t*)(A.ws + WS_MIX);
    LAS float* km = (LAS float*)(lds + AUX_OFF);
    { const float* kms = (const float*)(A.ws + WS_CTL + KM_OFF) + (size_t)((layer * NB + b) * 16) * 512 + hh * 128;
      for (int i = tid; i < j * 128; i += 512) km[i] = kms[(size_t)(i >> 7) * 512 + (i & 127)] * (1.f / 256.f); }
    __syncthreads();
    const int q0 = j * 256 + wid * 32, qpos = q0 + (lane & 31), tok = b * SEQ + qpos;
    const bf16_t* qrow = P + (size_t)tok * PP + C_CQ + hh * 128;
    float gate[16];
#pragma unroll
    for (int n = 0; n < 16; ++n) gate[n] = 0.f;
#pragma unroll 1
    for (int c = 0; c < 16; ++c) {
        const u32x4 qw = *(const u32x4*)(qrow + 8 * c);
        const float qf[8] = {bflo(qw.x), bfhi(qw.x), bflo(qw.y), bfhi(qw.y), bflo(qw.z), bfhi(qw.z), bflo(qw.w), bfhi(qw.w)};
#pragma unroll
        for (int n = 0; n < 16; ++n) {
            const f32x4 k0 = *(const LAS f32x4*)(km + n * 128 + 8 * c), k1 = *(const LAS f32x4*)(km + n * 128 + 8 * c + 4);
            gate[n] += qf[0] * k0[0] + qf[1] * k0[1] + qf[2] * k0[2] + qf[3] * k0[3] + qf[4] * k1[0] + qf[5] * k1[1] + qf[6] * k1[2] + qf[7] * k1[3];
        }
    }
    unsigned selmask = 0u;
#pragma unroll
    for (int pick = 0; pick < 3; ++pick) {
        float best = NEG_INF; int bi = -1;
#pragma unroll
        for (int n = 0; n < 16; ++n) { const bool ok = (n < j) && !((selmask >> n) & 1u) && (gate[n] > best || bi < 0); if (ok) { best = gate[n]; bi = n; } }
        if (bi >= 0) selmask |= 1u << bi;
    }
    unsigned wavemask = 0u;
#pragma unroll
    for (int n = 0; n < 16; ++n) wavemask |= (__any((selmask >> n) & 1u) ? 1u : 0u) << n;
    bf16x8 q[8]; fa_loadq<8>(q, qrow, hi, true);
    FAState st; fa_init(st);
    TFMobaE1 tf{j, q0, qpos, selmask, wavemask};
    e1_run<8>(st, q, P + (size_t)(b * SEQ) * PP + C_CK + hh * 128, P + (size_t)(b * SEQ) * PP + C_CV + hh * 128, 4 * j + 4, lds, 0.08838834764831845f * LOG2E, 0, tf, lane, wid);
    fa_normalize(st);
    int tok2 = b * SEQ + j * 256 + wid * 32 + (lane_id() & 31); asm volatile("" : "+v"(tok2));
    fa_store(st, MIX + (size_t)tok2 * DM + 1024 + hh * 128, hi);
}

struct TFDil { int rowbase, base, stride, add, uq, want, q4;
    __device__ __forceinline__ int row(int t, int key) const { int u = base + 32 * t + key; u = u < 0 ? 0 : u; int s = stride * u + add; s = s > SEQ - 1 ? SEQ - 1 : s; return rowbase + s; }
    __device__ __forceinline__ bool valid(int t, int r, int hi) const { const int u = base + 32 * t + crow(r, hi), d = uq - u; return u >= 0 && d >= 0 && d <= 128 && (want < 0 || q4 == want); } };

__device__ __forceinline__ void dil_unit(const Args& A, int b, int hh, int blk, LAS char* lds, const int wv) {
    int tid_ = wv * 64 + lane_id(); asm volatile("" : "+v"(tid_));
    const int tid = tid_, lane = tid & 63, wid = __builtin_amdgcn_readfirstlane(tid >> 6), hi = lane >> 5;
    const bf16_t* P = (const bf16_t*)(A.ws + WS_PROJ); bf16_t* MIX = (bf16_t*)(A.ws + WS_MIX);
    const int t0 = blk * 256 + (wid >> 2) * 128, r4 = wid & 3, c = lane & 31, i = c & 7, q4 = c >> 3;
    const int tq = t0 + 16 * i + 4 * q4 + r4, tok = b * SEQ + tq;
    bf16x8 q[8]; fa_loadq<8>(q, P + (size_t)tok * PP + C_DQ + hh * 128, hi, true); const LAS char* ql = nullptr;
    FAState st; fa_init(st);
    const float sc = 0.08838834764831845f * LOG2E;
    LAS char* vl = lds + wid * VT_BYTES;
    const int kc = C_DK + hh * 128, vc = C_DV + hh * 128;
    { TFDil tf{b * SEQ, t0 - 128, 1, 0, tq, -1, q4}; fa_run<8, false>(st, q, ql, P, tf, t0 >= 128 ? 0 : 4, 8, vl, sc, kc, vc, lane); }
    { const int u0 = t0 >> 2; int ts = (128 - u0 + 31) >> 5; ts = ts < 0 ? 0 : ts;
      TFDil tf{b * SEQ, u0 - 128, 4, r4, u0 + 4 * i + q4, -1, q4}; fa_run<8, false>(st, q, ql, P, tf, ts, 5, vl, sc, kc, vc, lane); }
    { const int u0 = t0 >> 4; int ts = (128 - u0 + 31) >> 5; ts = ts < 0 ? 0 : ts;
      for (int w4 = 0; w4 < 4; ++w4) { TFDil tf{b * SEQ, u0 - 128, 16, r4 + 4 * w4, u0 + i, w4, q4}; fa_run<8, false>(st, q, ql, P, tf, ts, 5, vl, sc, kc, vc, lane); } }
    fa_normalize(st);
    fa_store(st, MIX + (size_t)tok * DM + 1536 + hh * 128, hi);
}

struct TFDsaE1 { const LAS char* mb;
    __device__ __forceinline__ bool active(int, int) const { return true; }
    __device__ __forceinline__ bool masked(int, int) const { return true; }
    __device__ __forceinline__ unsigned fetch(int kt) const { return *(const LAS unsigned*)(mb + 512 * kt); }
    __device__ __forceinline__ bool valid(int, int sub, int r, int, unsigned mw) const { return ((mw >> (8 * (r & 3) + 4 * sub + (r >> 2))) & 1u) != 0u; } };

__device__ __forceinline__ unsigned ord16(unsigned h) { return (h & 0x8000u) ? (~h & 0xffffu) : (h | 0x8000u); }

__device__ __forceinline__ void dsa_unit(const Args& A, int layer, int b, int t0, LAS char* lds, const int wv, const int level) {
    int tid_ = wv * 64 + lane_id(); asm volatile("" : "+v"(tid_));
    const int tid = tid_, lane = tid & 63, wid = __builtin_amdgcn_readfirstlane(tid >> 6), hi = lane >> 5;
    const bf16_t* P = (const bf16_t*)(A.ws + WS_PROJ); bf16_t* MIX = (bf16_t*)(A.ws + WS_MIX);
    LAS unsigned short* sco = (LAS unsigned short*)lds;
    LAS char* kst = lds + 131072;
    unsigned* dsac = (unsigned*)(A.ws + WS_CTL) + CW_DSAC + 128 * layer + 64 * b + (t0 >> 6);
    const int nkeys = t0 + 16, nchunk = (nkeys + 127) >> 7;
    {
        const int r = lane & 31;
        const int tokq = b * SEQ + t0 + 2 * wid + (r >> 4);
        bf16x8 aq[4];
#pragma unroll
        for (int s = 0; s < 4; ++s) aq[s] = *(const bf16x8*)(P + (size_t)tokq * PP + C_IQ + (r & 15) * 64 + 16 * s + 8 * hi);
        float wgt[16];
#pragma unroll
        for (int rr = 0; rr < 16; ++rr) { const int head = (rr & 3) + 8 * ((rr >> 2) & 1) + 4 * hi;
            wgt[rr] = bf2f(P[(size_t)(b * SEQ + t0 + 2 * wid + (rr >> 3)) * PP + C_IW + head]) * 0.03125f; }
        const int tlim = (t0 + 2 * wid + 1) >> 5;
        const int k0_ = tid >> 3, c0_ = tid & 7;
        const bf16_t* src = P + (size_t)(b * SEQ) * PP + C_IK + c0_ * 8;
        u32x4 pa0, pa1, pb0, pb1;
#define DSA_STAGE_LOAD(d0_, d1_, ch_) do { int ka_ = 128 * (ch_) + k0_, kb_ = ka_ + 64; ka_ = ka_ > SEQ - 1 ? SEQ - 1 : ka_; kb_ = kb_ > SEQ - 1 ? SEQ - 1 : kb_; \
            d0_ = *(const u32x4*)(src + (size_t)ka_ * PP); d1_ = *(const u32x4*)(src + (size_t)kb_ * PP); } while (0)
#define DSA_CHUNK(s0_, s1_, ch_) do { \
            __syncthreads(); \
            *(LAS u32x4*)(kst + k0_ * 128 + ((c0_ ^ ((k0_ >> 1) & 7)) << 4)) = s0_; \
            *(LAS u32x4*)(kst + (k0_ + 64) * 128 + ((c0_ ^ (((k0_ + 64) >> 1) & 7)) << 4)) = s1_; \
            __syncthreads(); \
            if ((ch_) + 2 < nchunk) DSA_STAGE_LOAD(s0_, s1_, (ch_) + 2); \
              \
            _Pragma("unroll") for (int th = 0; th < 4; th += 2) { \
                bf16x8 kb_[2][4]; \
                _Pragma("unroll") for (int tt = 0; tt < 2; ++tt) { const int kr = 32 * (th + tt) + r; \
                    _Pragma("unroll") for (int s = 0; s < 4; ++s) kb_[tt][s] = *(const LAS bf16x8*)(kst + kr * 128 + (((2 * s + hi) ^ ((kr >> 1) & 7)) << 4)); } \
                f32x16 ca_[2]; \
                _Pragma("unroll") for (int tt = 0; tt < 2; ++tt) ca_[tt] = (f32x16){0.f, 0.f, 0.f, 0.f, 0.f, 0.f, 0.f, 0.f, 0.f, 0.f, 0.f, 0.f, 0.f, 0.f, 0.f, 0.f}; \
                _Pragma("unroll") for (int s = 0; s < 4; ++s) \
                    _Pragma("unroll") for (int tt = 0; tt < 2; ++tt) ca_[tt] = __builtin_amdgcn_mfma_f32_32x32x16_bf16(aq[s], kb_[tt][s], ca_[tt], 0, 0, 0); \
                _Pragma("unroll") for (int tt = 0; tt < 2; ++tt) { \
                    float p0 = 0.f, p1 = 0.f; \
                    _Pragma("unroll") for (int rr = 0; rr < 8; ++rr) { const float r0_ = __builtin_amdgcn_fmed3f(ca_[tt][rr], 0.f, 3.0e38f), r1_ = __builtin_amdgcn_fmed3f(ca_[tt][8 + rr], 0.f, 3.0e38f);     \
                        p0 = __builtin_fmaf(wgt[rr], r0_, p0); p1 = __builtin_fmaf(wgt[8 + rr], r1_, p1); } \
                    const swap2 sw = pl32swap(p0, p1); const float tot = sw.a + sw.b; \
                    const _Float16 hsc = (_Float16)tot; \
                    sco[(2 * wid + hi) * 4096 + 32 * (4 * (ch_) + th + tt) + r] = __builtin_bit_cast(unsigned short, hsc); \
                } __builtin_amdgcn_sched_barrier(0); } } while (0)
        DSA_STAGE_LOAD(pa0, pa1, 0);
        if (nchunk > 1) DSA_STAGE_LOAD(pb0, pb1, 1);
        for (int ch = 0; ch < nchunk; ch += 2) {
            DSA_CHUNK(pa0, pa1, ch);
            if (ch + 1 < nchunk) DSA_CHUNK(pb0, pb1, ch + 1);
        }
#undef DSA_CHUNK
#undef DSA_STAGE_LOAD
    }
    __syncthreads();
    if (level < 2) return;
#pragma unroll 1
    for (int qq = 0; qq < 2; ++qq) {
        const int qi = 2 * wid + qq, tq = t0 + qi, nv = tq + 1;
        unsigned long long* bmq = (unsigned long long*)(A.ws + WS_BM) + (size_t)(b * SEQ + tq) * 64;
        if (nv <= 256) { const int cntl = tq >= lane ? ((tq - lane) >> 3) + 1 : 0;
            if (lane < 8) __hip_atomic_store(bmq + lane, (1ull << cntl) - 1ull, RLX_AGENT);
            continue; }
        const int nch = (nv + 511) >> 9;
        typedef unsigned short u16x2 __attribute__((ext_vector_type(2)));
        unsigned v[32];
#pragma unroll
        for (int i = 0; i < 8; ++i) {
            if (i < nch) { const u32x4 f = *(const LAS u32x4*)(sco + qi * 4096 + i * 512 + 8 * lane);
                const unsigned w[4] = {f.x, f.y, f.z, f.w};
#pragma unroll
                for (int d = 0; d < 4; ++d) { const int k0 = i * 512 + 8 * lane + 2 * d;
                    const unsigned neg = (w[d] >> 15) & 0x00010001u, ordw = w[d] ^ ((neg * 0xffffu) | 0x80008000u);
                    const unsigned vm = (k0 <= tq ? 0x0000ffffu : 0u) | (k0 + 1 <= tq ? 0xffff0000u : 0u);
                    v[i * 4 + d] = ordw & vm; } }
            else {
#pragma unroll
                for (int d = 0; d < 4; ++d) v[i * 4 + d] = 0u; }
        }
        const unsigned one2u = 0x00010001u;
        unsigned x = 0u;
        for (int bit = 15; bit >= 0; --bit) {
            const unsigned cand = x | (1u << bit), cm1 = (cand - 1u) * 0x00010001u;
            unsigned c2u = 0u;
#pragma unroll
            for (int i = 0; i < 8; ++i) if (i < nch) {
#pragma unroll
                for (int d = 0; d < 4; ++d) { unsigned t_; asm("v_pk_sub_u16 %0, %1, %2 clamp" : "=v"(t_) : "v"(v[i * 4 + d]), "v"(cm1)); asm("v_pk_min_u16 %0, %1, %2" : "=v"(t_) : "v"(t_), "v"(one2u)); asm("v_pk_add_u16 %0, %1, %2" : "=v"(c2u) : "v"(c2u), "v"(t_)); } }
            const int cl = (int)(c2u & 0xffffu) + (int)(c2u >> 16);
            int cnt = 0;
#pragma unroll
            for (int bb = 0; bb < 7; ++bb) cnt += __popcll(__ballot((cl >> bb) & 1)) << bb;
            if (cnt >= 256) x = cand;
            if (cnt == 256) break;
        }
        int gtot = 0;
        { const unsigned xs = x * 0x00010001u; unsigned c2u = 0u;
#pragma unroll
          for (int i = 0; i < 8; ++i) if (i < nch) {
#pragma unroll
              for (int d = 0; d < 4; ++d) { unsigned t_; asm("v_pk_sub_u16 %0, %1, %2 clamp" : "=v"(t_) : "v"(v[i * 4 + d]), "v"(xs)); asm("v_pk_min_u16 %0, %1, %2" : "=v"(t_) : "v"(t_), "v"(one2u)); asm("v_pk_add_u16 %0, %1, %2" : "=v"(c2u) : "v"(c2u), "v"(t_)); } }
          const int cg = (int)(c2u & 0xffffu) + (int)(c2u >> 16);
#pragma unroll
          for (int bb = 0; bb < 7; ++bb) gtot += __popcll(__ballot((cg >> bb) & 1)) << bb; }
        int be = gtot;
        unsigned long long myw = 0ull;
#pragma unroll
        for (int i = 0; i < 8; ++i) if (i < nch) {
#pragma unroll
            for (int e = 0; e < 8; ++e) {
                const unsigned vv = (e & 1) ? (v[i * 4 + (e >> 1)] >> 16) : (v[i * 4 + (e >> 1)] & 0xffffu);
                const bool g = vv > x, eq = vv == x;
                const unsigned long long mg = __ballot(g), me = __ballot(eq);
                const int pe = be + (int)__builtin_amdgcn_mbcnt_hi((unsigned)(me >> 32), __builtin_amdgcn_mbcnt_lo((unsigned)me, 0u));
                const unsigned long long wj = mg | __ballot(eq && pe < 256);
                if (lane == 8 * i + e) myw = wj;
                be += __popcll(me);
            }
        }
        if (lane < 8 * nch) __hip_atomic_store(bmq + lane, myw, RLX_AGENT);
    }
    asm volatile("s_waitcnt vmcnt(0)" ::: "memory");
    __syncthreads();
    if (tid == 0) __hip_atomic_fetch_add(dsac, 1u, RLX_AGENT);
}

__device__ __forceinline__ void dsa_att_unit(const Args& A, int layer, int b, int g, LAS char* lds, const int wv) {
    int tid_ = wv * 64 + lane_id(); asm volatile("" : "+v"(tid_));
    const int tid = tid_, lane = tid & 63, wid = __builtin_amdgcn_readfirstlane(tid >> 6), hi = lane >> 5;
    const bf16_t* P = (const bf16_t*)(A.ws + WS_PROJ); bf16_t* MIX = (bf16_t*)(A.ws + WS_MIX);
    unsigned* ctl = (unsigned*)(A.ws + WS_CTL);
    if (tid == 0) {
        unsigned sp = 0u;
        while (__hip_atomic_load(ctl + CW_DSAC + 128 * layer + 64 * b + g, RLX_AGENT) < 4u) { __builtin_amdgcn_s_sleep(2);
            if ((++sp & 255u) == 0u) { if (__hip_atomic_load(ctl + CW_BAR + XB_TMO, RLX_AGENT)) break; if (sp > XB_SPIN_CAP) { atomicAdd(ctl + CW_BAR + XB_TMO, 1u); break; } } }
    }
    __syncthreads();
    __builtin_amdgcn_fence(__ATOMIC_ACQUIRE, "agent");
    LAS char* bml = lds + E1_NS * E1_STAGE;
    { const int qi = tid >> 3, e = tid & 7; const unsigned long long* src = (const unsigned long long*)(A.ws + WS_BM) + (size_t)(b * SEQ + 64 * g + qi) * 64 + e;
      for (int i = 0; 8 * i <= g; ++i) { const unsigned long long w = src[8 * i];
#pragma unroll
          for (int j = 0; j < 8; ++j) *(LAS unsigned char*)(bml + 512 * (8 * i + j) + 8 * qi + e) = (unsigned char)(w >> (8 * j)); } }
    const int c = lane & 31, qi = 8 * wid + (c >> 2), tok = b * SEQ + 64 * g + qi;
    bf16x8 q[8]; fa_loadq<8>(q, P + (size_t)tok * PP + C_AQ + (c & 3) * 128, hi, true);
    FAState st; fa_init(st);
    TFDsaE1 tf{bml + 8 * qi + 4 * hi};
    __syncthreads();
    e1_run<8>(st, q, P + (size_t)(b * SEQ) * PP + C_AK, P + (size_t)(b * SEQ) * PP + C_AV, g + 1, lds, 0.08838834764831845f * LOG2E, 0, tf, lane, wid);
    fa_normalize(st);
    fa_store(st, MIX + (size_t)tok * DM + (c & 3) * 128, hi);
}

#define XB_XCNT(j)  (256  + 64 * (j))
#define XB_XSUB(j)  (1280 + 64 * (j))
#define XB_XGEN(j)  (2304 + 64 * (j))
#define XB_TOP      3328
#define XB_TOPGEN   3392
__device__ __forceinline__ unsigned xb_ld(unsigned* p)              { return __hip_atomic_load(p, __ATOMIC_RELAXED, __HIP_MEMORY_SCOPE_AGENT); }
__device__ __forceinline__ unsigned xb_add(unsigned* p, unsigned v) { return __hip_atomic_fetch_add(p, v, __ATOMIC_RELAXED, __HIP_MEMORY_SCOPE_AGENT); }
__device__ __forceinline__ unsigned xb_xcc_id() { return (unsigned)__builtin_amdgcn_s_getreg((3 << 11) | 20) & 0xFu; }
#define XB_SPIN(cond, bar) do { unsigned _sp = 0; while (cond) { __builtin_amdgcn_s_sleep(1); \
    if ((++_sp & 255u) == 0u) { if (xb_ld(&(bar)[XB_TMO])) break; if (_sp > XB_SPIN_CAP) { atomicAdd(&(bar)[XB_TMO], 1u); break; } } } } while (0)
struct XcdBarrier { unsigned* bar; unsigned x; volatile LAS unsigned* st; };
__device__ __forceinline__ XcdBarrier xcd_barrier_post(unsigned* bar, volatile LAS unsigned* st, bool leader) {
    XcdBarrier b; b.bar = bar; b.x = xb_xcc_id(); b.st = st;
    if (leader) (void)xb_add(&bar[XB_XCNT(b.x)], 1u);
    return b;
}
__device__ __forceinline__ void xcd_barrier_complete(unsigned* bar, unsigned x, unsigned& nloc, unsigned& nx) {
    const unsigned G = gridDim.x * gridDim.y * gridDim.z;
    unsigned sum, cnt, mine, sp = 0u;
    for (;;) {
        sum = 0u; cnt = 0u; mine = 0u;
#pragma unroll
        for (unsigned j = 0; j < 16; ++j) { const unsigned c = xb_ld(&bar[XB_XCNT(j)]); sum += c; cnt += (c > 0u) ? 1u : 0u; mine = (j == x) ? c : mine; }
        if (sum == G) break;
        __builtin_amdgcn_s_sleep(1);
        if ((++sp & 255u) == 0u) { if (xb_ld(&bar[XB_TMO])) break; if (sp > XB_SPIN_CAP) { atomicAdd(&bar[XB_TMO], 1u); break; } }
    }
    nloc = mine > 0u ? mine : 1u; nx = cnt > 0u ? cnt : 1u;
}
__device__ __forceinline__ void xcd_barrier(const XcdBarrier& b, bool leader) {
    asm volatile("s_waitcnt vmcnt(0)" ::: "memory");
    __syncthreads();
    if (leader) {
        unsigned* bar = b.bar;
        __builtin_amdgcn_s_waitcnt(0);
        unsigned nloc = b.st[0], nx = b.st[1];
        if (nloc == 0u) { xcd_barrier_complete(bar, b.x, nloc, nx); b.st[0] = nloc; b.st[1] = nx; }
        const unsigned old = xb_add(&bar[XB_XSUB(b.x)], 1u);
        const unsigned gen = old / nloc;
        if (old + 1u == (gen + 1u) * nloc) {
            __builtin_amdgcn_fence(__ATOMIC_RELEASE, "agent");
            asm volatile("s_waitcnt vmcnt(0)" ::: "memory");
            const unsigned og = xb_add(&bar[XB_TOP], 1u);
            const unsigned tg = og / nx;
            if (og + 1u == (tg + 1u) * nx) xb_add(&bar[XB_TOPGEN], 1u);
            else XB_SPIN(xb_ld(&bar[XB_TOPGEN]) == tg, bar);
            __builtin_amdgcn_fence(__ATOMIC_ACQUIRE, "agent");
            xb_add(&bar[XB_XGEN(b.x)], 1u);
            asm volatile("s_waitcnt vmcnt(0)" ::: "memory");
        } else {
            XB_SPIN(xb_ld(&bar[XB_XGEN(b.x)]) == gen, bar);
            __builtin_amdgcn_fence(__ATOMIC_ACQUIRE, "agent");
            asm volatile("s_waitcnt vmcnt(0)" ::: "memory");
        }
    }
    __syncthreads();
}

struct Frame { LAS unsigned char* lds; LAS int* lctl; int wave, vcu, G; };

constexpr int NT8 = 20, NTB = 6;
constexpr size_t WIN_LAYER = 26 * MiB, WIN_BF = 10 * MiB;
struct TItem { const float* W; bf16_t* WT; int ldw, ldt, ncols, f8; };
__device__ __forceinline__ TItem decode_item(const Args& A, int it) {
    constexpr int I_IN = 208 * 32, I_OUT = 64 * 32, I_G = 32 * 32, I_D = 64 * 16;
    constexpr int N_IN = DEPTH * I_IN, N_OUT = DEPTH * I_OUT, N_GU = DEPTH * NE * 2 * I_G;
    TItem t; int r = it;
    if (r < N_IN) { const int l = r / I_IN; r -= l * I_IN; const int cb = r >> 5, kb = r & 31, bj = (cb >> 2) & 1;
        const int tile = cb >> 3, wc = cb & 3, grp = tile * 4 + wc;
        const int mode = GRP[grp][0], lo = GRP[grp][1], ho = GRP[grp][2];
        int ncols = 32, n0 = lo + (bj ? ho : 0);
        if (mode == 4) { ncols = 0; n0 = 0; } else if (mode == 3) { ncols = bj ? 0 : 16; n0 = lo; }
        t.W = A.w_in + (size_t)l * DM * PP + (size_t)(kb * 64) * PP + n0; t.ldw = PP; t.ncols = ncols; t.ldt = DM;
        if (tile < NT8) { t.f8 = 1; t.WT = (bf16_t*)(A.ws + WS_WIN + l * WIN_LAYER + (size_t)(cb * 32) * DM + kb * 64); }
        else { t.f8 = 0; t.WT = (bf16_t*)(A.ws + WS_WIN + l * WIN_LAYER + WIN_BF) + (size_t)((cb - NT8 * 8) * 32) * DM + kb * 64; }
        return t; }
    r -= N_IN;
    if (r < N_OUT) { const int l = r / I_OUT; r -= l * I_OUT; const int nb = r >> 5, kb = r & 31;
        t.W = A.w_out + (size_t)l * DM * DM + (size_t)(kb * 64) * DM + nb * 32; t.ldw = DM; t.ncols = 32; t.f8 = 0;
        t.WT = (bf16_t*)(A.ws + WS_WOUT) + (size_t)l * DM * DM + (size_t)(nb * 32) * DM + kb * 64; t.ldt = DM; return t; }
    r -= N_OUT;
    if (r < N_GU) { const int le = r / (2 * I_G); r -= le * 2 * I_G; const int up = r / I_G; r -= up * I_G; const int nb = r >> 5, kb = r & 31, n0 = nb * 32;
        t.W = (up ? A.wu : A.wg) + (size_t)le * DM * DFF + (size_t)(kb * 64) * DFF + n0; t.ldw = DFF; t.ncols = 32; t.f8 = 1;
        t.WT = (bf16_t*)((unsigned char*)(A.ws + WS_WGU) + (size_t)le * DM * DM + (size_t)(256 * (n0 >> 7) + (n0 & 127) + 128 * up) * DM + kb * 64); t.ldt = DM; return t; }
    r -= N_GU;
    { const int le = r / I_D; r -= le * I_D; const int nb = r >> 4, kb = r & 15;
      t.W = A.wd + (size_t)le * DFF * DM + (size_t)(kb * 64) * DM + nb * 32; t.ldw = DM; t.ncols = 32; t.f8 = 1;
      t.WT = (bf16_t*)((unsigned char*)(A.ws + WS_WD) + (size_t)le * DM * DFF + (size_t)(nb * 32) * DFF + kb * 64); t.ldt = DFF; return t; }
}
__device__ __forceinline__ void titem_load(const TItem& t, f32x4 (&v)[8], int lane) {
    const int c4 = (lane & 7) * 4; const bool on = c4 < t.ncols;
#pragma unroll
    for (int i = 0; i < 8; ++i) { const float* p = t.W + (size_t)((lane >> 3) + 8 * i) * t.ldw + c4; v[i] = on ? *(const f32x4*)p : (f32x4){0.f, 0.f, 0.f, 0.f}; }
}
__device__ __forceinline__ void titem_store(const TItem& t, const f32x4 (&v)[8], LAS float* scr, int lane) {
    const int c4 = (lane & 7) * 4;
#pragma unroll
    for (int i = 0; i < 8; ++i) { LAS float* d = scr + ((lane >> 3) + 8 * i) * 33 + c4; d[0] = v[i][0]; d[1] = v[i][1]; d[2] = v[i][2]; d[3] = v[i][3]; }
    asm volatile("s_waitcnt lgkmcnt(0)" ::: "memory");
    const int c = lane & 7;
#pragma unroll
    for (int j = 0; j < 4; ++j) { const int n = (lane >> 3) + 8 * j; const LAS float* s = scr + (8 * c) * 33 + n;
        if (t.f8) { u32x2 o; o.x = pk4_fp8(64.f * s[0 * 33], 64.f * s[1 * 33], 64.f * s[2 * 33], 64.f * s[3 * 33]); o.y = pk4_fp8(64.f * s[4 * 33], 64.f * s[5 * 33], 64.f * s[6 * 33], 64.f * s[7 * 33]);
            *(u32x2*)((unsigned char*)t.WT + (size_t)n * t.ldt + 8 * c) = o; }
        else { u32x4 o; o.x = cvtpk(s[0 * 33], s[1 * 33]); o.y = cvtpk(s[2 * 33], s[3 * 33]); o.z = cvtpk(s[4 * 33], s[5 * 33]); o.w = cvtpk(s[6 * 33], s[7 * 33]);
            *(u32x4*)(t.WT + (size_t)n * t.ldt + 8 * c) = o; } }
    asm volatile("s_waitcnt lgkmcnt(0)" ::: "memory");
}

constexpr int FILL_E1 = 2048, FILL_E2 = FILL_E1 + 32768, FILL_E3 = FILL_E2 + 16384, FILL_E4 = FILL_E3 + 6656, FILL_E5 = FILL_E4 + 2048, FILL_E6 = FILL_E5 + 32768, FILL_E7 = FILL_E6 + 16384;
constexpr int CW_FILL = 2048, CW_DONE = 2112;
__device__ __forceinline__ int fill_to_item(int i) {
    constexpr int N_IN = 2 * 6656, N_OUT = 2 * 2048, N_GU = 2 * 32768;
    if (i < FILL_E1) return N_IN + i;
    if (i < FILL_E2) return N_IN + N_OUT + (i - FILL_E1);
    if (i < FILL_E3) return N_IN + N_OUT + N_GU + (i - FILL_E2);
    if (i < FILL_E4) return 6656 + (i - FILL_E3);
    if (i < FILL_E5) return N_IN + 2048 + (i - FILL_E4);
    if (i < FILL_E6) return N_IN + N_OUT + 32768 + (i - FILL_E5);
    return N_IN + N_OUT + N_GU + 16384 + (i - FILL_E6);
}
__device__ __forceinline__ void fill_run(const Args& A, Frame& F, int must, bool opp, int ph) {
    unsigned* ctl = (unsigned*)(A.ws + WS_CTL);
    unsigned* qh = ctl + CW_FILL; unsigned* done = ctl + CW_DONE + 64 * ph;
    const int lane = lane_id();
    __syncthreads();
    if (opp && F.wave == 0 && lane == 0) __hip_atomic_fetch_add(done, 1u, RLX_AGENT);
    LAS float* scr = (LAS float*)(F.lds + F.wave * 16384);
    for (;;) {
        __syncthreads();
        if (F.wave == 0 && lane == 0) {
            int base = FILL_E7; const int head = (int)__hip_atomic_load(qh, RLX_AGENT);
            bool go = head < FILL_E7;
            if (go && head >= must) go = opp && (int)__hip_atomic_load(done, RLX_AGENT) < F.G;
            if (go) base = (int)__hip_atomic_fetch_add(qh, 16u, RLX_AGENT);
            F.lctl[1] = base;
        }
        __syncthreads();
        const int base = F.lctl[1];
        if (base >= FILL_E7) break;
        const int i0 = base + 2 * F.wave, i1 = i0 + 1;
        f32x4 va[8], vb[8]; TItem ta, tb;
        if (i0 < FILL_E7) { ta = decode_item(A, fill_to_item(i0)); titem_load(ta, va, lane); }
        if (i1 < FILL_E7) { tb = decode_item(A, fill_to_item(i1)); titem_load(tb, vb, lane); }
#ifndef PROBE_FILL2
#define PROBE_FILL2 0
#endif
        if (i0 < FILL_E7) titem_store(ta, va, scr, lane);
        if (i1 < FILL_E7) titem_store(tb, vb, scr, lane);
        if (PROBE_FILL2) {
            if (i0 < FILL_E7) { titem_load(ta, va, lane); } if (i1 < FILL_E7) { titem_load(tb, vb, lane); }
            if (i0 < FILL_E7) titem_store(ta, va, scr, lane); if (i1 < FILL_E7) titem_store(tb, vb, scr, lane); }
    }
}

__device__ __forceinline__ void phase_prologue(const Args& A, Frame& F) {
    LAS float* scr = (LAS float*)(F.lds + F.wave * 16384);
    const int lane = lane_id(), tid = F.wave * 64 + lane;
    const int gw = F.vcu * 8 + F.wave, NGW = F.G * 8;
    constexpr int NITEMS = 208 * 32;
    {
        f32x4 va[8], vb[8]; TItem ta, tb;
        int it = gw;
        if (it < NITEMS) { ta = decode_item(A, it); titem_load(ta, va, lane); }
        while (it < NITEMS) {
            const int it1 = it + NGW, it2 = it + 2 * NGW;
            if (it1 < NITEMS) { tb = decode_item(A, it1); titem_load(tb, vb, lane); }
            titem_store(ta, va, scr, lane);
            if (it1 >= NITEMS) break;
            if (it2 < NITEMS) { ta = decode_item(A, it2); titem_load(ta, va, lane); }
            titem_store(tb, vb, scr, lane);
            it = it2;
        }
    }
    { const int gt = F.vcu * 512 + tid, NT = F.G * 512; bf16_t* XB = (bf16_t*)(A.ws + WS_XB);
      for (size_t i = gt; i < (size_t)T * DM / 8; i += NT) { const f32x4 a = ((const f32x4*)A.x)[2 * i], c = ((const f32x4*)A.x)[2 * i + 1];
          u32x4 w; w.x = cvtpk(a[0], a[1]); w.y = cvtpk(a[2], a[3]); w.z = cvtpk(c[0], c[1]); w.w = cvtpk(c[2], c[3]); ((u32x4*)XB)[i] = w;
          u32x2 q8; q8.x = pk4_fp8(a[0], a[1], a[2], a[3]); q8.y = pk4_fp8(c[0], c[1], c[2], c[3]); ((u32x2*)(A.ws + WS_XQ))[i] = q8; } }
    { const int gt = F.vcu * 512 + tid, NT = F.G * 512; f32x2* r128 = (f32x2*)(A.ws + WS_R128); f32x2* r64 = (f32x2*)(A.ws + WS_R64);
      for (int i = gt; i < T * 64; i += NT) { const int tk = i >> 6, f = i & 63; const float inv = powf(10000.f, -(float)(2 * f) / 128.f), ang = (float)A.pos[tk] * inv; r128[i] = (f32x2){cosf(ang), sinf(ang)}; }
      for (int i = gt; i < T * 32; i += NT) { const int tk = i >> 5, f = i & 31; const float inv = powf(10000.f, -(float)(2 * f) / 64.f), ang = (float)A.pos[tk] * inv; r64[i] = (f32x2){cosf(ang), sinf(ang)}; } }
}

__device__ __forceinline__ void phase_proj(const Args& A, Frame& F, int layer) {
    float* kms = (float*)(A.ws + WS_CTL + KM_OFF) + (size_t)layer * NB * 16 * 512;
    {
        pg8::DenseOrder S; S.init(T, NT8 * 256, DM / 2, A.ws + WS_WIN + layer * WIN_LAYER, F.G, (int)blockIdx.x);
        EpiProj E{(bf16_t*)(A.ws + WS_PROJ), (const f32x2*)(A.ws + WS_R128), (const f32x2*)(A.ws + WS_R64), kms, 0};
        pg8::gemm_phase<EpiProj, pg8::DenseOrder, false, true>(F.lds, (const bf16_t*)(A.ws + WS_XQ), DM / 2, S, E, F.wave);
    }
    {
        pg8::DenseOrder S; S.init(T, NTB * 256, DM, A.ws + WS_WIN + layer * WIN_LAYER + WIN_BF, F.G, (int)blockIdx.x);
        EpiProj E{(bf16_t*)(A.ws + WS_PROJ), (const f32x2*)(A.ws + WS_R128), (const f32x2*)(A.ws + WS_R64), kms, NT8};
        pg8::gemm_phase<EpiProj, pg8::DenseOrder, false, false>(F.lds, (const bf16_t*)(A.ws + WS_XB), DM, S, E, F.wave);
    }
}

constexpr int N_MIX_UNITS = 1152;
__device__ __forceinline__ void phase_mixers(const Args& A, Frame& F, int layer, int rep) {
    unsigned* qh = (unsigned*)(A.ws + WS_CTL) + CW_QUEUE + 64 * layer + 16 * rep;
    LAS char* lds = (LAS char*)F.lds;
    for (;;) {
        __syncthreads();
        if (F.wave == 0 && lane_id() == 0) F.lctl[0] = (int)__hip_atomic_fetch_add(qh, 1u, RLX_AGENT);
        __syncthreads();
        const int u = F.lctl[0];
        if (u >= N_MIX_UNITS) break;
#ifndef UNIT_ONLY
#define UNIT_ONLY (rep == 0 ? 31 : PROBE_MIX)
#endif
#ifndef PROBE_DSA
#define PROBE_DSA 3
#endif
#ifndef PROBE_MIX
#define PROBE_MIX 31
#endif
        int kind, p0, p1;
        if (u < 512)       { kind = 2; p0 = 31 - (u >> 4); p1 = u & 15; }
        else if (u < 640)  { kind = 3; p0 = u - 512; p1 = 0; }
        else if (u < 704)  { kind = 1; p0 = (u - 640) & 7; p1 = 15 - ((u - 640) >> 3); }
        else if (u < 768)  { kind = 0; p0 = (u - 704) & 7; p1 = 31 - ((u - 704) >> 3); }
        else if (u < 832)  { kind = 4; p0 = (u - 768) & 1; p1 = 63 - ((u - 768) >> 1); }
        else if (u < 864)  { kind = 1; p0 = (u - 832) & 7; p1 = 7 - ((u - 832) >> 3); }
        else if (u < 928)  { kind = 0; p0 = (u - 864) & 7; p1 = 23 - ((u - 864) >> 3); }
        else if (u < 960)  { kind = 1; p0 = (u - 928) & 7; p1 = 3 - ((u - 928) >> 3); }
        else { const int v = u - 960, L = 15 - v / 12, w = v % 12;
            if (w < 8) { kind = 0; p0 = w; p1 = L; } else { kind = 4; p0 = (w - 8) & 1; p1 = 2 * L + 1 - ((w - 8) >> 1); } }
        if (kind == 0) { if (UNIT_ONLY & 1) diff_unit(A, layer, p0 >> 2, p0 & 3, p1, lds, F.wave); continue; }
        if (kind == 1) { if (UNIT_ONLY & 2) moba_unit(A, layer, p0 >> 2, p0 & 3, p1, lds, F.wave); continue; }
        if (kind == 2) { if (UNIT_ONLY & 4) dsa_unit(A, layer, p1 >> 3, 128 * p0 + 16 * (p1 & 7), lds, F.wave, rep == 0 ? 3 : PROBE_DSA); continue; }
        if (kind == 4) { if (UNIT_ONLY & 16) dsa_att_unit(A, layer, p0, p1, lds, F.wave); continue; }
        { if (UNIT_ONLY & 8) dil_unit(A, p0 >> 6, (p0 >> 4) & 3, p0 & 15, lds, F.wave); }
    }
}

__device__ __forceinline__ void phase_outproj(const Args& A, Frame& F, int layer) {
    pg8::DenseOrder S; S.init(T, DM, DM, (const bf16_t*)(A.ws + WS_WOUT) + (size_t)layer * DM * DM, F.G, (int)blockIdx.x);
    EpiOut E{layer == 0 ? A.x : (const float*)(A.ws + WS_XF2), (bf16_t*)(A.ws + WS_Y1)};
    pg8::gemm_phase<EpiOut, pg8::DenseOrder, false>(F.lds, (const bf16_t*)(A.ws + WS_MIX), DM, S, E, F.wave);
}

__device__ __forceinline__ void route_token(const float (&lg)[16], const float* rb, LAS int* lcnt, float* tok_gate, int* tok_e, int* tok_rank, int tk, int lane) {
    float aff[16], sc[16];
#pragma unroll
    for (int e = 0; e < 16; ++e) { aff[e] = 1.f / (1.f + expf(-lg[e])); sc[e] = aff[e] + rb[e]; }
    float gbest = NEG_INF; int gi = 0;
#pragma unroll
    for (int k = 0; k < 4; ++k) {
        const float a = sc[4 * k], b = sc[4 * k + 1], c = sc[4 * k + 2], d = sc[4 * k + 3];
        const float m1 = fmaxf(fmaxf(a, b), fmaxf(c, d));
        const float lo1 = fminf(a, b), hi1 = fmaxf(a, b), lo2 = fminf(c, d), hi2 = fmaxf(c, d);
        const float m2 = fmaxf(fminf(hi1, hi2), fmaxf(lo1, lo2));
        const float gs = m1 + m2;
        if (gs > gbest) { gbest = gs; gi = k; }
    }
    float s0 = sc[0], s1 = sc[1], s2_ = sc[2], s3 = sc[3], a0 = aff[0], a1 = aff[1], a2 = aff[2], a3 = aff[3];
#pragma unroll
    for (int k = 1; k < 4; ++k) if (gi == k) { s0 = sc[4 * k]; s1 = sc[4 * k + 1]; s2_ = sc[4 * k + 2]; s3 = sc[4 * k + 3]; a0 = aff[4 * k]; a1 = aff[4 * k + 1]; a2 = aff[4 * k + 2]; a3 = aff[4 * k + 3]; }
    int i1 = 0; float b1 = s0;
    if (s1 > b1) { b1 = s1; i1 = 1; } if (s2_ > b1) { b1 = s2_; i1 = 2; } if (s3 > b1) { b1 = s3; i1 = 3; }
    int i2 = -1; float b2 = NEG_INF;
    if (i1 != 0 && (i2 < 0 || s0 > b2)) { b2 = s0; i2 = 0; }
    if (i1 != 1 && (i2 < 0 || s1 > b2)) { b2 = s1; i2 = 1; }
    if (i1 != 2 && (i2 < 0 || s2_ > b2)) { b2 = s2_; i2 = 2; }
    if (i1 != 3 && (i2 < 0 || s3 > b2)) { b2 = s3; i2 = 3; }
    const float g1 = i1 == 0 ? a0 : i1 == 1 ? a1 : i1 == 2 ? a2 : a3, g2 = i2 == 0 ? a0 : i2 == 1 ? a1 : i2 == 2 ? a2 : a3;
    if (lane == 0) {
        const int e1 = gi * 4 + i1, e2 = gi * 4 + i2; const float gsum = g1 + g2;
        const int r1 = __hip_atomic_fetch_add(lcnt + e1, 1, __ATOMIC_RELAXED, __HIP_MEMORY_SCOPE_WORKGROUP), r2 = __hip_atomic_fetch_add(lcnt + e2, 1, __ATOMIC_RELAXED, __HIP_MEMORY_SCOPE_WORKGROUP);
        tok_e[2 * tk] = e1; tok_e[2 * tk + 1] = e2; tok_rank[2 * tk] = r1; tok_rank[2 * tk + 1] = r2; tok_gate[2 * tk] = g1 / gsum; tok_gate[2 * tk + 1] = g2 / gsum;
    }
}
__device__ __forceinline__ void phase_ln1_router(const Args& A, Frame& F, int layer) {
    const int lane = lane_id(), tid = F.wave * 64 + lane;
    LAS f32x4* wl = (LAS f32x4*)F.lds;
    for (int i = tid; i < 4 * 8 * 4 * 64; i += 512) { const int l = i & 63, c = (i >> 6) & 3, j = (i >> 8) & 7, q = i >> 11; wl[i] = *(const f32x4*)(A.rw + (size_t)(256 * j + 4 * l + c) * 16 + 4 * q); }
    if (tid < 16) F.lctl[96 + tid] = 0;
    __syncthreads();
    bf16_t* Y1 = (bf16_t*)(A.ws + WS_Y1); unsigned char* X1Q = (unsigned char*)(A.ws + WS_X1B);
    int* tok_e = (int*)(A.ws + WS_ROUTE + RT_TOKE); int* tok_rank = (int*)(A.ws + WS_ROUTE + RT_RANK); float* tok_gate = (float*)(A.ws + WS_ROUTE + RT_TOKG);
    LAS int* lcnt = F.lctl + 96;
    const float* g = A.lmg + layer * DM; const float* bb = A.lmb + layer * DM;
    constexpr int TPW = 2;
    u32x2 nx[TPW][8];
    { const int tkf = (F.vcu * 8 + F.wave) * TPW;
#pragma unroll
      for (int u = 0; u < TPW; ++u)
#pragma unroll
          for (int j = 0; j < 8; ++j) nx[u][j] = *(const u32x2*)(Y1 + (size_t)(tkf + u) * DM + 256 * j + 4 * lane); }
#pragma clang loop unroll(disable)
    for (int tk0 = (F.vcu * 8 + F.wave) * TPW; tk0 < T; tk0 += F.G * 8 * TPW) {
        f32x4 v[TPW][8]; float mean[TPW], rstd[TPW];
#pragma unroll
        for (int u = 0; u < TPW; ++u)
#pragma unroll
            for (int j = 0; j < 8; ++j) { const u32x2 y = nx[u][j]; v[u][j][0] = bflo(y.x); v[u][j][1] = bfhi(y.x); v[u][j][2] = bflo(y.y); v[u][j][3] = bfhi(y.y); }
        { const int tkn = tk0 + F.G * 8 * TPW;
          if (tkn < T) {
#pragma unroll
              for (int u = 0; u < TPW; ++u)
#pragma unroll
                  for (int j = 0; j < 8; ++j) nx[u][j] = *(const u32x2*)(Y1 + (size_t)(tkn + u) * DM + 256 * j + 4 * lane); } }
#pragma unroll
        for (int u = 0; u < TPW; ++u) { float s = 0.f;
#pragma unroll
            for (int j = 0; j < 8; ++j) s += (v[u][j][0] + v[u][j][1]) + (v[u][j][2] + v[u][j][3]);
            mean[u] = s; }
#pragma unroll
        for (int u = 0; u < TPW; ++u) mean[u] = allsum(mean[u]);
#pragma unroll
        for (int u = 0; u < TPW; ++u) { mean[u] *= (1.f / DM); float s2 = 0.f;
#pragma unroll
            for (int j = 0; j < 8; ++j) { v[u][j] = v[u][j] - mean[u]; s2 += (v[u][j][0] * v[u][j][0] + v[u][j][1] * v[u][j][1]) + (v[u][j][2] * v[u][j][2] + v[u][j][3] * v[u][j][3]); }
            rstd[u] = s2; }
#pragma unroll
        for (int u = 0; u < TPW; ++u) rstd[u] = allsum(rstd[u]);
#pragma unroll
        for (int u = 0; u < TPW; ++u) rstd[u] = rsqrtf(rstd[u] * (1.f / DM) + LN_EPS);
        float lg[TPW][16];
#pragma unroll
        for (int u = 0; u < TPW; ++u)
#pragma unroll
            for (int e = 0; e < 16; ++e) lg[u][e] = 0.f;
#pragma unroll
        for (int j = 0; j < 8; ++j) {
            const f32x4 gg = *(const f32x4*)(g + 256 * j + 4 * lane), b4 = *(const f32x4*)(bb + 256 * j + 4 * lane);
#pragma unroll
            for (int u = 0; u < TPW; ++u) {
                v[u][j] = v[u][j] * rstd[u] * gg + b4;
                { u32x2 w; w.x = cvtpk(v[u][j][0], v[u][j][1]); w.y = cvtpk(v[u][j][2], v[u][j][3]); *(u32x2*)(Y1 + (size_t)(tk0 + u) * DM + 256 * j + 4 * lane) = w; }
                *(unsigned*)(X1Q + (size_t)(tk0 + u) * DM + 256 * j + 4 * lane) = pk4_fp8(v[u][j][0], v[u][j][1], v[u][j][2], v[u][j][3]);
            }
#pragma unroll
            for (int c = 0; c < 4; ++c) {
#pragma unroll
                for (int q = 0; q < 4; ++q) { const f32x4 w4 = wl[((q * 8 + j) * 4 + c) * 64 + lane];
#pragma unroll
                    for (int u = 0; u < TPW; ++u) { lg[u][4 * q] += v[u][j][c] * w4[0]; lg[u][4 * q + 1] += v[u][j][c] * w4[1]; lg[u][4 * q + 2] += v[u][j][c] * w4[2]; lg[u][4 * q + 3] += v[u][j][c] * w4[3]; } }
                __builtin_amdgcn_sched_barrier(0);
            }
        }
#pragma unroll
        for (int u = 0; u < TPW; ++u)
#pragma unroll
            for (int e = 0; e < 16; ++e) lg[u][e] = allsum(lg[u][e]);
#pragma unroll
        for (int u = 0; u < TPW; ++u) route_token(lg[u], A.rb, lcnt, tok_gate, tok_e, tok_rank, tk0 + u, lane);
    }
    __syncthreads();
    { const int t2 = F.wave * 64 + lane_id();
      if (t2 < 16) ((int*)(A.ws + WS_ROUTE + RT_BLK))[F.vcu * 16 + t2] = lcnt[t2]; }
}
__device__ __forceinline__ void route_finish(const Args& A, Frame& F, int layer) {
    const int lane = lane_id(), tid = F.wave * 64 + lane;
    LAS int* tab = (LAS int*)F.lds;
    const int* blk = (const int*)(A.ws + WS_ROUTE + RT_BLK);
    for (int i = tid; i < F.G * 16; i += 512) tab[i] = blk[i];
    __syncthreads();
    if (tid < 16) { int base = 0, tot = 0;
        for (int b = 0; b < F.G; ++b) { const int c = tab[b * 16 + tid]; tot += c; if (b < F.vcu) base += c; }
        F.lctl[112 + tid] = base;
        if (F.vcu == 0) ((unsigned*)(A.ws + WS_CTL) + CW_CNT + 64 * layer)[tid] = (unsigned)tot; }
    __syncthreads();
    const int* tok_e = (const int*)(A.ws + WS_ROUTE + RT_TOKE); int* tok_rank = (int*)(A.ws + WS_ROUTE + RT_RANK); const float* tok_gate = (const float*)(A.ws + WS_ROUTE + RT_TOKG);
    int* tok_list = (int*)(A.ws + WS_ROUTE + RT_LIST); float* sgate = (float*)(A.ws + WS_ROUTE + RT_GATE);
    if (tid < 64) {
        const int k = tid & 1, u = (tid >> 1) & 1, w = (tid >> 2) & 7, it = tid >> 5;
        const int tk = (F.vcu * 8 + w) * 2 + u + F.G * 16 * it;
        if (tk < T) { const int e = tok_e[2 * tk + k], r = F.lctl[112 + e] + tok_rank[2 * tk + k];
            tok_rank[2 * tk + k] = r; tok_list[e * 8192 + r] = tk; sgate[e * 8192 + r] = tok_gate[2 * tk + k]; } }
}

__device__ __forceinline__ void moe_table(const Args& A, Frame& F, int layer) {
    __syncthreads();
    if (F.wave == 0 && lane_id() == 0) {
        const unsigned* cnt = (const unsigned*)(A.ws + WS_CTL) + CW_CNT + 64 * layer;
        int ps = 0, ub = 0;
        for (int e = 0; e < 16; ++e) { const int c = (int)__hip_atomic_load(cnt + e, RLX_AGENT), mt = (c + 255) >> 8;
            F.lctl[16 + e] = c; F.lctl[32 + e] = ps; F.lctl[48 + e] = ub; ps += mt * 256; ub += mt * 8; }
        F.lctl[48 + 16] = ub;
    }
    __syncthreads();
}
__device__ __forceinline__ void phase_moe_gu(const Args& A, Frame& F, int layer) {
    moe_table(A, F, layer);
    MoeSched S{F.lctl + 16, F.G, F.vcu, DM / 2, (const char*)(A.ws + WS_WGU) + (size_t)layer * NE * DM * DM, (size_t)DM * DM, (const int*)(A.ws + WS_ROUTE + RT_LIST), 1};
    EpiGU E{(unsigned char*)(A.ws + WS_H)};
    pg8::gemm_phase<EpiGU, MoeSched, true, true>(F.lds, (const bf16_t*)(A.ws + WS_X1B), DM / 2, S, E, F.wave);
}
__device__ __forceinline__ void phase_moe_down(const Args& A, Frame& F, int layer) {
    moe_table(A, F, layer);
    MoeSched S{F.lctl + 16, F.G, F.vcu, DFF / 2, (const char*)(A.ws + WS_WD) + (size_t)layer * NE * DM * DFF, (size_t)DM * DFF, nullptr, 0};
    EpiDown E{(bf16_t*)(A.ws + WS_YS), (const float*)(A.ws + WS_ROUTE + RT_GATE)};
    pg8::gemm_phase<EpiDown, MoeSched, false, true>(F.lds, (const bf16_t*)(A.ws + WS_H), DFF / 2, S, E, F.wave);
}

__device__ __forceinline__ void phase_final_ln(const Args& A, Frame& F, int layer) {
    moe_table(A, F, layer);
    const int lane = lane_id();
    const bf16_t* X1 = (const bf16_t*)(A.ws + WS_Y1); const bf16_t* YS = (const bf16_t*)(A.ws + WS_YS);
    const int* tok_e = (const int*)(A.ws + WS_ROUTE + RT_TOKE); const int* tok_rank = (const int*)(A.ws + WS_ROUTE + RT_RANK);
    const float* g = A.lfg + layer * DM; const float* bb = A.lfb + layer * DM;
    float* XO = layer == DEPTH - 1 ? A.out : (float*)(A.ws + WS_XF2); bf16_t* XB = (bf16_t*)(A.ws + WS_XB);
    constexpr int TPW = 4;
    for (int tk0 = (F.vcu * 8 + F.wave) * TPW; tk0 < T; tk0 += F.G * 8 * TPW) {
        f32x4 v[TPW][8]; float mean[TPW], rstd[TPW]; size_t s1[TPW], s2[TPW];
#pragma unroll
        for (int u = 0; u < TPW; ++u) { const int tk = tk0 + u; const int e1 = tok_e[2 * tk], e2 = tok_e[2 * tk + 1];
            s1[u] = (size_t)(F.lctl[32 + e1] + tok_rank[2 * tk]) * DM; s2[u] = (size_t)(F.lctl[32 + e2] + tok_rank[2 * tk + 1]) * DM; }
#pragma unroll
        for (int u = 0; u < TPW; ++u) {
#pragma unroll
            for (int j = 0; j < 8; ++j) { const int k = 256 * j + 4 * lane; const u32x2 xw = *(const u32x2*)(X1 + (size_t)(tk0 + u) * DM + k); const float x[4] = {bflo(xw.x), bfhi(xw.x), bflo(xw.y), bfhi(xw.y)};
                const u32x2 ya = *(const u32x2*)(YS + s1[u] + k), yb = *(const u32x2*)(YS + s2[u] + k);
                v[u][j][0] = x[0] * ALPHA + (bflo(ya.x) + bflo(yb.x)); v[u][j][1] = x[1] * ALPHA + (bfhi(ya.x) + bfhi(yb.x));
                v[u][j][2] = x[2] * ALPHA + (bflo(ya.y) + bflo(yb.y)); v[u][j][3] = x[3] * ALPHA + (bfhi(ya.y) + bfhi(yb.y)); } }
#pragma unroll
        for (int u = 0; u < TPW; ++u) { float s = 0.f;
#pragma unroll
            for (int j = 0; j < 8; ++j) s += (v[u][j][0] + v[u][j][1]) + (v[u][j][2] + v[u][j][3]);
            mean[u] = s; }
#pragma unroll
        for (int u = 0; u < TPW; ++u) mean[u] = allsum(mean[u]);
#pragma unroll
        for (int u = 0; u < TPW; ++u) { mean[u] *= (1.f / DM); float q2 = 0.f;
#pragma unroll
            for (int j = 0; j < 8; ++j) { v[u][j] = v[u][j] - mean[u]; q2 += (v[u][j][0] * v[u][j][0] + v[u][j][1] * v[u][j][1]) + (v[u][j][2] * v[u][j][2] + v[u][j][3] * v[u][j][3]); }
            rstd[u] = q2; }
#pragma unroll
        for (int u = 0; u < TPW; ++u) rstd[u] = allsum(rstd[u]);
#pragma unroll
        for (int u = 0; u < TPW; ++u) rstd[u] = rsqrtf(rstd[u] * (1.f / DM) + LN_EPS);
#pragma unroll
        for (int j = 0; j < 8; ++j) { const int k = 256 * j + 4 * lane; const f32x4 gg = *(const f32x4*)(g + k), b4 = *(const f32x4*)(bb + k);
#pragma unroll
            for (int u = 0; u < TPW; ++u) { const f32x4 o = v[u][j] * rstd[u] * gg + b4; *(f32x4*)(XO + (size_t)(tk0 + u) * DM + k) = o;
                if (layer != DEPTH - 1) { u32x2 w; w.x = cvtpk(o[0], o[1]); w.y = cvtpk(o[2], o[3]); *(u32x2*)(XB + (size_t)(tk0 + u) * DM + k) = w;
                    *(unsigned*)(A.ws + WS_XQ + (size_t)(tk0 + u) * DM + k) = pk4_fp8(o[0], o[1], o[2], o[3]); } } }
    }
}

constexpr int N_PHASES = 1 + 7 * DEPTH;
__global__ void __launch_bounds__(512, 2) fwd(Args A_karg) {
    extern __shared__ __attribute__((aligned(16))) unsigned char lds_raw[];
    Frame F; F.lds = (LAS unsigned char*)lds_raw; F.lctl = (LAS int*)(F.lds + LDS_CTL_OFF);
    const int wave0 = __builtin_amdgcn_readfirstlane((int)threadIdx.x >> 6); F.wave = wave0;
    F.G = gridDim.x; { const int bx = blockIdx.x; F.vcu = (F.G % 8 == 0) ? (bx % 8) * (F.G / 8) + bx / 8 : bx; }
    const int vcu0 = F.vcu;
    const int lo = A_karg.ph_lo, hi = A_karg.ph_hi;
#ifndef USE_CG_SYNC
#define USE_CG_SYNC 0
#endif
    const bool leader = (wave0 == 0 && lane_id() == 0);
    if (leader) { F.lctl[8] = 0; F.lctl[9] = 0; }
    __syncthreads();
    XcdBarrier xbar; xbar.bar = nullptr; xbar.x = 0; xbar.st = nullptr;
    if (!USE_CG_SYNC && hi - lo > 1) xbar = xcd_barrier_post((unsigned*)(A_karg.ws + WS_CTL) + CW_BAR, (volatile LAS unsigned*)(F.lctl + 8), leader);
    typedef const __attribute__((address_space(4))) Args* kargp_t;
    int ph = lo, rep = 0;
    while (ph < hi) {
        kargp_t kp = (kargp_t)__builtin_amdgcn_kernarg_segment_ptr(); asm volatile("" : "+s"(kp));
        Args A; A.x = kp->x; A.pos = kp->pos; A.w_in = kp->w_in; A.w_out = kp->w_out; A.dlam = kp->dlam; A.dng = kp->dng; A.lmg = kp->lmg; A.lmb = kp->lmb; A.rw = kp->rw; A.rb = kp->rb;
        A.wg = kp->wg; A.wu = kp->wu; A.wd = kp->wd; A.lfg = kp->lfg; A.lfb = kp->lfb; A.out = kp->out; A.ws = kp->ws; A.ph_lo = lo; A.ph_hi = hi;
        { int w_ = wave0, c_ = vcu0, g_ = (int)gridDim.x; asm volatile("" : "+s"(w_), "+s"(c_), "+s"(g_)); F.wave = w_; F.vcu = c_; F.G = g_; }
#ifdef PHASE_ONLY
        { const int layer = ph & 1;
          if (PHASE_ONLY == 0) phase_prologue(A, F);
          if (PHASE_ONLY == 1) phase_proj(A, F, layer);
          if (PHASE_ONLY == 2) phase_mixers(A, F, layer, 0);
          if (PHASE_ONLY == 3) phase_outproj(A, F, layer);
          if (PHASE_ONLY == 4) phase_ln1_router(A, F, layer);
          if (PHASE_ONLY == 5) phase_moe_gu(A, F, layer);
          if (PHASE_ONLY == 6) phase_moe_down(A, F, layer);
          if (PHASE_ONLY == 7) phase_final_ln(A, F, layer);
          ++ph; continue; }
#endif
#ifndef PROBE_REP
#define PROBE_REP 0
#endif
        const int kind = ph == 0 ? 0 : 1 + (ph - 1) % 7;
        if (ph == 0) phase_prologue(A, F);
        else {
            const int layer = (ph - 1) / 7, k = (ph - 1) % 7;
            if (k == 0) phase_proj(A, F, layer);
            else if (k == 1) phase_mixers(A, F, layer, rep);
            else if (k == 2) phase_outproj(A, F, layer);
            else if (k == 3) phase_ln1_router(A, F, layer);
            else if (k == 4) phase_moe_gu(A, F, layer);
            else if (k == 5) phase_moe_down(A, F, layer);
            else phase_final_ln(A, F, layer);
        }
        if (ph > 0 && (ph - 1) % 7 == 3 && rep == 0) {
            if (USE_CG_SYNC) cg::this_grid().sync(); else xcd_barrier(xbar, wave0 == 0 && lane_id() == 0);
            route_finish(A, F, (ph - 1) / 7);
        }
        {
            const int k7 = ph == 0 ? -1 : (ph - 1) % 7, lay = ph == 0 ? 0 : (ph - 1) / 7;
            int must = 0; bool opp = false;
            if (k7 == 0) { opp = true; }
            else if (k7 == 1) { must = lay == 0 ? FILL_E1 : FILL_E5; opp = true; }
            else if (k7 == 3) { must = lay == 0 ? FILL_E2 : FILL_E6; }
            else if (k7 == 4) { must = lay == 0 ? FILL_E3 : FILL_E7; opp = true; }
            else if (k7 == 5) { opp = true; }
            else if (k7 == 6) { must = lay == 0 ? FILL_E4 : FILL_E7; }
            if (ph > 0 && rep == 0 && (must > 0 || opp)) fill_run(A, F, must, opp, ph);
        }
        if (rep == 0 && ((PROBE_REP >> kind) & 1)) rep = 1; else { rep = 0; ++ph; }
#ifndef PROBE_SYNC
#define PROBE_SYNC 1
#endif
        if (ph < hi) { for (int k_ = 0; k_ < PROBE_SYNC; ++k_) { if (USE_CG_SYNC) cg::this_grid().sync(); else xcd_barrier(xbar, wave0 == 0 && lane_id() == 0); } }
    }
}

extern "C" void kernel_launch(void* const* d_in, const int* in_sizes, int n_in, void* d_out, int out_size, void* d_ws, size_t ws_size, hipStream_t stream) {
    static int grid = 0;
    if (grid == 0) {
        if (n_in != 15 || ws_size < WS_END) { fprintf(stderr, "kernel_launch: unexpected inputs (n_in %d, ws %zu)\n", n_in, ws_size); grid = -1; return; }
        int dev = 0, cus = 0, per_cu = 0;
        hipGetDevice(&dev); hipDeviceGetAttribute(&cus, hipDeviceAttributeMultiprocessorCount, dev);
        hipFuncSetAttribute((const void*)fwd, hipFuncAttributeMaxDynamicSharedMemorySize, LDS_BYTES);
        hipOccupancyMaxActiveBlocksPerMultiprocessor(&per_cu, (const void*)fwd, 512, LDS_BYTES);
        if (per_cu < 1) { fprintf(stderr, "kernel_launch: occupancy query says %d blocks per CU\n", per_cu); per_cu = 1; }
        (void)hipGetLastError();
        grid = cus;
    }
    if (grid < 0) return;
    hipMemsetAsync((char*)d_ws + WS_CTL, 0, CTL_BYTES, stream);
    Args a{};
    a.x = (const float*)d_in[0]; a.pos = (const int*)d_in[1]; a.w_in = (const float*)d_in[2]; a.w_out = (const float*)d_in[3]; a.dlam = (const float*)d_in[4]; a.dng = (const float*)d_in[5];
    a.lmg = (const float*)d_in[6]; a.lmb = (const float*)d_in[7]; a.rw = (const float*)d_in[8]; a.rb = (const float*)d_in[9]; a.wg = (const float*)d_in[10]; a.wu = (const float*)d_in[11];
    a.wd = (const float*)d_in[12]; a.lfg = (const float*)d_in[13]; a.lfb = (const float*)d_in[14]; a.out = (float*)d_out; a.ws = (unsigned char*)d_ws;
#if MK_N_LAUNCHES == 1
    a.ph_lo = 0; a.ph_hi = N_PHASES;
    void* args[] = {&a};
    hipError_t e = hipLaunchCooperativeKernel((const void*)fwd, dim3(grid), dim3(512), args, LDS_BYTES, stream);
    if (e != hipSuccess) fprintf(stderr, "cooperative launch failed: %s (grid %d)\n", hipGetErrorString(e), grid);
#else
    for (int ph = 0; ph < N_PHASES; ++ph) { a.ph_lo = ph; a.ph_hi = ph + 1; hipLaunchKernelGGL(fwd, dim3(grid), dim3(512), LDS_BYTES, stream, a); }
#endif
}
```

```cpp
#include <hip/hip_runtime.h>
#include <hip/hip_cooperative_groups.h>
#include <cstdio>
#include <cstdint>
namespace cg = cooperative_groups;

#ifndef MK_N_LAUNCHES
#define MK_N_LAUNCHES 1
#endif

#define LAS __attribute__((address_space(3)))
typedef unsigned short bf16_t;
typedef short bf16x8 __attribute__((ext_vector_type(8)));
typedef short s16x4 __attribute__((ext_vector_type(4)));
typedef float f32x2 __attribute__((ext_vector_type(2)));
typedef float f32x4 __attribute__((ext_vector_type(4)));
typedef float f32x16 __attribute__((ext_vector_type(16)));
typedef unsigned u32x2 __attribute__((ext_vector_type(2)));
typedef unsigned u32x4 __attribute__((ext_vector_type(4)));
typedef __bf16 bf16x2_t __attribute__((ext_vector_type(2)));
typedef int v8i32_t __attribute__((ext_vector_type(8)));

constexpr int NB = 2, SEQ = 4096, T = NB * SEQ, DM = 2048, DEPTH = 2;
constexpr int PP = 6480;
constexpr int NPROJ = 6656;
constexpr int C_AQ = 0, C_AK = 512, C_AV = 640, C_IQ = 768, C_IK = 1792, C_IW = 1856, C_BQ = 1872, C_BK = 2384, C_BV = 2896,
              C_CQ = 3408, C_CK = 3920, C_CV = 4432, C_DQ = 4944, C_DK = 5456, C_DV = 5968;
constexpr int NE = 16, DFF = 1024, HROWS = 20480;
constexpr float LN_EPS = 1e-5f;
constexpr float ALPHA = 1.41421356237309515f;
constexpr float LOG2E = 1.4426950408889634f;
constexpr float NEG_INF = -__builtin_huge_valf();

constexpr size_t MiB = 1u << 20;
constexpr size_t WS_CTL = 0, CTL_BYTES = 1 * MiB;
constexpr size_t WS_WIN = 1 * MiB;
constexpr size_t WS_WOUT = 53 * MiB;
constexpr size_t WS_WGU = 69 * MiB;
constexpr size_t WS_WD = 325 * MiB;
constexpr size_t WS_XB = 453 * MiB;
constexpr size_t WS_PROJ = 485 * MiB;
constexpr size_t WS_MIX = 587 * MiB;
constexpr size_t WS_Y1 = 619 * MiB;
constexpr size_t WS_XF2 = 683 * MiB;
constexpr size_t WS_X1B = 747 * MiB;
constexpr size_t WS_XQ = 763 * MiB;
constexpr size_t WS_H = 780 * MiB;
constexpr size_t WS_YS = 820 * MiB;
constexpr size_t WS_R128 = 900 * MiB;
constexpr size_t WS_R64 = 904 * MiB;
constexpr size_t WS_ROUTE = 906 * MiB;
constexpr size_t WS_BM = 910 * MiB;
constexpr size_t WS_END = 914 * MiB;
constexpr size_t RT_TOKE = 0, RT_RANK = 65536, RT_LIST = 131072, RT_GATE = 131072 + 524288;
constexpr size_t RT_TOKG = 2 * MiB, RT_BLK = 2 * MiB + 65536;
constexpr int CW_QUEUE = 64;
constexpr int CW_CNT = 1024;
constexpr int CW_BAR = 4096;
#define XB_TMO      128
#define XB_SPIN_CAP (1u << 22)
constexpr int CW_DSAC = 8192;
constexpr size_t KM_OFF = 262144;

constexpr int LDS_CTL_OFF = 155648;
constexpr int LDS_BYTES = 156672;
constexpr int VP = 320;
constexpr int VT_BYTES = 32 * VP;

__constant__ short GRP[104][4] = {
{1,0,64,0}, {1,32,64,32}, {1,128,64,0}, {1,160,64,32}, {1,256,64,0}, {1,288,64,32}, {1,384,64,0}, {1,416,64,32}, {1,512,64,0}, {1,544,64,32}, {0,640,32,0}, {0,704,32,0}, {2,768,32,0}, {2,832,32,0}, {2,896,32,0}, {2,960,32,0}, {2,1024,32,0}, {2,1088,32,0}, {2,1152,32,0}, {2,1216,32,0}, {2,1280,32,0}, {2,1344,32,0}, {2,1408,32,0}, {2,1472,32,0}, {2,1536,32,0}, {2,1600,32,0}, {2,1664,32,0}, {2,1728,32,0}, {2,1792,32,0}, {3,1856,0,0}, {1,3408,64,0}, {1,3440,64,32}, {1,3536,64,0}, {1,3568,64,32}, {1,3664,64,0}, {1,3696,64,32}, {1,3792,64,0}, {1,3824,64,32}, {1,3920,64,0}, {1,3952,64,32}, {1,4048,64,0}, {1,4080,64,32}, {1,4176,64,0}, {1,4208,64,32}, {1,4304,64,0}, {1,4336,64,32}, {0,4432,32,0}, {0,4496,32,0}, {0,4560,32,0}, {0,4624,32,0}, {0,4688,32,0}, {0,4752,32,0}, {0,4816,32,0}, {0,4880,32,0}, {1,4944,64,0}, {1,4976,64,32}, {1,5072,64,0}, {1,5104,64,32}, {1,5200,64,0}, {1,5232,64,32}, {1,5328,64,0}, {1,5360,64,32}, {1,5456,64,0}, {1,5488,64,32}, {1,5584,64,0}, {1,5616,64,32}, {1,5712,64,0}, {1,5744,64,32}, {1,5840,64,0}, {1,5872,64,32}, {0,5968,32,0}, {0,6032,32,0}, {0,6096,32,0}, {0,6160,32,0}, {0,6224,32,0}, {0,6288,32,0}, {0,6352,32,0}, {0,6416,32,0}, {4,0,0,0}, {4,0,0,0}, {2,1872,32,0}, {2,1936,32,0}, {2,2000,32,0}, {2,2064,32,0}, {2,2128,32,0}, {2,2192,32,0}, {2,2256,32,0}, {2,2320,32,0}, {2,2384,32,0}, {2,2448,32,0}, {2,2512,32,0}, {2,2576,32,0}, {2,2640,32,0}, {2,2704,32,0}, {2,2768,32,0}, {2,2832,32,0}, {0,2896,32,0}, {0,2960,32,0}, {0,3024,32,0}, {0,3088,32,0}, {0,3152,32,0}, {0,3216,32,0}, {0,3280,32,0}, {0,3344,32,0}};

__device__ __forceinline__ unsigned cvtpk(float lo, float hi) { f32x2 v = {lo, hi}; bf16x2_t b = __builtin_convertvector(v, bf16x2_t); return __builtin_bit_cast(unsigned, b); }
__device__ __forceinline__ unsigned pk4_fp8(float a, float b, float c, float d) { unsigned w = 0u; w = __builtin_amdgcn_cvt_pk_fp8_f32(a, b, w, false); w = __builtin_amdgcn_cvt_pk_fp8_f32(c, d, w, true); return w; }
__device__ __forceinline__ float bf2f(unsigned short b) { return __builtin_bit_cast(float, (unsigned)b << 16); }
__device__ __forceinline__ float bflo(unsigned w) { return __builtin_bit_cast(float, w << 16); }
__device__ __forceinline__ float bfhi(unsigned w) { return __builtin_bit_cast(float, w & 0xffff0000u); }
__device__ __forceinline__ int crow(int r, int hi) { return (r & 3) + 8 * (r >> 2) + 4 * hi; }
#define RLX_AGENT __ATOMIC_RELAXED, __HIP_MEMORY_SCOPE_AGENT
__device__ __forceinline__ int lane_id() { int l; asm volatile("v_mbcnt_lo_u32_b32 %0, -1, 0\n\tv_mbcnt_hi_u32_b32 %0, -1, %0" : "=v"(l)); return l; }

struct swap2 { float a, b; };
__device__ __forceinline__ swap2 pl32swap(float x, float y) { const auto r = __builtin_amdgcn_permlane32_swap(__float_as_uint(x), __float_as_uint(y), false, false); const unsigned u0 = r[0], u1 = r[1]; swap2 o; o.a = __uint_as_float(u0); o.b = __uint_as_float(u1); return o; }
template <int M> __device__ __forceinline__ float shx_f(float v) { return __int_as_float(__builtin_amdgcn_ds_swizzle(__float_as_int(v), (M << 10) | 0x1f)); }
__device__ __forceinline__ float xsum32(float v) { const swap2 r = pl32swap(v, v); return r.a + r.b; }
__device__ __forceinline__ float xmax32(float v) { const swap2 r = pl32swap(v, v); return fmaxf(r.a, r.b); }
__device__ __forceinline__ int wave_isum(int v) {
    v += __builtin_amdgcn_update_dpp(0, v, 0xB1, 0xF, 0xF, true);
    v += __builtin_amdgcn_update_dpp(0, v, 0x4E, 0xF, 0xF, true);
    v += __builtin_amdgcn_update_dpp(0, v, 0x141, 0xF, 0xF, true);
    v += __builtin_amdgcn_update_dpp(0, v, 0x140, 0xF, 0xF, true);
    return __builtin_amdgcn_readlane(v, 0) + __builtin_amdgcn_readlane(v, 16) + __builtin_amdgcn_readlane(v, 32) + __builtin_amdgcn_readlane(v, 48);
}
__device__ __forceinline__ float allsum(float v) { v += shx_f<1>(v); v += shx_f<2>(v); v += shx_f<4>(v); v += shx_f<8>(v); v += shx_f<16>(v); return xsum32(v); }
__device__ __forceinline__ float wave_sum(float v) { return allsum(v); }
__device__ __forceinline__ swap2 pl16swap(float x, float y) { const auto r = __builtin_amdgcn_permlane16_swap(__float_as_uint(x), __float_as_uint(y), false, false); const unsigned u0 = r[0], u1 = r[1]; swap2 o; o.a = __uint_as_float(u0); o.b = __uint_as_float(u1); return o; }

namespace pg8 {
constexpr int BM = 256, BK = 64, HALF = 128, HTB = HALF * BK * 2, STAGE_BYTES = 8 * HTB, NXCD = 8, WGM = 8;
__device__ __forceinline__ int lds_byte(int r, int c) { const int st = (r >> 4) * 2 + (c >> 5), rr = r & 15, cc = c & 31, ob = rr * 64 + cc * 2; return st * 1024 + (ob ^ (((ob >> 9) & 1) << 5)); }
__device__ __forceinline__ void stage_rc(int b, int& R, int& C) { const int st = b / 1024, sb = b % 1024, swz = sb ^ (((sb >> 9) & 1) << 5); R = (st >> 1) * 16 + swz / 64; C = (st & 1) * 32 + (swz % 64) / 2; }
__device__ __forceinline__ int perm32(int rho) { const int n = rho >> 4, i = rho & 15; return 8 * (i >> 2) + 4 * n + (i & 3); }

struct Unit { int pm, pn, e; const char* B; const int* list; int row0, cnt, orow0; };
__device__ __forceinline__ int a_row(const Unit& u, int r) {
    if (u.list) { int rr = u.row0 + r; rr = rr < u.cnt ? rr : u.cnt - 1; return u.list[rr]; }
    return u.row0 + r;
}

struct DenseOrder {
    int nM, nN, nwg, G, c, K; const char* Bt;
    __device__ void init(int M, int N, int K_, const void* Bt_, int G_, int c_) { nM = M / BM; nN = N / BM; nwg = nM * nN; G = G_; c = c_; K = K_; Bt = (const char*)Bt_; }
    __device__ bool next(int i, Unit& u) const {
        const long L = (long)i * G + c; if (L >= nwg) return false;
        int wgid = (int)L; { const int q = nwg / NXCD, r = nwg % NXCD, xcd = wgid % NXCD, off = wgid / NXCD; wgid = (xcd < r ? xcd * (q + 1) : r * (q + 1) + (xcd - r) * q) + off; }
        const int nig = WGM * nN, gid = wgid / nig, fm = gid * WGM, gsz = (nM - fm) < WGM ? (nM - fm) : WGM;
        u.pm = fm + ((wgid % nig) % gsz); u.pn = (wgid % nig) / gsz; u.e = 0;
        u.B = Bt + (size_t)u.pn * BM * K * 2; u.list = nullptr; u.row0 = u.pm * BM; u.cnt = 0; u.orow0 = u.pm * BM; return true;
    }
};

template <class Epi, class Sched, bool GATHER, bool FP8 = false>
__device__ __forceinline__ void gemm_phase(LAS unsigned char* lds, const bf16_t* Aptr, const int K, const Sched& S, const Epi& E, const int wv) {
    int tid_ = wv * 64 + lane_id(); asm volatile("" : "+v"(tid_));
    const int tid = tid_, wid = __builtin_amdgcn_readfirstlane(tid >> 6), lane = tid & 63, wr = wid >> 2, wc = wid & 3, fr = lane & 15, fq = lane >> 4;
    const int nt = K / BK;
    unsigned voffB[2], voffA[2];
#pragma unroll
    for (int i = 0; i < 2; ++i) { int sR, sC; stage_rc(tid * 16 + i * 8192, sR, sC); const int Rb = Epi::PERM ? ((sR & ~31) + perm32(sR & 31)) : sR; voffB[i] = (unsigned)(Rb * K + sC) * 2u; voffA[i] = (unsigned)(sR * K + sC) * 2u; }
    const size_t kstep = (size_t)(BK * 2);
    const size_t hstep = (size_t)HALF * K * 2;
    const unsigned ldsw = (unsigned)wid * 1024u;
    const int aoff = FP8 ? lds_byte(wr * 64 + fr, fq * 16) : lds_byte(wr * 64 + fr, fq * 8), boff = FP8 ? lds_byte(wc * 32 + fr, fq * 16) : lds_byte(wc * 32 + fr, fq * 8);
    const int aoff2 = FP8 ? lds_byte(wr * 64 + fr, fq * 16 + 8) : aoff + 1024, boff2 = FP8 ? lds_byte(wc * 32 + fr, fq * 16 + 8) : boff + 1024;
    const char* gA = (const char*)Aptr;
#define PG8_SA(b, h) (((b) * 2 + (h)) * HTB)
#define PG8_SB(b, h) ((4 + (b) * 2 + (h)) * HTB)
#define PG8_STAGE2(bufoff, gbase, o0, o1) do { \
        __builtin_amdgcn_global_load_lds((const unsigned*)((const char*)(gbase) + (o0)), (LAS unsigned*)(lds + (bufoff) + ldsw), 16, 0, 0); \
        __builtin_amdgcn_global_load_lds((const unsigned*)((const char*)(gbase) + (o1)), (LAS unsigned*)(lds + (bufoff) + ldsw + 8192), 16, 0, 0); } while (0)
#define PG8_STAGEB(bufoff, gbase) PG8_STAGE2(bufoff, gbase, voffB[0], voffB[1])
#define PG8_STAGEA(bufoff, gbase, h, useN) do { if constexpr (GATHER) { const u32x4 vo_ = *(const LAS u32x4*)(lds + STAGE_BYTES + ((((useN) ? ui + 1 : ui) & 1) ? 8192 : 0) + tid * 16); \
            if ((h) == 0) { PG8_STAGE2(bufoff, gbase, vo_.x, vo_.y); } else { PG8_STAGE2(bufoff, gbase, vo_.z, vo_.w); } } \
        else { const char* gb_ = (const char*)(gbase) + (size_t)((useN) ? nrow0 : crow0) * K * 2 + (h) * hstep; PG8_STAGE2(bufoff, gb_, voffA[0], voffA[1]); } } while (0)
#define PG8_LD16(p_) (*(const LAS u32x4*)(p_))
#define PG8_MK8(lo_, hi_) (v8i32_t){(int)lo_.x, (int)lo_.y, (int)lo_.z, (int)lo_.w, (int)hi_.x, (int)hi_.y, (int)hi_.z, (int)hi_.w}
#define PG8_LDA(dst, b, h) do { _Pragma("unroll") for (int m = 0; m < 4; ++m) { \
        if constexpr (FP8) { const u32x4 lo_ = PG8_LD16(lds + PG8_SA(b, h) + aoff + m * 2048), hi_ = PG8_LD16(lds + PG8_SA(b, h) + aoff2 + m * 2048); dst##8[m] = PG8_MK8(lo_, hi_); } \
        else { dst[m][0] = *(const LAS bf16x8*)(lds + PG8_SA(b, h) + aoff + m * 2048); dst[m][1] = *(const LAS bf16x8*)(lds + PG8_SA(b, h) + aoff2 + m * 2048); } } } while (0)
#define PG8_LDB(dst, b, h) do { _Pragma("unroll") for (int n = 0; n < 2; ++n) { \
        if constexpr (FP8) { const u32x4 lo_ = PG8_LD16(lds + PG8_SB(b, h) + boff + n * 2048), hi_ = PG8_LD16(lds + PG8_SB(b, h) + boff2 + n * 2048); dst##8[n] = PG8_MK8(lo_, hi_); } \
        else { dst[n][0] = *(const LAS bf16x8*)(lds + PG8_SB(b, h) + boff + n * 2048); dst[n][1] = *(const LAS bf16x8*)(lds + PG8_SB(b, h) + boff2 + n * 2048); } } } while (0)
#define PG8_MMA(ai, bj, At, Bt) do { __builtin_amdgcn_s_setprio(1); _Pragma("unroll") for (int m = 0; m < 4; ++m) _Pragma("unroll") for (int n = 0; n < 2; ++n) { \
        if constexpr (FP8) { asm("v_mfma_scale_f32_16x16x128_f8f6f4 %0, %1, %2, %0, %3, %4 op_sel_hi:[0,0,0]" : "+v"(acc[ai][bj][m][n]) : "v"(Bt##8[n]), "v"(At##8[m]), "v"(sc_w_), "v"(sc_a_)); } \
        else { _Pragma("unroll") for (int k = 0; k < 2; ++k) acc[ai][bj][m][n] = __builtin_amdgcn_mfma_f32_16x16x32_bf16(Bt[n][k], At[m][k], acc[ai][bj][m][n], 0, 0, 0); } } \
        __builtin_amdgcn_s_setprio(0); } while (0)
#define PG8_WAIT_V(n) asm volatile("s_waitcnt vmcnt(" #n ")" ::: "memory")
#define PG8_WAIT_L(n) asm volatile("s_waitcnt lgkmcnt(" #n ")" ::: "memory")
#define PG8_BAR __builtin_amdgcn_s_barrier()
#define PG8_SCHED __builtin_amdgcn_sched_barrier(0)
#define PG8_AOFFS(u, par) do { unsigned v_[2][2]; _Pragma("unroll") for (int i_ = 0; i_ < 2; ++i_) { int sR_, sC_; stage_rc(tid * 16 + i_ * 8192, sR_, sC_); _Pragma("unroll") for (int h_ = 0; h_ < 2; ++h_) v_[h_][i_] = (unsigned)(a_row(u, h_ * HALF + sR_) * K + sC_) * 2u; } \
        *(LAS u32x4*)(lds + STAGE_BYTES + (((par) & 1) ? 8192 : 0) + tid * 16) = (u32x4){v_[0][0], v_[0][1], v_[1][0], v_[1][1]}; } while (0)
    Unit cur, nxt; int ui = 0;
    if (!S.next(0, cur)) return;
    f32x4 acc[2][2][4][2];
#pragma unroll
    for (int a = 0; a < 2; ++a)
#pragma unroll
        for (int b = 0; b < 2; ++b)
#pragma unroll
            for (int m = 0; m < 4; ++m)
#pragma unroll
                for (int n = 0; n < 2; ++n) acc[a][b][m][n] = (f32x4){0.f, 0.f, 0.f, 0.f};
    const int sc_w_ = E.scale_w, sc_a_ = E.scale_a;
    bf16x8 At[4][2], B0[2][2], B1[2][2]; v8i32_t At8[4], B08[2], B18[2];
    int crow0 = cur.row0, nrow0 = cur.row0;
    if constexpr (GATHER) { PG8_AOFFS(cur, 0); }
    const char* cB = cur.B;
    PG8_STAGEB(PG8_SB(0, 0), cB); PG8_STAGEB(PG8_SB(0, 1), cB + hstep); PG8_STAGEA(PG8_SA(0, 0), gA, 0, false); PG8_STAGEA(PG8_SA(0, 1), gA, 1, false);
    if (wr == 1) PG8_BAR;
    PG8_WAIT_V(2); PG8_BAR;
    PG8_STAGEB(PG8_SB(1, 0), cB + kstep); PG8_STAGEA(PG8_SA(1, 0), gA + kstep, 0, false); PG8_STAGEB(PG8_SB(1, 1), cB + hstep + kstep);
    PG8_WAIT_V(6); PG8_BAR;
    for (;;) {
        const bool has_next = S.next(ui + 1, nxt);
        if constexpr (GATHER) { if (has_next) { PG8_AOFFS(nxt, ui + 1); } else { PG8_AOFFS(cur, ui + 1); } }
        nrow0 = has_next ? nxt.row0 : crow0;
        const char* nB = has_next ? nxt.B : cB;
#pragma clang loop unroll(disable)
        for (int t = 0; t < nt; t += 2) {
            const bool last = (t == nt - 2);
            const char* a1 = gA + (size_t)(t + 1) * kstep;
            const char* a2 = last ? gA : gA + (size_t)(t + 2) * kstep; const char* b2 = last ? nB : cB + (size_t)(t + 2) * kstep;
            const char* a3 = a2 + kstep; const char* b3 = b2 + kstep;
            PG8_LDB(B0, 0, 0); PG8_LDB(B1, 0, 1); PG8_SCHED; PG8_LDA(At, 0, 0); PG8_STAGEA(PG8_SA(1, 1), a1, 1, false);
            PG8_WAIT_V(8); PG8_WAIT_L(0); PG8_BAR; PG8_MMA(0, 0, At, B0); PG8_MMA(0, 1, At, B1); PG8_BAR; PG8_SCHED;
            PG8_LDA(At, 0, 1); PG8_STAGEB(PG8_SB(0, 0), b2); PG8_STAGEB(PG8_SB(0, 1), b2 + hstep); PG8_STAGEA(PG8_SA(0, 0), a2, 0, last);
            PG8_WAIT_V(8); PG8_WAIT_L(0); PG8_BAR; PG8_MMA(1, 0, At, B0); PG8_MMA(1, 1, At, B1); PG8_BAR; PG8_SCHED;
            PG8_LDB(B0, 1, 0); PG8_LDB(B1, 1, 1); PG8_SCHED; PG8_LDA(At, 1, 0); PG8_STAGEA(PG8_SA(0, 1), a2, 1, last);
            PG8_WAIT_V(8); PG8_WAIT_L(0); PG8_BAR; PG8_MMA(0, 0, At, B0); PG8_MMA(0, 1, At, B1); PG8_BAR; PG8_SCHED;
            PG8_LDA(At, 1, 1); PG8_STAGEB(PG8_SB(1, 0), b3); PG8_STAGEB(PG8_SB(1, 1), b3 + hstep); PG8_STAGEA(PG8_SA(1, 0), a3, 0, last);
            PG8_WAIT_V(8); PG8_WAIT_L(0); PG8_BAR; PG8_MMA(1, 0, At, B0); PG8_MMA(1, 1, At, B1); PG8_BAR; PG8_SCHED;
        }
        if (wr == 0) PG8_BAR;
        { Unit eu = cur; int el = lane;
          eu.pm = __builtin_amdgcn_readfirstlane(eu.pm); eu.pn = __builtin_amdgcn_readfirstlane(eu.pn); eu.e = __builtin_amdgcn_readfirstlane(eu.e);
          eu.cnt = __builtin_amdgcn_readfirstlane(eu.cnt); eu.orow0 = __builtin_amdgcn_readfirstlane(eu.orow0);
          asm volatile("" : "+s"(eu.pm), "+s"(eu.pn), "+s"(eu.e), "+s"(eu.cnt), "+s"(eu.orow0), "+v"(el));
          E(acc, eu, wr, wc, el & 15, el >> 4); }
        if (!has_next) break;
#pragma unroll
        for (int a = 0; a < 2; ++a)
#pragma unroll
            for (int b = 0; b < 2; ++b)
#pragma unroll
                for (int m = 0; m < 4; ++m)
#pragma unroll
                    for (int n = 0; n < 2; ++n) acc[a][b][m][n] = (f32x4){0.f, 0.f, 0.f, 0.f};
        cur = nxt; cB = nB; ++ui; crow0 = nrow0;
        if (wr == 1) PG8_BAR;
    }
    PG8_WAIT_V(0);
    PG8_BAR;
#undef PG8_SA
#undef PG8_SB
#undef PG8_STAGE2
#undef PG8_STAGEB
#undef PG8_STAGEA
#undef PG8_LDA
#undef PG8_LDB
#undef PG8_MMA
#undef PG8_LD16
#undef PG8_MK8
#undef PG8_WAIT_V
#undef PG8_WAIT_L
#undef PG8_BAR
#undef PG8_SCHED
#undef PG8_AOFFS
}
}

typedef f32x4 acc_t[2][2][4][2];
constexpr int SC_W = 0x79797979, SC_X = 0x7f7f7f7f, SC_H = 0x7b7b7b7b;

struct EpiProj {
    static constexpr bool PERM = true; static constexpr int scale_w = SC_W, scale_a = SC_X;
    bf16_t* P; const f32x2* r128; const f32x2* r64; float* kmsum; int pn_off;
    __device__ __forceinline__ void operator()(const acc_t& acc, const pg8::Unit& u, int wr, int wc, int fr, int fq) const {
        const int g = (u.pn + pn_off) * 4 + wc;
        const int mode = GRP[g][0], lo = GRP[g][1], ho = GRP[g][2], fb = GRP[g][3];
        if (mode == 4) return;
        const bool ksum = (lo >= C_CK && lo < C_CV);
        float cs[16];
#pragma unroll
        for (int k = 0; k < 16; ++k) cs[k] = 0.f;
#pragma unroll
        for (int ai = 0; ai < 2; ++ai)
#pragma unroll
            for (int m = 0; m < 4; ++m) {
                const int row = u.orow0 + ai * 128 + wr * 64 + m * 16 + fr;
                f32x4 l0 = acc[ai][0][m][0], l1 = acc[ai][0][m][1], h0 = acc[ai][1][m][0], h1 = acc[ai][1][m][1];
                if (mode == 1 || mode == 2) {
                    const f32x4* tb = (const f32x4*)((mode == 1 ? r128 + (size_t)row * 64 : r64 + (size_t)row * 32) + fb + 8 * fq);
                    const f32x4 t0 = tb[0], t1 = tb[1], t2 = tb[2], t3 = tb[3];
                    f32x4 nl0, nl1, nh0, nh1;
                    nl0[0] = l0[0] * t0[0] - h0[0] * t0[1]; nh0[0] = l0[0] * t0[1] + h0[0] * t0[0];
                    nl0[1] = l0[1] * t0[2] - h0[1] * t0[3]; nh0[1] = l0[1] * t0[3] + h0[1] * t0[2];
                    nl0[2] = l0[2] * t1[0] - h0[2] * t1[1]; nh0[2] = l0[2] * t1[1] + h0[2] * t1[0];
                    nl0[3] = l0[3] * t1[2] - h0[3] * t1[3]; nh0[3] = l0[3] * t1[3] + h0[3] * t1[2];
                    nl1[0] = l1[0] * t2[0] - h1[0] * t2[1]; nh1[0] = l1[0] * t2[1] + h1[0] * t2[0];
                    nl1[1] = l1[1] * t2[2] - h1[1] * t2[3]; nh1[1] = l1[1] * t2[3] + h1[1] * t2[2];
                    nl1[2] = l1[2] * t3[0] - h1[2] * t3[1]; nh1[2] = l1[2] * t3[1] + h1[2] * t3[0];
                    nl1[3] = l1[3] * t3[2] - h1[3] * t3[3]; nh1[3] = l1[3] * t3[3] + h1[3] * t3[2];
                    l0 = nl0; l1 = nl1; h0 = nh0; h1 = nh1;
                }
                if (ksum) {
#pragma unroll
                    for (int k = 0; k < 4; ++k) { cs[k] += l0[k]; cs[4 + k] += l1[k]; cs[8 + k] += h0[k]; cs[12 + k] += h1[k]; }
                }
                bf16_t* rp = P + (size_t)row * PP + lo + 8 * fq;
                u32x4 w; w.x = cvtpk(l0[0], l0[1]); w.y = cvtpk(l0[2], l0[3]); w.z = cvtpk(l1[0], l1[1]); w.w = cvtpk(l1[2], l1[3]);
                if (mode != 3) { *(u32x4*)rp = w; u32x4 v; v.x = cvtpk(h0[0], h0[1]); v.y = cvtpk(h0[2], h0[3]); v.z = cvtpk(h1[0], h1[1]); v.w = cvtpk(h1[2], h1[3]); *(u32x4*)(rp + ho) = v; }
                else if (fq < 2) *(u32x4*)rp = w;
            }
        if (ksum) {
#pragma unroll
            for (int k = 0; k < 16; ++k) { float v = cs[k]; v += shx_f<1>(v); v += shx_f<2>(v); v += shx_f<4>(v); v += shx_f<8>(v); cs[k] = v; }
            if (fr == 0) { float* dst = kmsum + (size_t)u.pm * 512 + (lo - C_CK) + 8 * fq;
#pragma unroll
                for (int k = 0; k < 8; ++k) { atomicAdd(dst + k, cs[k]); atomicAdd(dst + 64 + k, cs[8 + k]); } }
        }
    }
};

struct EpiOut {
    static constexpr bool PERM = true; static constexpr int scale_w = 0, scale_a = 0;
    const float* X; bf16_t* Y;
    __device__ __forceinline__ void operator()(const acc_t& acc, const pg8::Unit& u, int wr, int wc, int fr, int fq) const {
#pragma unroll
        for (int ai = 0; ai < 2; ++ai)
#pragma unroll
            for (int m = 0; m < 4; ++m) {
                const size_t off = (size_t)(u.orow0 + ai * 128 + wr * 64 + m * 16 + fr) * DM + u.pn * 256 + wc * 32 + 8 * fq;
#pragma unroll
                for (int bj = 0; bj < 2; ++bj) {
                    const f32x4 x0 = *(const f32x4*)(X + off + bj * 128), x1 = *(const f32x4*)(X + off + bj * 128 + 4);
                    const f32x4 a = x0 * ALPHA + acc[ai][bj][m][0], b = x1 * ALPHA + acc[ai][bj][m][1];
                    u32x4 w; w.x = cvtpk(a[0], a[1]); w.y = cvtpk(a[2], a[3]); w.z = cvtpk(b[0], b[1]); w.w = cvtpk(b[2], b[3]);
                    *(u32x4*)(Y + off + bj * 128) = w;
                }
            }
    }
};

struct EpiGU {
    static constexpr bool PERM = true; static constexpr int scale_w = SC_W, scale_a = SC_X;
    unsigned char* H;
    __device__ __forceinline__ void operator()(const acc_t& acc, const pg8::Unit& u, int wr, int wc, int fr, int fq) const {
#pragma unroll
        for (int ai = 0; ai < 2; ++ai)
#pragma unroll
            for (int m = 0; m < 4; ++m) {
                const size_t off = (size_t)(u.orow0 + ai * 128 + wr * 64 + m * 16 + fr) * DFF + u.pn * 128 + wc * 32 + 8 * fq;
                float hv[8];
#pragma unroll
                for (int n = 0; n < 2; ++n)
#pragma unroll
                    for (int j = 0; j < 4; ++j) { const float g = acc[ai][0][m][n][j], up = acc[ai][1][m][n][j]; hv[n * 4 + j] = 16.f * g * up / (1.f + __expf(-g)); }
                u32x2 w; w.x = pk4_fp8(hv[0], hv[1], hv[2], hv[3]); w.y = pk4_fp8(hv[4], hv[5], hv[6], hv[7]);
                *(u32x2*)(H + off) = w;
            }
    }
};

struct EpiDown {
    static constexpr bool PERM = true; static constexpr int scale_w = SC_W, scale_a = SC_H;
    bf16_t* Y; const float* sgate;
    __device__ __forceinline__ void operator()(const acc_t& acc, const pg8::Unit& u, int wr, int wc, int fr, int fq) const {
#pragma unroll
        for (int ai = 0; ai < 2; ++ai)
#pragma unroll
            for (int m = 0; m < 4; ++m) {
                const int r = ai * 128 + wr * 64 + m * 16 + fr, rk = u.pm * 256 + r;
                const float gt = rk < u.cnt ? sgate[u.e * 8192 + rk] : 0.f;
                const size_t off = (size_t)(u.orow0 + r) * DM + u.pn * 256 + wc * 32 + 8 * fq;
#pragma unroll
                for (int bj = 0; bj < 2; ++bj) {
                    const f32x4 a = acc[ai][bj][m][0] * gt, b = acc[ai][bj][m][1] * gt;
                    u32x4 w; w.x = cvtpk(a[0], a[1]); w.y = cvtpk(a[2], a[3]); w.z = cvtpk(b[0], b[1]); w.w = cvtpk(b[2], b[3]);
                    *(u32x4*)(Y + off + bj * 128) = w;
                }
            }
    }
};

struct MoeSched {
    const LAS int* tab; int G, c, K; const char* Bbase; size_t Bstride; const int* lists; int gather;
    __device__ bool next(int i, pg8::Unit& u) const {
#define RFL(x) __builtin_amdgcn_readfirstlane(x)
        const int L = i * G + c; if (L >= RFL(tab[32 + 16])) return false;
        int e = 0;
#pragma unroll
        for (int k = 1; k < 16; ++k) e += (L >= RFL(tab[32 + k])) ? 1 : 0;
        const int r = L - RFL(tab[32 + e]), cnt = RFL(tab[e]), mt = (cnt + 255) >> 8, nt = RFL(r / mt), mtile = r - nt * mt;
        u.pm = mtile; u.pn = nt; u.e = e; u.B = Bbase + (size_t)e * Bstride + (size_t)nt * 256 * K * 2;
        u.cnt = cnt; u.orow0 = RFL(tab[16 + e]) + mtile * 256;
        if (gather) { u.list = lists + e * 8192; u.row0 = mtile * 256; } else { u.list = nullptr; u.row0 = u.orow0; }
        return true;
#undef RFL
    }
};

struct FAState { f32x16 o[4]; float m, l; };
template <int NSTEP> struct KVRegs { u32x4 k[NSTEP]; u32x4 v[8]; };

__device__ __forceinline__ s16x4 vtr(const LAS char* p) { typedef short v4i16_t __attribute__((ext_vector_type(4)));
    return __builtin_bit_cast(s16x4, __builtin_amdgcn_ds_read_tr16_b64_v4i16((LAS v4i16_t*)p)); }

template <int NSTEP, class TF>
__device__ __forceinline__ void fa_load(KVRegs<NSTEP>& R, const bf16_t* P, const TF& tf, int t, int kcol, int vcol, int lane) {
#pragma unroll
    for (int i = 0; i < 8; ++i) { const bf16_t* rp = P + (size_t)tf.row(t, 4 * i + (lane >> 4)) * PP + (lane & 15) * 8; R.v[i] = *(const u32x4*)(rp + vcol);
        if constexpr (NSTEP == 8) R.k[i] = *(const u32x4*)(rp + kcol); }
    if constexpr (NSTEP == 4) {
#pragma unroll
        for (int i = 0; i < 4; ++i) R.k[i] = *(const u32x4*)(P + (size_t)tf.row(t, 8 * i + (lane >> 3)) * PP + kcol + (lane & 7) * 8); }
}

template <int NSTEP, bool QLDS, class TF>
__device__ __forceinline__ void fa_run(FAState& st, const bf16x8 (&q)[QLDS ? 1 : NSTEP], const LAS char* ql, const bf16_t* P, const TF& tf, int t_lo, int t_hi, LAS char* vl, float sc, int kcol, int vcol, int lane) {
    if (t_lo >= t_hi) return;
    constexpr int KP = NSTEP == 8 ? 272 : 144;
    const int hi = lane >> 5;
    const LAS char* vt = vl + (4 * hi + ((lane & 15) >> 2)) * VP + (16 * ((lane >> 4) & 1) + 4 * (lane & 3)) * 2;
    const LAS char* kt = vl + (lane & 31) * KP + hi * 16;
    KVRegs<NSTEP> R;
    fa_load<NSTEP>(R, P, tf, t_lo, kcol, vcol, lane);
    for (int t = t_lo; t < t_hi; ++t) {
        if constexpr (NSTEP == 8) {
#pragma unroll
            for (int i = 0; i < 8; ++i) *(LAS u32x4*)(vl + (4 * i + (lane >> 4)) * KP + (lane & 15) * 16) = R.k[i];
        } else {
#pragma unroll
            for (int i = 0; i < 4; ++i) *(LAS u32x4*)(vl + (8 * i + (lane >> 3)) * KP + (lane & 7) * 16) = R.k[i];
        }
        f32x16 s = {0.f, 0.f, 0.f, 0.f, 0.f, 0.f, 0.f, 0.f, 0.f, 0.f, 0.f, 0.f, 0.f, 0.f, 0.f, 0.f};
#pragma unroll
        for (int i = 0; i < NSTEP; ++i) { bf16x8 qf; if constexpr (QLDS) qf = *(const LAS bf16x8*)(ql + i * 1024 + lane * 16); else qf = q[i];
            const bf16x8 kf = *(const LAS bf16x8*)(kt + i * 32);
            s = __builtin_amdgcn_mfma_f32_32x32x16_bf16(kf, qf, s, 0, 0, 0); }
#pragma unroll
        for (int i = 0; i < 8; ++i) *(LAS u32x4*)(vl + (4 * i + (lane >> 4)) * VP + (lane & 15) * 16) = R.v[i];
        if (t + 1 < t_hi) fa_load<NSTEP>(R, P, tf, t + 1, kcol, vcol, lane);
        float tmax = NEG_INF;
#pragma unroll
        for (int r = 0; r < 16; ++r) { const float v = tf.valid(t, r, hi) ? s[r] * sc : NEG_INF; s[r] = v; tmax = fmaxf(tmax, v); }
        tmax = xmax32(tmax);
        const float mn = fmaxf(st.m, tmax), ms = (mn == NEG_INF) ? 0.f : mn;
        const float alpha = __builtin_amdgcn_exp2f(st.m - ms);
        float ps = 0.f;
#pragma unroll
        for (int r = 0; r < 16; ++r) { const float p = __builtin_amdgcn_exp2f(s[r] - ms); s[r] = p; ps += p; }
        st.l = st.l * alpha + ps; st.m = mn;
        if (!__all(alpha == 1.f)) {
#pragma unroll
            for (int d = 0; d < 4; ++d)
#pragma unroll
                for (int r = 0; r < 16; ++r) st.o[d][r] *= alpha;
        }
        u32x4 p0, p1;
        p0.x = cvtpk(s[0], s[1]); p0.y = cvtpk(s[2], s[3]); p0.z = cvtpk(s[4], s[5]); p0.w = cvtpk(s[6], s[7]);
        p1.x = cvtpk(s[8], s[9]); p1.y = cvtpk(s[10], s[11]); p1.z = cvtpk(s[12], s[13]); p1.w = cvtpk(s[14], s[15]);
        const bf16x8 pb0 = __builtin_bit_cast(bf16x8, p0), pb1 = __builtin_bit_cast(bf16x8, p1);
#pragma unroll
        for (int d = 0; d < 4; ++d) {
            const s16x4 a0 = vtr(vt + d * 64), a1 = vtr(vt + d * 64 + 8 * VP), b0 = vtr(vt + d * 64 + 16 * VP), b1 = vtr(vt + d * 64 + 24 * VP);
            const bf16x8 v0 = {a0[0], a0[1], a0[2], a0[3], a1[0], a1[1], a1[2], a1[3]}, v1 = {b0[0], b0[1], b0[2], b0[3], b1[0], b1[1], b1[2], b1[3]};
            st.o[d] = __builtin_amdgcn_mfma_f32_32x32x16_bf16(v0, pb0, st.o[d], 0, 0, 0);
            st.o[d] = __builtin_amdgcn_mfma_f32_32x32x16_bf16(v1, pb1, st.o[d], 0, 0, 0);
        }
    }
}
__device__ __forceinline__ void fa_init(FAState& st) {
#pragma unroll
    for (int d = 0; d < 4; ++d)
#pragma unroll
        for (int r = 0; r < 16; ++r) st.o[d][r] = 0.f;
    st.m = NEG_INF; st.l = 0.f;
}
__device__ __forceinline__ void fa_normalize(FAState& st) {
    const float lt = xsum32(st.l), inv = lt > 0.f ? 1.f / lt : 0.f;
#pragma unroll
    for (int d = 0; d < 4; ++d)
#pragma unroll
        for (int r = 0; r < 16; ++r) st.o[d][r] *= inv;
}
__device__ __forceinline__ void fa_store(const FAState& st, bf16_t* orow, int hi) {
#pragma unroll
    for (int d = 0; d < 4; ++d)
#pragma unroll
        for (int g = 0; g < 4; ++g) { u32x2 w; w.x = cvtpk(st.o[d][4 * g], st.o[d][4 * g + 1]); w.y = cvtpk(st.o[d][4 * g + 2], st.o[d][4 * g + 3]);
            *(u32x2*)(orow + 32 * d + 8 * g + 4 * hi) = w; }
}
template <int NSTEP>
__device__ __forceinline__ void fa_loadq(bf16x8 (&q)[NSTEP], const bf16_t* qrow, int hi, bool on) {
#pragma unroll
    for (int s = 0; s < NSTEP; ++s) { bf16x8 z = {0, 0, 0, 0, 0, 0, 0, 0}; q[s] = on ? *(const bf16x8*)(qrow + 16 * s + 8 * hi) : z; }
}

template <int NSTEP>
__device__ __forceinline__ void fa_loadq_lds(LAS char* ql, const bf16_t* qrow, int hi, bool on, int lane) {
#pragma unroll
    for (int s = 0; s < NSTEP; ++s) { bf16x8 z = {0, 0, 0, 0, 0, 0, 0, 0}; *(LAS bf16x8*)(ql + s * 1024 + lane * 16) = on ? *(const bf16x8*)(qrow + 16 * s + 8 * hi) : z; }
}
constexpr int QL_OFF = 8 * VT_BYTES, QL_BYTES = 8192, AUX_OFF = 147456;


constexpr int E1_STAGE = 32768, E1_NS = 3;
template <int NSTEP, class TF>
__device__ __forceinline__ void e1_run(FAState& st, const bf16x8 (&q)[NSTEP], const bf16_t* Kg, const bf16_t* Vg, const int nkt, LAS char* ring, const float sc, const int kc0, const TF& tf, const int lane, const int wid) {
    const int hi = lane >> 5, r32 = lane & 31;
    unsigned doff[2];
#pragma unroll
    for (int i = 0; i < 2; ++i) { const int row = 8 * wid + 4 * i + (lane >> 4), sw = ((row & 3) << 2) | ((row >> 2) & 3); doff[i] = (unsigned)(row * PP + 8 * ((lane & 15) ^ sw)) * 2u; }
    const unsigned ldsw = (unsigned)wid * 2048u;
#define E1_DMAK(kt_, stg_) do { const char* kb_ = (const char*)(Kg + (size_t)(kt_) * 64 * PP); LAS char* sb_ = ring + (stg_) * E1_STAGE + ldsw; \
        __builtin_amdgcn_global_load_lds((const unsigned*)(kb_ + doff[0]), (LAS unsigned*)(sb_), 16, 0, 0); __builtin_amdgcn_global_load_lds((const unsigned*)(kb_ + doff[1]), (LAS unsigned*)(sb_ + 1024), 16, 0, 0); } while (0)
#define E1_DMAV(kt_, stg_) do { const char* vb_ = (const char*)(Vg + (size_t)(kt_) * 64 * PP); LAS char* sb_ = ring + (stg_) * E1_STAGE + ldsw; \
        __builtin_amdgcn_global_load_lds((const unsigned*)(vb_ + doff[0]), (LAS unsigned*)(sb_ + 16384), 16, 0, 0); __builtin_amdgcn_global_load_lds((const unsigned*)(vb_ + doff[1]), (LAS unsigned*)(sb_ + 16384 + 1024), 16, 0, 0); } while (0)
    const int swk = ((r32 & 3) << 2) | ((r32 >> 2) & 3);
    const int koff0 = 256 * r32 + 16 * ((kc0 + hi) ^ swk);
    int voff0[2];
    { const int qq = (lane & 15) >> 2, p = lane & 3, cl = 2 * ((lane >> 4) & 1) + (p >> 1);
#pragma unroll
      for (int rd = 0; rd < 2; ++rd) voff0[rd] = 16384 + 256 * (8 * rd + 4 * hi + qq) + 16 * (4 * qq + (cl ^ ((2 * rd + hi) & 3))) + 8 * (p & 1); }
    if (nkt <= 0) return;
    E1_DMAK(0, 0);
    if (nkt > 1) E1_DMAK(1, 1);
    E1_DMAV(0, 0);
    const f32x16 zero16 = {0.f, 0.f, 0.f, 0.f, 0.f, 0.f, 0.f, 0.f, 0.f, 0.f, 0.f, 0.f, 0.f, 0.f, 0.f, 0.f};
    const bf16x8 zb = {0, 0, 0, 0, 0, 0, 0, 0};
    bf16x8 pb0 = zb, pb1 = zb, pb2 = zb, pb3 = zb;
    int pend = 0, stg = 0, stp = 2;
#pragma clang loop unroll(disable)
    for (int kt = 0; kt <= nkt; ++kt) {
        if (kt + 1 < nkt) asm volatile("s_waitcnt vmcnt(4)" ::: "memory"); else if (kt < nkt) asm volatile("s_waitcnt vmcnt(2)" ::: "memory"); else asm volatile("s_waitcnt vmcnt(0)" ::: "memory");
        __builtin_amdgcn_s_barrier();
        const int sn = stg + 1 >= E1_NS ? 0 : stg + 1;
        if (kt + 2 < nkt) E1_DMAK(kt + 2, stp);
        if (kt + 1 < nkt) E1_DMAV(kt + 1, sn);
        const LAS char* sb = ring + stg * E1_STAGE;
        const bool in = kt < nkt, act0 = in && tf.active(kt, 0), act1 = in && tf.active(kt, 1);
        int act = __builtin_amdgcn_readfirstlane((act0 || act1) ? 1 : 0); asm volatile("" : "+s"(act));
        f32x16 c0 = zero16, c1 = zero16;
        float tmax = NEG_INF, ms = 0.f, alpha = 1.f, ps = 0.f;
        bool mk0 = false, mk1 = false;
        auto mw = tf.fetch(in ? kt : 0);
        if (act) {
            mk0 = tf.masked(kt, 0); mk1 = tf.masked(kt, 1) || !act1;
            int kof = koff0; asm volatile("" : "+v"(kof));
#pragma unroll
            for (int i = 0; i < NSTEP; ++i) { const bf16x8 kf0 = *(const LAS bf16x8*)(sb + (kof ^ (32 * i))), kf1 = *(const LAS bf16x8*)(sb + 8192 + (kof ^ (32 * i)));
                c0 = __builtin_amdgcn_mfma_f32_32x32x16_bf16(kf0, q[i], c0, 0, 0, 0); c1 = __builtin_amdgcn_mfma_f32_32x32x16_bf16(kf1, q[i], c1, 0, 0, 0); }
        }
        const unsigned vb0 = (unsigned)(uintptr_t)(ring + stp * E1_STAGE) + (unsigned)voff0[0], vb1 = (unsigned)(uintptr_t)(ring + stp * E1_STAGE) + (unsigned)voff0[1];
        s16x4 ta[16], tb[16];
#define E1_TRP(j_, off_) do { const unsigned ad0 = vb0 ^ (64u * ((j_) >> 2)), ad1 = vb1 ^ (64u * ((j_) >> 2)); \
            asm volatile("ds_read_b64_tr_b16 %0, %1 offset:" #off_ : "=&v"(ta[j_]) : "v"(ad0) : "memory"); asm volatile("ds_read_b64_tr_b16 %0, %1 offset:" #off_ : "=&v"(tb[j_]) : "v"(ad1) : "memory"); } while (0)
#define E1_PVM(j_, pb_, w_) do { asm volatile("s_waitcnt lgkmcnt(" #w_ ")" ::: "memory"); __builtin_amdgcn_sched_barrier(0); \
            st.o[(j_) >> 2] = __builtin_amdgcn_mfma_f32_32x32x16_bf16((bf16x8){ta[j_][0], ta[j_][1], ta[j_][2], ta[j_][3], tb[j_][0], tb[j_][1], tb[j_][2], tb[j_][3]}, pb_, st.o[(j_) >> 2], 0, 0, 0); \
            __builtin_amdgcn_sched_barrier(0); } while (0)
#define E1_MAX0 do { if (mk0) { _Pragma("unroll") for (int r = 0; r < 16; ++r) { const float v = (act0 && tf.valid(kt, 0, r, hi, mw)) ? c0[r] : NEG_INF; c0[r] = v; tmax = fmaxf(tmax, v); } } \
            else { _Pragma("unroll") for (int r = 0; r < 16; ++r) { const float v = act0 ? c0[r] : NEG_INF; c0[r] = v; tmax = fmaxf(tmax, v); } } __builtin_amdgcn_sched_barrier(0); } while (0)
#define E1_MAX1 do { if (mk1) { _Pragma("unroll") for (int r = 0; r < 16; ++r) { const float v = (act1 && tf.valid(kt, 1, r, hi, mw)) ? c1[r] : NEG_INF; c1[r] = v; tmax = fmaxf(tmax, v); } } \
            else { _Pragma("unroll") for (int r = 0; r < 16; ++r) tmax = fmaxf(tmax, c1[r]); } __builtin_amdgcn_sched_barrier(0); } while (0)
#define E1_RED do { const swap2 rr = pl32swap(tmax, tmax); tmax = fmaxf(rr.a, rr.b) * sc; const float mn = fmaxf(st.m, tmax); ms = (mn == NEG_INF) ? 0.f : mn; \
            alpha = __builtin_amdgcn_exp2f(st.m - ms); st.m = mn; __builtin_amdgcn_sched_barrier(0); } while (0)
#define E1_EXP(c_, lo_) do { _Pragma("unroll") for (int r = (lo_); r < (lo_) + 8; ++r) { const float p = __builtin_amdgcn_exp2f(__builtin_fmaf(c_[r], sc, -ms)); c_[r] = p; ps += p; } __builtin_amdgcn_sched_barrier(0); } while (0)
        __builtin_amdgcn_sched_barrier(0);
        if (pend) { asm volatile("s_waitcnt lgkmcnt(0)" ::: "memory"); __builtin_amdgcn_sched_barrier(0); E1_TRP(0, 0); E1_TRP(1, 4096); E1_TRP(2, 8192); E1_TRP(3, 12288);
                    E1_PVM(0, pb0, 6); E1_TRP(4, 0); E1_PVM(1, pb1, 6); E1_TRP(5, 4096); }
        if (act) E1_MAX0;
        if (pend) { E1_PVM(2, pb2, 6); E1_TRP(6, 8192); E1_PVM(3, pb3, 6); E1_TRP(7, 12288); }
        if (act) E1_MAX1;
        if (pend) { E1_PVM(4, pb0, 6); E1_TRP(8, 0); E1_PVM(5, pb1, 6); E1_TRP(9, 4096); }
        if (act) E1_RED;
        if (pend) { E1_PVM(6, pb2, 6); E1_TRP(10, 8192); E1_PVM(7, pb3, 6); E1_TRP(11, 12288); }
        if (act) E1_EXP(c0, 0);
        if (pend) { E1_PVM(8, pb0, 6); E1_TRP(12, 0); E1_PVM(9, pb1, 6); E1_TRP(13, 4096); }
        if (act) E1_EXP(c0, 8);
        if (pend) { E1_PVM(10, pb2, 6); E1_TRP(14, 8192); E1_PVM(11, pb3, 6); E1_TRP(15, 12288); }
        if (act) E1_EXP(c1, 0);
        if (pend) { E1_PVM(12, pb0, 6); E1_PVM(13, pb1, 4); }
        if (act) E1_EXP(c1, 8);
        if (pend) { E1_PVM(14, pb2, 2); E1_PVM(15, pb3, 0); }
#undef E1_TRP
#undef E1_PVM
#undef E1_MAX0
#undef E1_MAX1
#undef E1_RED
#undef E1_EXP
        if (act) {
            st.l = st.l * alpha + ps;
            if (!__all(alpha == 1.f)) {
#pragma unroll
                for (int d = 0; d < 4; ++d)
#pragma unroll
                    for (int r = 0; r < 16; ++r) st.o[d][r] *= alpha;
            }
            u32x4 w0, w1, w2, w3;
            w0.x = cvtpk(c0[0], c0[1]); w0.y = cvtpk(c0[2], c0[3]); w0.z = cvtpk(c0[4], c0[5]); w0.w = cvtpk(c0[6], c0[7]);
            w1.x = cvtpk(c0[8], c0[9]); w1.y = cvtpk(c0[10], c0[11]); w1.z = cvtpk(c0[12], c0[13]); w1.w = cvtpk(c0[14], c0[15]);
            w2.x = cvtpk(c1[0], c1[1]); w2.y = cvtpk(c1[2], c1[3]); w2.z = cvtpk(c1[4], c1[5]); w2.w = cvtpk(c1[6], c1[7]);
            w3.x = cvtpk(c1[8], c1[9]); w3.y = cvtpk(c1[10], c1[11]); w3.z = cvtpk(c1[12], c1[13]); w3.w = cvtpk(c1[14], c1[15]);
            pb0 = __builtin_bit_cast(bf16x8, w0); pb1 = __builtin_bit_cast(bf16x8, w1); pb2 = __builtin_bit_cast(bf16x8, w2); pb3 = __builtin_bit_cast(bf16x8, w3);
        }
        asm volatile("s_waitcnt lgkmcnt(0)" ::: "memory");
        pend = act; stp = stg; stg = sn;
    }
#undef E1_DMAK
#undef E1_DMAV
}

struct Args {
    const float* x; const int* pos; const float* w_in; const float* w_out; const float* dlam; const float* dng; const float* lmg; const float* lmb;
    const float* rw; const float* rb; const float* wg; const float* wu; const float* wd; const float* lfg; const float* lfb;
    float* out; unsigned char* ws; int ph_lo, ph_hi;
};

struct TFDiffE1 { int q0, qpos;
    __device__ __forceinline__ bool active(int kt, int sub) const { return 64 * kt + 32 * sub <= q0; }
    __device__ __forceinline__ bool masked(int kt, int sub) const { return 64 * kt + 32 * sub == q0; }
    __device__ __forceinline__ int fetch(int) const { return 0; }
    __device__ __forceinline__ bool valid(int kt, int sub, int r, int hi, int) const { return 64 * kt + 32 * sub + crow(r, hi) <= qpos; } };

__device__ __forceinline__ void diff_unit(const Args& A, int layer, int b, int hh, int qb, LAS char* lds, const int wv) {
    int tid_ = wv * 64 + lane_id(); asm volatile("" : "+v"(tid_));
    const int tid = tid_, lane = tid & 63, wid = __builtin_amdgcn_readfirstlane(tid >> 6), sub = wid & 3, map = wid >> 2, hi = lane >> 5;
    const bf16_t* P = (const bf16_t*)(A.ws + WS_PROJ); bf16_t* MIX = (bf16_t*)(A.ws + WS_MIX);
    const int q0 = qb * 128 + sub * 32, qpos = q0 + (lane & 31), tok = b * SEQ + qpos;
    bf16x8 q[4]; fa_loadq<4>(q, P + (size_t)tok * PP + C_BQ + hh * 128 + map * 64, hi, true);
    FAState st; fa_init(st);
    TFDiffE1 tf{q0, qpos};
    e1_run<4>(st, q, P + (size_t)(b * SEQ) * PP + C_BK + hh * 128, P + (size_t)(b * SEQ) * PP + C_BV + hh * 128, 2 * qb + 2, lds, 0.125f * LOG2E, 8 * map, tf, lane, wid);
    __syncthreads();
    fa_normalize(st);
    LAS float* xch = (LAS float*)lds + sub * 4096;
    if (map == 1) {
#pragma unroll
        for (int d = 0; d < 4; ++d)
#pragma unroll
            for (int r = 0; r < 16; ++r) xch[(d * 16 + r) * 64 + lane] = st.o[d][r];
    }
    __syncthreads();
    if (map == 0) {
        int ly_ = layer; asm volatile("" : "+s"(ly_)); const int layer = ly_;
        const float* dl = A.dlam + layer * 256;
        const float s1 = wave_sum(dl[lane] * dl[64 + lane]), s2 = wave_sum(dl[128 + lane] * dl[192 + lane]);
        float c08 = 0.8f; asm volatile("" : "+v"(c08));
        const float lam_init = c08 - 0.6f * expf(-0.3f * (float)layer);
        const float lam = expf(s1) - expf(s2) + lam_init;
        float ss = 0.f;
#pragma unroll
        for (int d = 0; d < 4; ++d)
#pragma unroll
            for (int r = 0; r < 16; ++r) { const float o = st.o[d][r] - lam * xch[(d * 16 + r) * 64 + lane]; st.o[d][r] = o; ss += o * o; }
        ss = xsum32(ss);
        const float rinv = rsqrtf(ss * (1.f / 128.f) + LN_EPS) * (1.f - lam_init);
        const float* g = A.dng + layer * 128;
#pragma unroll
        for (int d = 0; d < 4; ++d)
#pragma unroll
            for (int r = 0; r < 16; ++r) st.o[d][r] *= rinv * g[32 * d + crow(r, hi)];
        fa_store(st, MIX + (size_t)tok * DM + 512 + hh * 128, hi);
    }
}

struct TFMobaE1 { int j, q0, qpos; unsigned selmask, wavemask;
    __device__ __forceinline__ bool active(int kt, int sub) const { const int n = kt >> 2; return n < j ? ((wavemask >> n) & 1u) != 0u : (64 * kt + 32 * sub <= q0); }
    __device__ __forceinline__ bool masked(int kt, int sub) const { const int n = kt >> 2; return n < j ? true : (64 * kt + 32 * sub == q0); }
    __device__ __forceinline__ int fetch(int) const { return 0; }
    __device__ __forceinline__ bool valid(int kt, int sub, int r, int hi, int) const { const int n = kt >> 2; return n < j ? ((selmask >> n) & 1u) != 0u : (64 * kt + 32 * sub + crow(r, hi) <= qpos); } };

__device__ __forceinline__ void moba_unit(const Args& A, int layer, int b, int hh, int j, LAS char* lds, const int wv) {
    int tid_ = wv * 64 + lane_id(); asm volatile("" : "+v"(tid_));
    const int tid = tid_, lane = tid & 63, wid = __builtin_amdgcn_readfirstlane(tid >> 6), hi = lane >> 5;
    const bf16_t* P = (const bf16_t*)(A.ws + WS_PROJ); bf16_t* MIX = (bf16_t*)(A.ws + WS_MIX);
    LAS float* km = (LAS float*)(lds + AUX_OFF);
    { const float* kms = (const float*)(A.ws + WS_CTL + KM_OFF) + (size_t)((layer * NB + b) * 16) * 512 + hh * 128;
      for (int i = tid; i < j * 128; i += 512) km[i] = kms[(size_t)(i >> 7) * 512 + (i & 127)] * (1.f / 256.f); }
    __syncthreads();
    const int q0 = j * 256 + wid * 32, qpos = q0 + (lane & 31), tok = b * SEQ + qpos;
    const bf16_t* qrow = P + (size_t)tok * PP + C_CQ + hh * 128;
    float gate[16];
#pragma unroll
    for (int n = 0; n < 16; ++n) gate[n] = 0.f;
#pragma unroll 1
    for (int c = 0; c < 16; ++c) {
        const u32x4 qw = *(const u32x4*)(qrow + 8 * c);
        const float qf[8] = {bflo(qw.x), bfhi(qw.x), bflo(qw.y), bfhi(qw.y), bflo(qw.z), bfhi(qw.z), bflo(qw.w), bfhi(qw.w)};
#pragma unroll
        for (int n = 0; n < 16; ++n) {
            const f32x4 k0 = *(const LAS f32x4*)(km + n * 128 + 8 * c), k1 = *(const LAS f32x4*)(km + n * 128 + 8 * c + 4);
            gate[n] += qf[0] * k0[0] + qf[1] * k0[1] + qf[2] * k0[2] + qf[3] * k0[3] + qf[4] * k1[0] + qf[5] * k1[1] + qf[6] * k1[2] + qf[7] * k1[3];
        }
    }
    unsigned selmask = 0u;
#pragma unroll
    for (int pick = 0; pick < 3; ++pick) {
        float best = NEG_INF; int bi = -1;
#pragma unroll
        for (int n = 0; n < 16; ++n) { const bool ok = (n < j) && !((selmask >> n) & 1u) && (gate[n] > best || bi < 0); if (ok) { best = gate[n]; bi = n; } }
        if (bi >= 0) selmask |= 1u << bi;
    }
    unsigned wavemask = 0u;
#pragma unroll
    for (int n = 0; n < 16; ++n) wavemask |= (__any((selmask >> n) & 1u) ? 1u : 0u) << n;
    bf16x8 q[8]; fa_loadq<8>(q, qrow, hi, true);
    FAState st; fa_init(st);
    TFMobaE1 tf{j, q0, qpos, selmask, wavemask};
    e1_run<8>(st, q, P + (size_t)(b * SEQ) * PP + C_CK + hh * 128, P + (size_t)(b * SEQ) * PP + C_CV + hh * 128, 4 * j + 4, lds, 0.08838834764831845f * LOG2E, 0, tf, lane, wid);
    fa_normalize(st);
    int tok2 = b * SEQ + j * 256 + wid * 32 + (lane_id() & 31); asm volatile("" : "+v"(tok2));
    fa_store(st, MIX + (size_t)tok2 * DM + 1024 + hh * 128, hi);
}

struct TFDil { int rowbase, base, stride, add, uq, want, q4;
    __device__ __forceinline__ int row(int t, int key) const { int u = base + 32 * t + key; u = u < 0 ? 0 : u; int s = stride * u + add; s = s > SEQ - 1 ? SEQ - 1 : s; return rowbase + s; }
    __device__ __forceinline__ bool valid(int t, int r, int hi) const { const int u = base + 32 * t + crow(r, hi), d = uq - u; return u >= 0 && d >= 0 && d <= 128 && (want < 0 || q4 == want); } };

__device__ __forceinline__ void dil_unit(const Args& A, int b, int hh, int blk, LAS char* lds, const int wv) {
    int tid_ = wv * 64 + lane_id(); asm volatile("" : "+v"(tid_));
    const int tid = tid_, lane = tid & 63, wid = __builtin_amdgcn_readfirstlane(tid >> 6), hi = lane >> 5;
    const bf16_t* P = (const bf16_t*)(A.ws + WS_PROJ); bf16_t* MIX = (bf16_t*)(A.ws + WS_MIX);
    const int t0 = blk * 256 + (wid >> 2) * 128, r4 = wid & 3, c = lane & 31, i = c & 7, q4 = c >> 3;
    const int tq = t0 + 16 * i + 4 * q4 + r4, tok = b * SEQ + tq;
    bf16x8 q[8]; fa_loadq<8>(q, P + (size_t)tok * PP + C_DQ + hh * 128, hi, true); const LAS char* ql = nullptr;
    FAState st; fa_init(st);
    const float sc = 0.08838834764831845f * LOG2E;
    LAS char* vl = lds + wid * VT_BYTES;
    const int kc = C_DK + hh * 128, vc = C_DV + hh * 128;
    { TFDil tf{b * SEQ, t0 - 128, 1, 0, tq, -1, q4}; fa_run<8, false>(st, q, ql, P, tf, t0 >= 128 ? 0 : 4, 8, vl, sc, kc, vc, lane); }
    { const int u0 = t0 >> 2; int ts = (128 - u0 + 31) >> 5; ts = ts < 0 ? 0 : ts;
      TFDil tf{b * SEQ, u0 - 128, 4, r4, u0 + 4 * i + q4, -1, q4}; fa_run<8, false>(st, q, ql, P, tf, ts, 5, vl, sc, kc, vc, lane); }
    { const int u0 = t0 >> 4; int ts = (128 - u0 + 31) >> 5; ts = ts < 0 ? 0 : ts;
      for (int w4 = 0; w4 < 4; ++w4) { TFDil tf{b * SEQ, u0 - 128, 16, r4 + 4 * w4, u0 + i, w4, q4}; fa_run<8, false>(st, q, ql, P, tf, ts, 5, vl, sc, kc, vc, lane); } }
    fa_normalize(st);
    fa_store(st, MIX + (size_t)tok * DM + 1536 + hh * 128, hi);
}

struct TFDsaE1 { const LAS char* mb;
    __device__ __forceinline__ bool active(int, int) const { return true; }
    __device__ __forceinline__ bool masked(int, int) const { return true; }
    __device__ __forceinline__ unsigned fetch(int kt) const { return *(const LAS unsigned*)(mb + 512 * kt); }
    __device__ __forceinline__ bool valid(int, int sub, int r, int, unsigned mw) const { return ((mw >> (8 * (r & 3) + 4 * sub + (r >> 2))) & 1u) != 0u; } };

__device__ __forceinline__ unsigned ord16(unsigned h) { return (h & 0x8000u) ? (~h & 0xffffu) : (h | 0x8000u); }

__device__ __forceinline__ void dsa_unit(const Args& A, int layer, int b, int t0, LAS char* lds, const int wv, const int level) {
    int tid_ = wv * 64 + lane_id(); asm volatile("" : "+v"(tid_));
    const int tid = tid_, lane = tid & 63, wid = __builtin_amdgcn_readfirstlane(tid >> 6), hi = lane >> 5;
    const bf16_t* P = (const bf16_t*)(A.ws + WS_PROJ); bf16_t* MIX = (bf16_t*)(A.ws + WS_MIX);
    LAS unsigned short* sco = (LAS unsigned short*)lds;
    LAS char* kst = lds + 131072;
    unsigned* dsac = (unsigned*)(A.ws + WS_CTL) + CW_DSAC + 128 * layer + 64 * b + (t0 >> 6);
    const int nkeys = t0 + 16, nchunk = (nkeys + 127) >> 7;
    {
        const int r = lane & 31;
        const int tokq = b * SEQ + t0 + 2 * wid + (r >> 4);
        bf16x8 aq[4];
#pragma unroll
        for (int s = 0; s < 4; ++s) aq[s] = *(const bf16x8*)(P + (size_t)tokq * PP + C_IQ + (r & 15) * 64 + 16 * s + 8 * hi);
        float wgt[16];
#pragma unroll
        for (int rr = 0; rr < 16; ++rr) { const int head = (rr & 3) + 8 * ((rr >> 2) & 1) + 4 * hi;
            wgt[rr] = bf2f(P[(size_t)(b * SEQ + t0 + 2 * wid + (rr >> 3)) * PP + C_IW + head]) * 0.03125f; }
        const int tlim = (t0 + 2 * wid + 1) >> 5;
        const int k0_ = tid >> 3, c0_ = tid & 7;
        const bf16_t* src = P + (size_t)(b * SEQ) * PP + C_IK + c0_ * 8;
        u32x4 pa0, pa1, pb0, pb1;
#define DSA_STAGE_LOAD(d0_, d1_, ch_) do { int ka_ = 128 * (ch_) + k0_, kb_ = ka_ + 64; ka_ = ka_ > SEQ - 1 ? SEQ - 1 : ka_; kb_ = kb_ > SEQ - 1 ? SEQ - 1 : kb_; \
            d0_ = *(const u32x4*)(src + (size_t)ka_ * PP); d1_ = *(const u32x4*)(src + (size_t)kb_ * PP); } while (0)
#define DSA_CHUNK(s0_, s1_, ch_) do { \
            __syncthreads(); \
            *(LAS u32x4*)(kst + k0_ * 128 + ((c0_ ^ ((k0_ >> 1) & 7)) << 4)) = s0_; \
            *(LAS u32x4*)(kst + (k0_ + 64) * 128 + ((c0_ ^ (((k0_ + 64) >> 1) & 7)) << 4)) = s1_; \
            __syncthreads(); \
            if ((ch_) + 2 < nchunk) DSA_STAGE_LOAD(s0_, s1_, (ch_) + 2); \
              \
            _Pragma("unroll") for (int th = 0; th < 4; th += 2) { \
                bf16x8 kb_[2][4]; \
                _Pragma("unroll") for (int tt = 0; tt < 2; ++tt) { const int kr = 32 * (th + tt) + r; \
                    _Pragma("unroll") for (int s = 0; s < 4; ++s) kb_[tt][s] = *(const LAS bf16x8*)(kst + kr * 128 + (((2 * s + hi) ^ ((kr >> 1) & 7)) << 4)); } \
                f32x16 ca_[2]; \
                _Pragma("unroll") for (int tt = 0; tt < 2; ++tt) ca_[tt] = (f32x16){0.f, 0.f, 0.f, 0.f, 0.f, 0.f, 0.f, 0.f, 0.f, 0.f, 0.f, 0.f, 0.f, 0.f, 0.f, 0.f}; \
                _Pragma("unroll") for (int s = 0; s < 4; ++s) \
                    _Pragma("unroll") for (int tt = 0; tt < 2; ++tt) ca_[tt] = __builtin_amdgcn_mfma_f32_32x32x16_bf16(aq[s], kb_[tt][s], ca_[tt], 0, 0, 0); \
                _Pragma("unroll") for (int tt = 0; tt < 2; ++tt) { \
                    float p0 = 0.f, p1 = 0.f; \
                    _Pragma("unroll") for (int rr = 0; rr < 8; ++rr) { const float r0_ = __builtin_amdgcn_fmed3f(ca_[tt][rr], 0.f, 3.0e38f), r1_ = __builtin_amdgcn_fmed3f(ca_[tt][8 + rr], 0.f, 3.0e38f);     \
                        p0 = __builtin_fmaf(wgt[rr], r0_, p0); p1 = __builtin_fmaf(wgt[8 + rr], r1_, p1); } \
                    const swap2 sw = pl32swap(p0, p1); const float tot = sw.a + sw.b; \
                    const _Float16 hsc = (_Float16)tot; \
                    sco[(2 * wid + hi) * 4096 + 32 * (4 * (ch_) + th + tt) + r] = __builtin_bit_cast(unsigned short, hsc); \
                } __builtin_amdgcn_sched_barrier(0); } } while (0)
        DSA_STAGE_LOAD(pa0, pa1, 0);
        if (nchunk > 1) DSA_STAGE_LOAD(pb0, pb1, 1);
        for (int ch = 0; ch < nchunk; ch += 2) {
            DSA_CHUNK(pa0, pa1, ch);
            if (ch + 1 < nchunk) DSA_CHUNK(pb0, pb1, ch + 1);
        }
#undef DSA_CHUNK
#undef DSA_STAGE_LOAD
    }
    __syncthreads();
    if (level < 2) return;
#pragma unroll 1
    for (int qq = 0; qq < 2; ++qq) {
        const int qi = 2 * wid + qq, tq = t0 + qi, nv = tq + 1;
        unsigned long long* bmq = (unsigned long long*)(A.ws + WS_BM) + (size_t)(b * SEQ + tq) * 64;
        if (nv <= 256) { const int cntl = tq >= lane ? ((tq - lane) >> 3) + 1 : 0;
            if (lane < 8) __hip_atomic_store(bmq + lane, (1ull << cntl) - 1ull, RLX_AGENT);
            continue; }
        const int nch = (nv + 511) >> 9;
        typedef unsigned short u16x2 __attribute__((ext_vector_type(2)));
        unsigned v[32];
#pragma unroll
        for (int i = 0; i < 8; ++i) {
            if (i < nch) { const u32x4 f = *(const LAS u32x4*)(sco + qi * 4096 + i * 512 + 8 * lane);
                const unsigned w[4] = {f.x, f.y, f.z, f.w};
#pragma unroll
                for (int d = 0; d < 4; ++d) { const int k0 = i * 512 + 8 * lane + 2 * d;
                    const unsigned neg = (w[d] >> 15) & 0x00010001u, ordw = w[d] ^ ((neg * 0xffffu) | 0x80008000u);
                    const unsigned vm = (k0 <= tq ? 0x0000ffffu : 0u) | (k0 + 1 <= tq ? 0xffff0000u : 0u);
                    v[i * 4 + d] = ordw & vm; } }
            else {
#pragma unroll
                for (int d = 0; d < 4; ++d) v[i * 4 + d] = 0u; }
        }
        const unsigned one2u = 0x00010001u;
        unsigned x = 0u;
        for (int bit = 15; bit >= 0; --bit) {
            const unsigned cand = x | (1u << bit), cm1 = (cand - 1u) * 0x00010001u;
            unsigned c2u = 0u;
#pragma unroll
            for (int i = 0; i < 8; ++i) if (i < nch) {
#pragma unroll
                for (int d = 0; d < 4; ++d) { unsigned t_; asm("v_pk_sub_u16 %0, %1, %2 clamp" : "=v"(t_) : "v"(v[i * 4 + d]), "v"(cm1)); asm("v_pk_min_u16 %0, %1, %2" : "=v"(t_) : "v"(t_), "v"(one2u)); asm("v_pk_add_u16 %0, %1, %2" : "=v"(c2u) : "v"(c2u), "v"(t_)); } }
            const int cl = (int)(c2u & 0xffffu) + (int)(c2u >> 16);
            const int cnt = wave_isum(cl);
            if (cnt >= 256) x = cand;
            if (cnt == 256) break;
        }
        int gtot = 0;
        { const unsigned xs = x * 0x00010001u; unsigned c2u = 0u;
#pragma unroll
          for (int i = 0; i < 8; ++i) if (i < nch) {
#pragma unroll
              for (int d = 0; d < 4; ++d) { unsigned t_; asm("v_pk_sub_u16 %0, %1, %2 clamp" : "=v"(t_) : "v"(v[i * 4 + d]), "v"(xs)); asm("v_pk_min_u16 %0, %1, %2" : "=v"(t_) : "v"(t_), "v"(one2u)); asm("v_pk_add_u16 %0, %1, %2" : "=v"(c2u) : "v"(c2u), "v"(t_)); } }
          const int cg = (int)(c2u & 0xffffu) + (int)(c2u >> 16);
          gtot = wave_isum(cg); }
        int be = gtot;
        unsigned long long myw = 0ull;
#pragma unroll
        for (int i = 0; i < 8; ++i) if (i < nch) {
#pragma unroll
            for (int e = 0; e < 8; ++e) {
                const unsigned vv = (e & 1) ? (v[i * 4 + (e >> 1)] >> 16) : (v[i * 4 + (e >> 1)] & 0xffffu);
                const bool g = vv > x, eq = vv == x;
                const unsigned long long mg = __ballot(g), me = __ballot(eq);
                const int pe = be + (int)__builtin_amdgcn_mbcnt_hi((unsigned)(me >> 32), __builtin_amdgcn_mbcnt_lo((unsigned)me, 0u));
                const unsigned long long wj = mg | __ballot(eq && pe < 256);
                if (lane == 8 * i + e) myw = wj;
                be += __popcll(me);
            }
        }
        if (lane < 8 * nch) __hip_atomic_store(bmq + lane, myw, RLX_AGENT);
    }
    asm volatile("s_waitcnt vmcnt(0)" ::: "memory");
    __syncthreads();
    if (tid == 0) __hip_atomic_fetch_add(dsac, 1u, RLX_AGENT);
}

__device__ __forceinline__ void dsa_att_unit(const Args& A, int layer, int b, int g, LAS char* lds, const int wv) {
    int tid_ = wv * 64 + lane_id(); asm volatile("" : "+v"(tid_));
    const int tid = tid_, lane = tid & 63, wid = __builtin_amdgcn_readfirstlane(tid >> 6), hi = lane >> 5;
    const bf16_t* P = (const bf16_t*)(A.ws + WS_PROJ); bf16_t* MIX = (bf16_t*)(A.ws + WS_MIX);
    unsigned* ctl = (unsigned*)(A.ws + WS_CTL);
    if (tid == 0) {
        unsigned sp = 0u;
        while (__hip_atomic_load(ctl + CW_DSAC + 128 * layer + 64 * b + g, RLX_AGENT) < 4u) { __builtin_amdgcn_s_sleep(2);
            if ((++sp & 255u) == 0u) { if (__hip_atomic_load(ctl + CW_BAR + XB_TMO, RLX_AGENT)) break; if (sp > XB_SPIN_CAP) { atomicAdd(ctl + CW_BAR + XB_TMO, 1u); break; } } }
    }
    __syncthreads();
    __builtin_amdgcn_fence(__ATOMIC_ACQUIRE, "agent");
    LAS char* bml = lds + E1_NS * E1_STAGE;
    { const int qi = tid >> 3, e = tid & 7; const unsigned long long* src = (const unsigned long long*)(A.ws + WS_BM) + (size_t)(b * SEQ + 64 * g + qi) * 64 + e;
      for (int i = 0; 8 * i <= g; ++i) { const unsigned long long w = src[8 * i];
#pragma unroll
          for (int j = 0; j < 8; ++j) *(LAS unsigned char*)(bml + 512 * (8 * i + j) + 8 * qi + e) = (unsigned char)(w >> (8 * j)); } }
    const int c = lane & 31, qi = 8 * wid + (c >> 2), tok = b * SEQ + 64 * g + qi;
    bf16x8 q[8]; fa_loadq<8>(q, P + (size_t)tok * PP + C_AQ + (c & 3) * 128, hi, true);
    FAState st; fa_init(st);
    TFDsaE1 tf{bml + 8 * qi + 4 * hi};
    __syncthreads();
    e1_run<8>(st, q, P + (size_t)(b * SEQ) * PP + C_AK, P + (size_t)(b * SEQ) * PP + C_AV, g + 1, lds, 0.08838834764831845f * LOG2E, 0, tf, lane, wid);
    fa_normalize(st);
    fa_store(st, MIX + (size_t)tok * DM + (c & 3) * 128, hi);
}

#define XB_XCNT(j)  (256  + 64 * (j))
#define XB_XSUB(j)  (1280 + 64 * (j))
#define XB_XGEN(j)  (2304 + 64 * (j))
#define XB_TOP      3328
#define XB_TOPGEN   3392
__device__ __forceinline__ unsigned xb_ld(unsigned* p)              { return __hip_atomic_load(p, __ATOMIC_RELAXED, __HIP_MEMORY_SCOPE_AGENT); }
__device__ __forceinline__ unsigned xb_add(unsigned* p, unsigned v) { return __hip_atomic_fetch_add(p, v, __ATOMIC_RELAXED, __HIP_MEMORY_SCOPE_AGENT); }
__device__ __forceinline__ unsigned xb_xcc_id() { return (unsigned)__builtin_amdgcn_s_getreg((3 << 11) | 20) & 0xFu; }
#define XB_SPIN(cond, bar) do { unsigned _sp = 0; while (cond) { __builtin_amdgcn_s_sleep(1); \
    if ((++_sp & 255u) == 0u) { if (xb_ld(&(bar)[XB_TMO])) break; if (_sp > XB_SPIN_CAP) { atomicAdd(&(bar)[XB_TMO], 1u); break; } } } } while (0)
struct XcdBarrier { unsigned* bar; unsigned x; volatile LAS unsigned* st; };
__device__ __forceinline__ XcdBarrier xcd_barrier_post(unsigned* bar, volatile LAS unsigned* st, bool leader) {
    XcdBarrier b; b.bar = bar; b.x = xb_xcc_id(); b.st = st;
    if (leader) (void)xb_add(&bar[XB_XCNT(b.x)], 1u);
    return b;
}
__device__ __forceinline__ void xcd_barrier_complete(unsigned* bar, unsigned x, unsigned& nloc, unsigned& nx) {
    const unsigned G = gridDim.x * gridDim.y * gridDim.z;
    unsigned sum, cnt, mine, sp = 0u;
    for (;;) {
        sum = 0u; cnt = 0u; mine = 0u;
#pragma unroll
        for (unsigned j = 0; j < 16; ++j) { const unsigned c = xb_ld(&bar[XB_XCNT(j)]); sum += c; cnt += (c > 0u) ? 1u : 0u; mine = (j == x) ? c : mine; }
        if (sum == G) break;
        __builtin_amdgcn_s_sleep(1);
        if ((++sp & 255u) == 0u) { if (xb_ld(&bar[XB_TMO])) break; if (sp > XB_SPIN_CAP) { atomicAdd(&bar[XB_TMO], 1u); break; } }
    }
    nloc = mine > 0u ? mine : 1u; nx = cnt > 0u ? cnt : 1u;
}
__device__ __forceinline__ void xcd_barrier(const XcdBarrier& b, bool leader) {
    asm volatile("s_waitcnt vmcnt(0)" ::: "memory");
    __syncthreads();
    if (leader) {
        unsigned* bar = b.bar;
        __builtin_amdgcn_s_waitcnt(0);
        unsigned nloc = b.st[0], nx = b.st[1];
        if (nloc == 0u) { xcd_barrier_complete(bar, b.x, nloc, nx); b.st[0] = nloc; b.st[1] = nx; }
        const unsigned old = xb_add(&bar[XB_XSUB(b.x)], 1u);
        const unsigned gen = old / nloc;
        if (old + 1u == (gen + 1u) * nloc) {
            __builtin_amdgcn_fence(__ATOMIC_RELEASE, "agent");
            asm volatile("s_waitcnt vmcnt(0)" ::: "memory");
            const unsigned og = xb_add(&bar[XB_TOP], 1u);
            const unsigned tg = og / nx;
            if (og + 1u == (tg + 1u) * nx) xb_add(&bar[XB_TOPGEN], 1u);
            else XB_SPIN(xb_ld(&bar[XB_TOPGEN]) == tg, bar);
            __builtin_amdgcn_fence(__ATOMIC_ACQUIRE, "agent");
            xb_add(&bar[XB_XGEN(b.x)], 1u);
            asm volatile("s_waitcnt vmcnt(0)" ::: "memory");
        } else {
            XB_SPIN(xb_ld(&bar[XB_XGEN(b.x)]) == gen, bar);
            __builtin_amdgcn_fence(__ATOMIC_ACQUIRE, "agent");
            asm volatile("s_waitcnt vmcnt(0)" ::: "memory");
        }
    }
    __syncthreads();
}

struct Frame { LAS unsigned char* lds; LAS int* lctl; int wave, vcu, G; };

constexpr int NT8 = 20, NTB = 6;
constexpr size_t WIN_LAYER = 26 * MiB, WIN_BF = 10 * MiB;
struct TItem { const float* W; bf16_t* WT; int ldw, ldt, ncols, f8; };
__device__ __forceinline__ TItem decode_item(const Args& A, int it) {
    constexpr int I_IN = 208 * 32, I_OUT = 64 * 32, I_G = 32 * 32, I_D = 64 * 16;
    constexpr int N_IN = DEPTH * I_IN, N_OUT = DEPTH * I_OUT, N_GU = DEPTH * NE * 2 * I_G;
    TItem t; int r = it;
    if (r < N_IN) { const int l = r / I_IN; r -= l * I_IN; const int cb = r >> 5, kb = r & 31, bj = (cb >> 2) & 1;
        const int tile = cb >> 3, wc = cb & 3, grp = tile * 4 + wc;
        const int mode = GRP[grp][0], lo = GRP[grp][1], ho = GRP[grp][2];
        int ncols = 32, n0 = lo + (bj ? ho : 0);
        if (mode == 4) { ncols = 0; n0 = 0; } else if (mode == 3) { ncols = bj ? 0 : 16; n0 = lo; }
        t.W = A.w_in + (size_t)l * DM * PP + (size_t)(kb * 64) * PP + n0; t.ldw = PP; t.ncols = ncols; t.ldt = DM;
        if (tile < NT8) { t.f8 = 1; t.WT = (bf16_t*)(A.ws + WS_WIN + l * WIN_LAYER + (size_t)(cb * 32) * DM + kb * 64); }
        else { t.f8 = 0; t.WT = (bf16_t*)(A.ws + WS_WIN + l * WIN_LAYER + WIN_BF) + (size_t)((cb - NT8 * 8) * 32) * DM + kb * 64; }
        return t; }
    r -= N_IN;
    if (r < N_OUT) { const int l = r / I_OUT; r -= l * I_OUT; const int nb = r >> 5, kb = r & 31;
        t.W = A.w_out + (size_t)l * DM * DM + (size_t)(kb * 64) * DM + nb * 32; t.ldw = DM; t.ncols = 32; t.f8 = 0;
        t.WT = (bf16_t*)(A.ws + WS_WOUT) + (size_t)l * DM * DM + (size_t)(nb * 32) * DM + kb * 64; t.ldt = DM; return t; }
    r -= N_OUT;
    if (r < N_GU) { const int le = r / (2 * I_G); r -= le * 2 * I_G; const int up = r / I_G; r -= up * I_G; const int nb = r >> 5, kb = r & 31, n0 = nb * 32;
        t.W = (up ? A.wu : A.wg) + (size_t)le * DM * DFF + (size_t)(kb * 64) * DFF + n0; t.ldw = DFF; t.ncols = 32; t.f8 = 1;
        t.WT = (bf16_t*)((unsigned char*)(A.ws + WS_WGU) + (size_t)le * DM * DM + (size_t)(256 * (n0 >> 7) + (n0 & 127) + 128 * up) * DM + kb * 64); t.ldt = DM; return t; }
    r -= N_GU;
    { const int le = r / I_D; r -= le * I_D; const int nb = r >> 4, kb = r & 15;
      t.W = A.wd + (size_t)le * DFF * DM + (size_t)(kb * 64) * DM + nb * 32; t.ldw = DM; t.ncols = 32; t.f8 = 1;
      t.WT = (bf16_t*)((unsigned char*)(A.ws + WS_WD) + (size_t)le * DM * DFF + (size_t)(nb * 32) * DFF + kb * 64); t.ldt = DFF; return t; }
}
__device__ __forceinline__ void titem_load(const TItem& t, f32x4 (&v)[8], int lane) {
    const int c4 = (lane & 7) * 4; const bool on = c4 < t.ncols;
#pragma unroll
    for (int i = 0; i < 8; ++i) { const float* p = t.W + (size_t)((lane >> 3) + 8 * i) * t.ldw + c4; v[i] = on ? *(const f32x4*)p : (f32x4){0.f, 0.f, 0.f, 0.f}; }
}
__device__ __forceinline__ void titem_store(const TItem& t, const f32x4 (&v)[8], LAS float* scr, int lane) {
    const int c4 = (lane & 7) * 4;
#pragma unroll
    for (int i = 0; i < 8; ++i) { LAS float* d = scr + ((lane >> 3) + 8 * i) * 33 + c4; d[0] = v[i][0]; d[1] = v[i][1]; d[2] = v[i][2]; d[3] = v[i][3]; }
    asm volatile("s_waitcnt lgkmcnt(0)" ::: "memory");
    const int c = lane & 7;
#pragma unroll
    for (int j = 0; j < 4; ++j) { const int n = (lane >> 3) + 8 * j; const LAS float* s = scr + (8 * c) * 33 + n;
        if (t.f8) { u32x2 o; o.x = pk4_fp8(64.f * s[0 * 33], 64.f * s[1 * 33], 64.f * s[2 * 33], 64.f * s[3 * 33]); o.y = pk4_fp8(64.f * s[4 * 33], 64.f * s[5 * 33], 64.f * s[6 * 33], 64.f * s[7 * 33]);
            *(u32x2*)((unsigned char*)t.WT + (size_t)n * t.ldt + 8 * c) = o; }
        else { u32x4 o; o.x = cvtpk(s[0 * 33], s[1 * 33]); o.y = cvtpk(s[2 * 33], s[3 * 33]); o.z = cvtpk(s[4 * 33], s[5 * 33]); o.w = cvtpk(s[6 * 33], s[7 * 33]);
            *(u32x4*)(t.WT + (size_t)n * t.ldt + 8 * c) = o; } }
    asm volatile("s_waitcnt lgkmcnt(0)" ::: "memory");
}

constexpr int FILL_E1 = 2048, FILL_E2 = FILL_E1 + 32768, FILL_E3 = FILL_E2 + 16384, FILL_E4 = FILL_E3 + 6656, FILL_E5 = FILL_E4 + 2048, FILL_E6 = FILL_E5 + 32768, FILL_E7 = FILL_E6 + 16384;
constexpr int CW_FILL = 2048, CW_DONE = 2112;
__device__ __forceinline__ int fill_to_item(int i) {
    constexpr int N_IN = 2 * 6656, N_OUT = 2 * 2048, N_GU = 2 * 32768;
    if (i < FILL_E1) return N_IN + i;
    if (i < FILL_E2) return N_IN + N_OUT + (i - FILL_E1);
    if (i < FILL_E3) return N_IN + N_OUT + N_GU + (i - FILL_E2);
    if (i < FILL_E4) return 6656 + (i - FILL_E3);
    if (i < FILL_E5) return N_IN + 2048 + (i - FILL_E4);
    if (i < FILL_E6) return N_IN + N_OUT + 32768 + (i - FILL_E5);
    return N_IN + N_OUT + N_GU + 16384 + (i - FILL_E6);
}
__device__ __forceinline__ void fill_run(const Args& A, Frame& F, int must, bool opp, int ph) {
    unsigned* ctl = (unsigned*)(A.ws + WS_CTL);
    unsigned* qh = ctl + CW_FILL; unsigned* done = ctl + CW_DONE + 64 * ph;
    const int lane = lane_id();
    __syncthreads();
    if (opp && F.wave == 0 && lane == 0) __hip_atomic_fetch_add(done, 1u, RLX_AGENT);
    LAS float* scr = (LAS float*)(F.lds + F.wave * 16384);
    for (;;) {
        __syncthreads();
        if (F.wave == 0 && lane == 0) {
            int base = FILL_E7; const int head = (int)__hip_atomic_load(qh, RLX_AGENT);
            bool go = head < FILL_E7;
            if (go && head >= must) go = opp && (int)__hip_atomic_load(done, RLX_AGENT) < F.G;
            if (go) base = (int)__hip_atomic_fetch_add(qh, 16u, RLX_AGENT);
            F.lctl[1] = base;
        }
        __syncthreads();
        const int base = F.lctl[1];
        if (base >= FILL_E7) break;
        const int i0 = base + 2 * F.wave, i1 = i0 + 1;
        f32x4 va[8], vb[8]; TItem ta, tb;
        if (i0 < FILL_E7) { ta = decode_item(A, fill_to_item(i0)); titem_load(ta, va, lane); }
        if (i1 < FILL_E7) { tb = decode_item(A, fill_to_item(i1)); titem_load(tb, vb, lane); }
#ifndef PROBE_FILL2
#define PROBE_FILL2 0
#endif
        if (i0 < FILL_E7) titem_store(ta, va, scr, lane);
        if (i1 < FILL_E7) titem_store(tb, vb, scr, lane);
        if (PROBE_FILL2) {
            if (i0 < FILL_E7) { titem_load(ta, va, lane); } if (i1 < FILL_E7) { titem_load(tb, vb, lane); }
            if (i0 < FILL_E7) titem_store(ta, va, scr, lane); if (i1 < FILL_E7) titem_store(tb, vb, scr, lane); }
    }
}

__device__ __forceinline__ void phase_prologue(const Args& A, Frame& F) {
    LAS float* scr = (LAS float*)(F.lds + F.wave * 16384);
    const int lane = lane_id(), tid = F.wave * 64 + lane;
    const int gw = F.vcu * 8 + F.wave, NGW = F.G * 8;
    constexpr int NITEMS = 208 * 32;
    {
        f32x4 va[8], vb[8]; TItem ta, tb;
        int it = gw;
        if (it < NITEMS) { ta = decode_item(A, it); titem_load(ta, va, lane); }
        while (it < NITEMS) {
            const int it1 = it + NGW, it2 = it + 2 * NGW;
            if (it1 < NITEMS) { tb = decode_item(A, it1); titem_load(tb, vb, lane); }
            titem_store(ta, va, scr, lane);
            if (it1 >= NITEMS) break;
            if (it2 < NITEMS) { ta = decode_item(A, it2); titem_load(ta, va, lane); }
            titem_store(tb, vb, scr, lane);
            it = it2;
        }
    }
    { const int gt = F.vcu * 512 + tid, NT = F.G * 512; bf16_t* XB = (bf16_t*)(A.ws + WS_XB);
      for (size_t i = gt; i < (size_t)T * DM / 8; i += NT) { const f32x4 a = ((const f32x4*)A.x)[2 * i], c = ((const f32x4*)A.x)[2 * i + 1];
          u32x4 w; w.x = cvtpk(a[0], a[1]); w.y = cvtpk(a[2], a[3]); w.z = cvtpk(c[0], c[1]); w.w = cvtpk(c[2], c[3]); ((u32x4*)XB)[i] = w;
          u32x2 q8; q8.x = pk4_fp8(a[0], a[1], a[2], a[3]); q8.y = pk4_fp8(c[0], c[1], c[2], c[3]); ((u32x2*)(A.ws + WS_XQ))[i] = q8; } }
    { const int gt = F.vcu * 512 + tid, NT = F.G * 512; f32x2* r128 = (f32x2*)(A.ws + WS_R128); f32x2* r64 = (f32x2*)(A.ws + WS_R64);
      for (int i = gt; i < T * 64; i += NT) { const int tk = i >> 6, f = i & 63; const float inv = powf(10000.f, -(float)(2 * f) / 128.f), ang = (float)A.pos[tk] * inv; r128[i] = (f32x2){cosf(ang), sinf(ang)}; }
      for (int i = gt; i < T * 32; i += NT) { const int tk = i >> 5, f = i & 31; const float inv = powf(10000.f, -(float)(2 * f) / 64.f), ang = (float)A.pos[tk] * inv; r64[i] = (f32x2){cosf(ang), sinf(ang)}; } }
}

__device__ __forceinline__ void phase_proj(const Args& A, Frame& F, int layer) {
    float* kms = (float*)(A.ws + WS_CTL + KM_OFF) + (size_t)layer * NB * 16 * 512;
    {
        pg8::DenseOrder S; S.init(T, NT8 * 256, DM / 2, A.ws + WS_WIN + layer * WIN_LAYER, F.G, (int)blockIdx.x);
        EpiProj E{(bf16_t*)(A.ws + WS_PROJ), (const f32x2*)(A.ws + WS_R128), (const f32x2*)(A.ws + WS_R64), kms, 0};
        pg8::gemm_phase<EpiProj, pg8::DenseOrder, false, true>(F.lds, (const bf16_t*)(A.ws + WS_XQ), DM / 2, S, E, F.wave);
    }
    {
        pg8::DenseOrder S; S.init(T, NTB * 256, DM, A.ws + WS_WIN + layer * WIN_LAYER + WIN_BF, F.G, (int)blockIdx.x);
        EpiProj E{(bf16_t*)(A.ws + WS_PROJ), (const f32x2*)(A.ws + WS_R128), (const f32x2*)(A.ws + WS_R64), kms, NT8};
        pg8::gemm_phase<EpiProj, pg8::DenseOrder, false, false>(F.lds, (const bf16_t*)(A.ws + WS_XB), DM, S, E, F.wave);
    }
}

constexpr int N_MIX_UNITS = 1152;
__device__ __forceinline__ void phase_mixers(const Args& A, Frame& F, int layer, int rep) {
    unsigned* qh = (unsigned*)(A.ws + WS_CTL) + CW_QUEUE + 64 * layer + 16 * rep;
    LAS char* lds = (LAS char*)F.lds;
    for (;;) {
        __syncthreads();
        if (F.wave == 0 && lane_id() == 0) F.lctl[0] = (int)__hip_atomic_fetch_add(qh, 1u, RLX_AGENT);
        __syncthreads();
        const int u = F.lctl[0];
        if (u >= N_MIX_UNITS) break;
#ifndef UNIT_ONLY
#define UNIT_ONLY (rep == 0 ? 31 : PROBE_MIX)
#endif
#ifndef PROBE_DSA
#define PROBE_DSA 3
#endif
#ifndef PROBE_MIX
#define PROBE_MIX 31
#endif
        int kind, p0, p1;
        if (u < 512)       { kind = 2; p0 = 31 - (u >> 4); p1 = u & 15; }
        else if (u < 640)  { kind = 3; p0 = u - 512; p1 = 0; }
        else if (u < 704)  { kind = 1; p0 = (u - 640) & 7; p1 = 15 - ((u - 640) >> 3); }
        else if (u < 768)  { kind = 0; p0 = (u - 704) & 7; p1 = 31 - ((u - 704) >> 3); }
        else if (u < 832)  { kind = 4; p0 = (u - 768) & 1; p1 = 63 - ((u - 768) >> 1); }
        else if (u < 864)  { kind = 1; p0 = (u - 832) & 7; p1 = 7 - ((u - 832) >> 3); }
        else if (u < 928)  { kind = 0; p0 = (u - 864) & 7; p1 = 23 - ((u - 864) >> 3); }
        else if (u < 960)  { kind = 1; p0 = (u - 928) & 7; p1 = 3 - ((u - 928) >> 3); }
        else { const int v = u - 960, L = 15 - v / 12, w = v % 12;
            if (w < 8) { kind = 0; p0 = w; p1 = L; } else { kind = 4; p0 = (w - 8) & 1; p1 = 2 * L + 1 - ((w - 8) >> 1); } }
        if (kind == 0) { if (UNIT_ONLY & 1) diff_unit(A, layer, p0 >> 2, p0 & 3, p1, lds, F.wave); continue; }
        if (kind == 1) { if (UNIT_ONLY & 2) moba_unit(A, layer, p0 >> 2, p0 & 3, p1, lds, F.wave); continue; }
        if (kind == 2) { if (UNIT_ONLY & 4) dsa_unit(A, layer, p1 >> 3, 128 * p0 + 16 * (p1 & 7), lds, F.wave, rep == 0 ? 3 : PROBE_DSA); continue; }
        if (kind == 4) { if (UNIT_ONLY & 16) dsa_att_unit(A, layer, p0, p1, lds, F.wave); continue; }
        { if (UNIT_ONLY & 8) dil_unit(A, p0 >> 6, (p0 >> 4) & 3, p0 & 15, lds, F.wave); }
    }
}

__device__ __forceinline__ void phase_outproj(const Args& A, Frame& F, int layer) {
    pg8::DenseOrder S; S.init(T, DM, DM, (const bf16_t*)(A.ws + WS_WOUT) + (size_t)layer * DM * DM, F.G, (int)blockIdx.x);
    EpiOut E{layer == 0 ? A.x : (const float*)(A.ws + WS_XF2), (bf16_t*)(A.ws + WS_Y1)};
    pg8::gemm_phase<EpiOut, pg8::DenseOrder, false>(F.lds, (const bf16_t*)(A.ws + WS_MIX), DM, S, E, F.wave);
}

__device__ __forceinline__ void route_token(const float (&lg)[16], const float* rb, LAS int* lcnt, float* tok_gate, int* tok_e, int* tok_rank, int tk, int lane) {
    float aff[16], sc[16];
#pragma unroll
    for (int e = 0; e < 16; ++e) { aff[e] = 1.f / (1.f + expf(-lg[e])); sc[e] = aff[e] + rb[e]; }
    float gbest = NEG_INF; int gi = 0;
#pragma unroll
    for (int k = 0; k < 4; ++k) {
        const float a = sc[4 * k], b = sc[4 * k + 1], c = sc[4 * k + 2], d = sc[4 * k + 3];
        const float m1 = fmaxf(fmaxf(a, b), fmaxf(c, d));
        const float lo1 = fminf(a, b), hi1 = fmaxf(a, b), lo2 = fminf(c, d), hi2 = fmaxf(c, d);
        const float m2 = fmaxf(fminf(hi1, hi2), fmaxf(lo1, lo2));
        const float gs = m1 + m2;
        if (gs > gbest) { gbest = gs; gi = k; }
    }
    float s0 = sc[0], s1 = sc[1], s2_ = sc[2], s3 = sc[3], a0 = aff[0], a1 = aff[1], a2 = aff[2], a3 = aff[3];
#pragma unroll
    for (int k = 1; k < 4; ++k) if (gi == k) { s0 = sc[4 * k]; s1 = sc[4 * k + 1]; s2_ = sc[4 * k + 2]; s3 = sc[4 * k + 3]; a0 = aff[4 * k]; a1 = aff[4 * k + 1]; a2 = aff[4 * k + 2]; a3 = aff[4 * k + 3]; }
    int i1 = 0; float b1 = s0;
    if (s1 > b1) { b1 = s1; i1 = 1; } if (s2_ > b1) { b1 = s2_; i1 = 2; } if (s3 > b1) { b1 = s3; i1 = 3; }
    int i2 = -1; float b2 = NEG_INF;
    if (i1 != 0 && (i2 < 0 || s0 > b2)) { b2 = s0; i2 = 0; }
    if (i1 != 1 && (i2 < 0 || s1 > b2)) { b2 = s1; i2 = 1; }
    if (i1 != 2 && (i2 < 0 || s2_ > b2)) { b2 = s2_; i2 = 2; }
    if (i1 != 3 && (i2 < 0 || s3 > b2)) { b2 = s3; i2 = 3; }
    const float g1 = i1 == 0 ? a0 : i1 == 1 ? a1 : i1 == 2 ? a2 : a3, g2 = i2 == 0 ? a0 : i2 == 1 ? a1 : i2 == 2 ? a2 : a3;
    if (lane == 0) {
        const int e1 = gi * 4 + i1, e2 = gi * 4 + i2; const float gsum = g1 + g2;
        const int r1 = __hip_atomic_fetch_add(lcnt + e1, 1, __ATOMIC_RELAXED, __HIP_MEMORY_SCOPE_WORKGROUP), r2 = __hip_atomic_fetch_add(lcnt + e2, 1, __ATOMIC_RELAXED, __HIP_MEMORY_SCOPE_WORKGROUP);
        tok_e[2 * tk] = e1; tok_e[2 * tk + 1] = e2; tok_rank[2 * tk] = r1; tok_rank[2 * tk + 1] = r2; tok_gate[2 * tk] = g1 / gsum; tok_gate[2 * tk + 1] = g2 / gsum;
    }
}
__device__ __forceinline__ void phase_ln1_router(const Args& A, Frame& F, int layer) {
    const int lane = lane_id(), tid = F.wave * 64 + lane;
    LAS f32x4* wl = (LAS f32x4*)F.lds;
    for (int i = tid; i < 4 * 8 * 4 * 64; i += 512) { const int l = i & 63, c = (i >> 6) & 3, j = (i >> 8) & 7, q = i >> 11; wl[i] = *(const f32x4*)(A.rw + (size_t)(256 * j + 4 * l + c) * 16 + 4 * q); }
    if (tid < 16) F.lctl[96 + tid] = 0;
    __syncthreads();
    bf16_t* Y1 = (bf16_t*)(A.ws + WS_Y1); unsigned char* X1Q = (unsigned char*)(A.ws + WS_X1B);
    int* tok_e = (int*)(A.ws + WS_ROUTE + RT_TOKE); int* tok_rank = (int*)(A.ws + WS_ROUTE + RT_RANK); float* tok_gate = (float*)(A.ws + WS_ROUTE + RT_TOKG);
    LAS int* lcnt = F.lctl + 96;
    const float* g = A.lmg + layer * DM; const float* bb = A.lmb + layer * DM;
    constexpr int TPW = 2;
    u32x2 nx[TPW][8];
    { const int tkf = (F.vcu * 8 + F.wave) * TPW;
#pragma unroll
      for (int u = 0; u < TPW; ++u)
#pragma unroll
          for (int j = 0; j < 8; ++j) nx[u][j] = *(const u32x2*)(Y1 + (size_t)(tkf + u) * DM + 256 * j + 4 * lane); }
#pragma clang loop unroll(disable)
    for (int tk0 = (F.vcu * 8 + F.wave) * TPW; tk0 < T; tk0 += F.G * 8 * TPW) {
        f32x4 v[TPW][8]; float mean[TPW], rstd[TPW];
#pragma unroll
        for (int u = 0; u < TPW; ++u)
#pragma unroll
            for (int j = 0; j < 8; ++j) { const u32x2 y = nx[u][j]; v[u][j][0] = bflo(y.x); v[u][j][1] = bfhi(y.x); v[u][j][2] = bflo(y.y); v[u][j][3] = bfhi(y.y); }
        { const int tkn = tk0 + F.G * 8 * TPW;
          if (tkn < T) {
#pragma unroll
              for (int u = 0; u < TPW; ++u)
#pragma unroll
                  for (int j = 0; j < 8; ++j) nx[u][j] = *(const u32x2*)(Y1 + (size_t)(tkn + u) * DM + 256 * j + 4 * lane); } }
#pragma unroll
        for (int u = 0; u < TPW; ++u) { float s = 0.f;
#pragma unroll
            for (int j = 0; j < 8; ++j) s += (v[u][j][0] + v[u][j][1]) + (v[u][j][2] + v[u][j][3]);
            mean[u] = s; }
#pragma unroll
        for (int u = 0; u < TPW; ++u) mean[u] = allsum(mean[u]);
#pragma unroll
        for (int u = 0; u < TPW; ++u) { mean[u] *= (1.f / DM); float s2 = 0.f;
#pragma unroll
            for (int j = 0; j < 8; ++j) { v[u][j] = v[u][j] - mean[u]; s2 += (v[u][j][0] * v[u][j][0] + v[u][j][1] * v[u][j][1]) + (v[u][j][2] * v[u][j][2] + v[u][j][3] * v[u][j][3]); }
            rstd[u] = s2; }
#pragma unroll
        for (int u = 0; u < TPW; ++u) rstd[u] = allsum(rstd[u]);
#pragma unroll
        for (int u = 0; u < TPW; ++u) rstd[u] = rsqrtf(rstd[u] * (1.f / DM) + LN_EPS);
        float lg[TPW][16];
#pragma unroll
        for (int u = 0; u < TPW; ++u)
#pragma unroll
            for (int e = 0; e < 16; ++e) lg[u][e] = 0.f;
#pragma unroll
        for (int j = 0; j < 8; ++j) {
            const f32x4 gg = *(const f32x4*)(g + 256 * j + 4 * lane), b4 = *(const f32x4*)(bb + 256 * j + 4 * lane);
#pragma unroll
            for (int u = 0; u < TPW; ++u) {
                v[u][j] = v[u][j] * rstd[u] * gg + b4;
                { u32x2 w; w.x = cvtpk(v[u][j][0], v[u][j][1]); w.y = cvtpk(v[u][j][2], v[u][j][3]); *(u32x2*)(Y1 + (size_t)(tk0 + u) * DM + 256 * j + 4 * lane) = w; }
                *(unsigned*)(X1Q + (size_t)(tk0 + u) * DM + 256 * j + 4 * lane) = pk4_fp8(v[u][j][0], v[u][j][1], v[u][j][2], v[u][j][3]);
            }
#pragma unroll
            for (int c = 0; c < 4; ++c) {
#pragma unroll
                for (int q = 0; q < 4; ++q) { const f32x4 w4 = wl[((q * 8 + j) * 4 + c) * 64 + lane];
#pragma unroll
                    for (int u = 0; u < TPW; ++u) { lg[u][4 * q] += v[u][j][c] * w4[0]; lg[u][4 * q + 1] += v[u][j][c] * w4[1]; lg[u][4 * q + 2] += v[u][j][c] * w4[2]; lg[u][4 * q + 3] += v[u][j][c] * w4[3]; } }
                __builtin_amdgcn_sched_barrier(0);
            }
        }
#pragma unroll
        for (int u = 0; u < TPW; ++u)
#pragma unroll
            for (int e = 0; e < 16; ++e) lg[u][e] = allsum(lg[u][e]);
#pragma unroll
        for (int u = 0; u < TPW; ++u) route_token(lg[u], A.rb, lcnt, tok_gate, tok_e, tok_rank, tk0 + u, lane);
    }
    __syncthreads();
    { const int t2 = F.wave * 64 + lane_id();
      if (t2 < 16) ((int*)(A.ws + WS_ROUTE + RT_BLK))[F.vcu * 16 + t2] = lcnt[t2]; }
}
__device__ __forceinline__ void route_finish(const Args& A, Frame& F, int layer) {
    const int lane = lane_id(), tid = F.wave * 64 + lane;
    LAS int* tab = (LAS int*)F.lds;
    const int* blk = (const int*)(A.ws + WS_ROUTE + RT_BLK);
    for (int i = tid; i < F.G * 16; i += 512) tab[i] = blk[i];
    __syncthreads();
    if (tid < 16) { int base = 0, tot = 0;
        for (int b = 0; b < F.G; ++b) { const int c = tab[b * 16 + tid]; tot += c; if (b < F.vcu) base += c; }
        F.lctl[112 + tid] = base;
        if (F.vcu == 0) ((unsigned*)(A.ws + WS_CTL) + CW_CNT + 64 * layer)[tid] = (unsigned)tot; }
    __syncthreads();
    const int* tok_e = (const int*)(A.ws + WS_ROUTE + RT_TOKE); int* tok_rank = (int*)(A.ws + WS_ROUTE + RT_RANK); const float* tok_gate = (const float*)(A.ws + WS_ROUTE + RT_TOKG);
    int* tok_list = (int*)(A.ws + WS_ROUTE + RT_LIST); float* sgate = (float*)(A.ws + WS_ROUTE + RT_GATE);
    if (tid < 64) {
        const int k = tid & 1, u = (tid >> 1) & 1, w = (tid >> 2) & 7, it = tid >> 5;
        const int tk = (F.vcu * 8 + w) * 2 + u + F.G * 16 * it;
        if (tk < T) { const int e = tok_e[2 * tk + k], r = F.lctl[112 + e] + tok_rank[2 * tk + k];
            tok_rank[2 * tk + k] = r; tok_list[e * 8192 + r] = tk; sgate[e * 8192 + r] = tok_gate[2 * tk + k]; } }
}

__device__ __forceinline__ void moe_table(const Args& A, Frame& F, int layer) {
    __syncthreads();
    if (F.wave == 0 && lane_id() == 0) {
        const unsigned* cnt = (const unsigned*)(A.ws + WS_CTL) + CW_CNT + 64 * layer;
        int ps = 0, ub = 0;
        for (int e = 0; e < 16; ++e) { const int c = (int)__hip_atomic_load(cnt + e, RLX_AGENT), mt = (c + 255) >> 8;
            F.lctl[16 + e] = c; F.lctl[32 + e] = ps; F.lctl[48 + e] = ub; ps += mt * 256; ub += mt * 8; }
        F.lctl[48 + 16] = ub;
    }
    __syncthreads();
}
__device__ __forceinline__ void phase_moe_gu(const Args& A, Frame& F, int layer) {
    moe_table(A, F, layer);
    MoeSched S{F.lctl + 16, F.G, F.vcu, DM / 2, (const char*)(A.ws + WS_WGU) + (size_t)layer * NE * DM * DM, (size_t)DM * DM, (const int*)(A.ws + WS_ROUTE + RT_LIST), 1};
    EpiGU E{(unsigned char*)(A.ws + WS_H)};
    pg8::gemm_phase<EpiGU, MoeSched, true, true>(F.lds, (const bf16_t*)(A.ws + WS_X1B), DM / 2, S, E, F.wave);
}
__device__ __forceinline__ void phase_moe_down(const Args& A, Frame& F, int layer) {
    moe_table(A, F, layer);
    MoeSched S{F.lctl + 16, F.G, F.vcu, DFF / 2, (const char*)(A.ws + WS_WD) + (size_t)layer * NE * DM * DFF, (size_t)DM * DFF, nullptr, 0};
    EpiDown E{(bf16_t*)(A.ws + WS_YS), (const float*)(A.ws + WS_ROUTE + RT_GATE)};
    pg8::gemm_phase<EpiDown, MoeSched, false, true>(F.lds, (const bf16_t*)(A.ws + WS_H), DFF / 2, S, E, F.wave);
}

__device__ __forceinline__ void phase_final_ln(const Args& A, Frame& F, int layer) {
    moe_table(A, F, layer);
    const int lane = lane_id();
    const bf16_t* X1 = (const bf16_t*)(A.ws + WS_Y1); const bf16_t* YS = (const bf16_t*)(A.ws + WS_YS);
    const int* tok_e = (const int*)(A.ws + WS_ROUTE + RT_TOKE); const int* tok_rank = (const int*)(A.ws + WS_ROUTE + RT_RANK);
    const float* g = A.lfg + layer * DM; const float* bb = A.lfb + layer * DM;
    float* XO = layer == DEPTH - 1 ? A.out : (float*)(A.ws + WS_XF2); bf16_t* XB = (bf16_t*)(A.ws + WS_XB);
    constexpr int TPW = 4;
    for (int tk0 = (F.vcu * 8 + F.wave) * TPW; tk0 < T; tk0 += F.G * 8 * TPW) {
        f32x4 v[TPW][8]; float mean[TPW], rstd[TPW]; size_t s1[TPW], s2[TPW];
#pragma unroll
        for (int u = 0; u < TPW; ++u) { const int tk = tk0 + u; const int e1 = tok_e[2 * tk], e2 = tok_e[2 * tk + 1];
            s1[u] = (size_t)(F.lctl[32 + e1] + tok_rank[2 * tk]) * DM; s2[u] = (size_t)(F.lctl[32 + e2] + tok_rank[2 * tk + 1]) * DM; }
#pragma unroll
        for (int u = 0; u < TPW; ++u) {
#pragma unroll
            for (int j = 0; j < 8; ++j) { const int k = 256 * j + 4 * lane; const u32x2 xw = *(const u32x2*)(X1 + (size_t)(tk0 + u) * DM + k); const float x[4] = {bflo(xw.x), bfhi(xw.x), bflo(xw.y), bfhi(xw.y)};
                const u32x2 ya = *(const u32x2*)(YS + s1[u] + k), yb = *(const u32x2*)(YS + s2[u] + k);
                v[u][j][0] = x[0] * ALPHA + (bflo(ya.x) + bflo(yb.x)); v[u][j][1] = x[1] * ALPHA + (bfhi(ya.x) + bfhi(yb.x));
                v[u][j][2] = x[2] * ALPHA + (bflo(ya.y) + bflo(yb.y)); v[u][j][3] = x[3] * ALPHA + (bfhi(ya.y) + bfhi(yb.y)); } }
#pragma unroll
        for (int u = 0; u < TPW; ++u) { float s = 0.f;
#pragma unroll
            for (int j = 0; j < 8; ++j) s += (v[u][j][0] + v[u][j][1]) + (v[u][j][2] + v[u][j][3]);
            mean[u] = s; }
#pragma unroll
        for (int u = 0; u < TPW; ++u) mean[u] = allsum(mean[u]);
#pragma unroll
        for (int u = 0; u < TPW; ++u) { mean[u] *= (1.f / DM); float q2 = 0.f;
#pragma unroll
            for (int j = 0; j < 8; ++j) { v[u][j] = v[u][j] - mean[u]; q2 += (v[u][j][0] * v[u][j][0] + v[u][j][1] * v[u][j][1]) + (v[u][j][2] * v[u][j][2] + v[u][j][3] * v[u][j][3]); }
            rstd[u] = q2; }
#pragma unroll
        for (int u = 0; u < TPW; ++u) rstd[u] = allsum(rstd[u]);
#pragma unroll
        for (int u = 0; u < TPW; ++u) rstd[u] = rsqrtf(rstd[u] * (1.f / DM) + LN_EPS);
#pragma unroll
        for (int j = 0; j < 8; ++j) { const int k = 256 * j + 4 * lane; const f32x4 gg = *(const f32x4*)(g + k), b4 = *(const f32x4*)(bb + k);
#pragma unroll
            for (int u = 0; u < TPW; ++u) { const f32x4 o = v[u][j] * rstd[u] * gg + b4; *(f32x4*)(XO + (size_t)(tk0 + u) * DM + k) = o;
                if (layer != DEPTH - 1) { u32x2 w; w.x = cvtpk(o[0], o[1]); w.y = cvtpk(o[2], o[3]); *(u32x2*)(XB + (size_t)(tk0 + u) * DM + k) = w;
                    *(unsigned*)(A.ws + WS_XQ + (size_t)(tk0 + u) * DM + k) = pk4_fp8(o[0], o[1], o[2], o[3]); } } }
    }
}

constexpr int N_PHASES = 1 + 7 * DEPTH;
__global__ void __launch_bounds__(512, 2) fwd(Args A_karg) {
    extern __shared__ __attribute__((aligned(16))) unsigned char lds_raw[];
    Frame F; F.lds = (LAS unsigned char*)lds_raw; F.lctl = (LAS int*)(F.lds + LDS_CTL_OFF);
    const int wave0 = __builtin_amdgcn_readfirstlane((int)threadIdx.x >> 6); F.wave = wave0;
    F.G = gridDim.x; { const int bx = blockIdx.x; F.vcu = (F.G % 8 == 0) ? (bx % 8) * (F.G / 8) + bx / 8 : bx; }
    const int vcu0 = F.vcu;
    const int lo = A_karg.ph_lo, hi = A_karg.ph_hi;
#ifndef USE_CG_SYNC
#define USE_CG_SYNC 0
#endif
    const bool leader = (wave0 == 0 && lane_id() == 0);
    if (leader) { F.lctl[8] = 0; F.lctl[9] = 0; }
    __syncthreads();
    XcdBarrier xbar; xbar.bar = nullptr; xbar.x = 0; xbar.st = nullptr;
    if (!USE_CG_SYNC && hi - lo > 1) xbar = xcd_barrier_post((unsigned*)(A_karg.ws + WS_CTL) + CW_BAR, (volatile LAS unsigned*)(F.lctl + 8), leader);
    typedef const __attribute__((address_space(4))) Args* kargp_t;
    int ph = lo, rep = 0;
    while (ph < hi) {
        kargp_t kp = (kargp_t)__builtin_amdgcn_kernarg_segment_ptr(); asm volatile("" : "+s"(kp));
        Args A; A.x = kp->x; A.pos = kp->pos; A.w_in = kp->w_in; A.w_out = kp->w_out; A.dlam = kp->dlam; A.dng = kp->dng; A.lmg = kp->lmg; A.lmb = kp->lmb; A.rw = kp->rw; A.rb = kp->rb;
        A.wg = kp->wg; A.wu = kp->wu; A.wd = kp->wd; A.lfg = kp->lfg; A.lfb = kp->lfb; A.out = kp->out; A.ws = kp->ws; A.ph_lo = lo; A.ph_hi = hi;
        { int w_ = wave0, c_ = vcu0, g_ = (int)gridDim.x; asm volatile("" : "+s"(w_), "+s"(c_), "+s"(g_)); F.wave = w_; F.vcu = c_; F.G = g_; }
#ifdef PHASE_ONLY
        { const int layer = ph & 1;
          if (PHASE_ONLY == 0) phase_prologue(A, F);
          if (PHASE_ONLY == 1) phase_proj(A, F, layer);
          if (PHASE_ONLY == 2) phase_mixers(A, F, layer, 0);
          if (PHASE_ONLY == 3) phase_outproj(A, F, layer);
          if (PHASE_ONLY == 4) phase_ln1_router(A, F, layer);
          if (PHASE_ONLY == 5) phase_moe_gu(A, F, layer);
          if (PHASE_ONLY == 6) phase_moe_down(A, F, layer);
          if (PHASE_ONLY == 7) phase_final_ln(A, F, layer);
          ++ph; continue; }
#endif
#ifndef PROBE_REP
#define PROBE_REP 0
#endif
        const int kind = ph == 0 ? 0 : 1 + (ph - 1) % 7;
        if (ph == 0) phase_prologue(A, F);
        else {
            const int layer = (ph - 1) / 7, k = (ph - 1) % 7;
            if (k == 0) phase_proj(A, F, layer);
            else if (k == 1) phase_mixers(A, F, layer, rep);
            else if (k == 2) phase_outproj(A, F, layer);
            else if (k == 3) phase_ln1_router(A, F, layer);
            else if (k == 4) phase_moe_gu(A, F, layer);
            else if (k == 5) phase_moe_down(A, F, layer);
            else phase_final_ln(A, F, layer);
        }
        if (ph > 0 && (ph - 1) % 7 == 3 && rep == 0) {
            if (USE_CG_SYNC) cg::this_grid().sync(); else xcd_barrier(xbar, wave0 == 0 && lane_id() == 0);
            route_finish(A, F, (ph - 1) / 7);
        }
        {
            const int k7 = ph == 0 ? -1 : (ph - 1) % 7, lay = ph == 0 ? 0 : (ph - 1) / 7;
            int must = 0; bool opp = false;
            if (k7 == 0) { opp = true; }
            else if (k7 == 1) { must = lay == 0 ? FILL_E1 : FILL_E5; opp = true; }
            else if (k7 == 3) { must = lay == 0 ? FILL_E2 : FILL_E6; }
            else if (k7 == 4) { must = lay == 0 ? FILL_E3 : FILL_E7; opp = true; }
            else if (k7 == 5) { opp = true; }
            else if (k7 == 6) { must = lay == 0 ? FILL_E4 : FILL_E7; }
            if (ph > 0 && rep == 0 && (must > 0 || opp)) fill_run(A, F, must, opp, ph);
        }
        if (rep == 0 && ((PROBE_REP >> kind) & 1)) rep = 1; else { rep = 0; ++ph; }
#ifndef PROBE_SYNC
#define PROBE_SYNC 1
#endif
        if (ph < hi) { for (int k_ = 0; k_ < PROBE_SYNC; ++k_) { if (USE_CG_SYNC) cg::this_grid().sync(); else xcd_barrier(xbar, wave0 == 0 && lane_id() == 0); } }
    }
}

extern "C" void kernel_launch(void* const* d_in, const int* in_sizes, int n_in, void* d_out, int out_size, void* d_ws, size_t ws_size, hipStream_t stream) {
    static int grid = 0;
    if (grid == 0) {
        if (n_in != 15 || ws_size < WS_END) { fprintf(stderr, "kernel_launch: unexpected inputs (n_in %d, ws %zu)\n", n_in, ws_size); grid = -1; return; }
        int dev = 0, cus = 0, per_cu = 0;
        hipGetDevice(&dev); hipDeviceGetAttribute(&cus, hipDeviceAttributeMultiprocessorCount, dev);
        hipFuncSetAttribute((const void*)fwd, hipFuncAttributeMaxDynamicSharedMemorySize, LDS_BYTES);
        hipOccupancyMaxActiveBlocksPerMultiprocessor(&per_cu, (const void*)fwd, 512, LDS_BYTES);
        if (per_cu < 1) { fprintf(stderr, "kernel_launch: occupancy query says %d blocks per CU\n", per_cu); per_cu = 1; }
        (void)hipGetLastError();
        grid = cus;
    }
    if (grid < 0) return;
    hipMemsetAsync((char*)d_ws + WS_CTL, 0, CTL_BYTES, stream);
    Args a{};
    a.x = (const float*)d_in[0]; a.pos = (const int*)d_in[1]; a.w_in = (const float*)d_in[2]; a.w_out = (const float*)d_in[3]; a.dlam = (const float*)d_in[4]; a.dng = (const float*)d_in[5];
    a.lmg = (const float*)d_in[6]; a.lmb = (const float*)d_in[7]; a.rw = (const float*)d_in[8]; a.rb = (const float*)d_in[9]; a.wg = (const float*)d_in[10]; a.wu = (const float*)d_in[11];
    a.wd = (const float*)d_in[12]; a.lfg = (const float*)d_in[13]; a.lfb = (const float*)d_in[14]; a.out = (float*)d_out; a.ws = (unsigned char*)d_ws;
#if MK_N_LAUNCHES == 1
    a.ph_lo = 0; a.ph_hi = N_PHASES;
    void* args[] = {&a};
    hipError_t e = hipLaunchCooperativeKernel((const void*)fwd, dim3(grid), dim3(512), args, LDS_BYTES, stream);
    if (e != hipSuccess) fprintf(stderr, "cooperative launch failed: %s (grid %d)\n", hipGetErrorString(e), grid);
#else
    for (int ph = 0; ph < N_PHASES; ++ph) { a.ph_lo = ph; a.ph_hi = ph + 1; hipLaunchKernelGGL(fwd, dim3(grid), dim3(512), LDS_BYTES, stream, a); }
#endif
}
```

```cpp
#include <hip/hip_runtime.h>
#include <hip/hip_cooperative_groups.h>
#include <cstdio>
#include <cstdint>
namespace cg = cooperative_groups;

#ifndef MK_N_LAUNCHES
#define MK_N_LAUNCHES 1
#endif

#define LAS __attribute__((address_space(3)))
typedef unsigned short bf16_t;
typedef short bf16x8 __attribute__((ext_vector_type(8)));
typedef short s16x4 __attribute__((ext_vector_type(4)));
typedef float f32x2 __attribute__((ext_vector_type(2)));
typedef float f32x4 __attribute__((ext_vector_type(4)));
typedef float f32x16 __attribute__((ext_vector_type(16)));
typedef unsigned u32x2 __attribute__((ext_vector_type(2)));
typedef unsigned u32x4 __attribute__((ext_vector_type(4)));
typedef __bf16 bf16x2_t __attribute__((ext_vector_type(2)));
typedef int v8i32_t __attribute__((ext_vector_type(8)));

constexpr int NB = 2, SEQ = 4096, T = NB * SEQ, DM = 2048, DEPTH = 2;
constexpr int PP = 6480;
constexpr int NPROJ = 6656;
constexpr int C_AQ = 0, C_AK = 512, C_AV = 640, C_IQ = 768, C_IK = 1792, C_IW = 1856, C_BQ = 1872, C_BK = 2384, C_BV = 2896,
              C_CQ = 3408, C_CK = 3920, C_CV = 4432, C_DQ = 4944, C_DK = 5456, C_DV = 5968;
constexpr int NE = 16, DFF = 1024, HROWS = 20480;
constexpr float LN_EPS = 1e-5f;
constexpr float ALPHA = 1.41421356237309515f;
constexpr float LOG2E = 1.4426950408889634f;
constexpr float NEG_INF = -__builtin_huge_valf();

constexpr size_t MiB = 1u << 20;
constexpr size_t WS_CTL = 0, CTL_BYTES = 1 * MiB;
constexpr size_t WS_WIN = 1 * MiB;
constexpr size_t WS_WOUT = 53 * MiB;
constexpr size_t WS_WGU = 69 * MiB;
constexpr size_t WS_WD = 325 * MiB;
constexpr size_t WS_XB = 453 * MiB;
constexpr size_t WS_PROJ = 485 * MiB;
constexpr size_t WS_MIX = 587 * MiB;
constexpr size_t WS_Y1 = 619 * MiB;
constexpr size_t WS_XF2 = 683 * MiB;
constexpr size_t WS_X1B = 747 * MiB;
constexpr size_t WS_XQ = 763 * MiB;
constexpr size_t WS_H = 780 * MiB;
constexpr size_t WS_YS = 820 * MiB;
constexpr size_t WS_R128 = 900 * MiB;
constexpr size_t WS_R64 = 904 * MiB;
constexpr size_t WS_ROUTE = 906 * MiB;
constexpr size_t WS_BM = 910 * MiB;
constexpr size_t WS_END = 914 * MiB;
constexpr size_t RT_TOKE = 0, RT_RANK = 65536, RT_LIST = 131072, RT_GATE = 131072 + 524288;
constexpr size_t RT_TOKG = 2 * MiB, RT_BLK = 2 * MiB + 65536;
constexpr int CW_QUEUE = 64;
constexpr int CW_CNT = 1024;
constexpr int CW_BAR = 4096;
#define XB_TMO      128
#define XB_SPIN_CAP (1u << 22)
constexpr int CW_DSAC = 8192;
constexpr size_t KM_OFF = 262144;

constexpr int LDS_CTL_OFF = 155648;
constexpr int LDS_BYTES = 156672;
constexpr int VP = 320;
constexpr int VT_BYTES = 32 * VP;

__constant__ short GRP[104][4] = {
{1,0,64,0}, {1,32,64,32}, {1,128,64,0}, {1,160,64,32}, {1,256,64,0}, {1,288,64,32}, {1,384,64,0}, {1,416,64,32}, {1,512,64,0}, {1,544,64,32}, {0,640,32,0}, {0,704,32,0}, {2,768,32,0}, {2,832,32,0}, {2,896,32,0}, {2,960,32,0}, {2,1024,32,0}, {2,1088,32,0}, {2,1152,32,0}, {2,1216,32,0}, {2,1280,32,0}, {2,1344,32,0}, {2,1408,32,0}, {2,1472,32,0}, {2,1536,32,0}, {2,1600,32,0}, {2,1664,32,0}, {2,1728,32,0}, {2,1792,32,0}, {3,1856,0,0}, {1,3408,64,0}, {1,3440,64,32}, {1,3536,64,0}, {1,3568,64,32}, {1,3664,64,0}, {1,3696,64,32}, {1,3792,64,0}, {1,3824,64,32}, {1,3920,64,0}, {1,3952,64,32}, {1,4048,64,0}, {1,4080,64,32}, {1,4176,64,0}, {1,4208,64,32}, {1,4304,64,0}, {1,4336,64,32}, {0,4432,32,0}, {0,4496,32,0}, {0,4560,32,0}, {0,4624,32,0}, {0,4688,32,0}, {0,4752,32,0}, {0,4816,32,0}, {0,4880,32,0}, {1,4944,64,0}, {1,4976,64,32}, {1,5072,64,0}, {1,5104,64,32}, {1,5200,64,0}, {1,5232,64,32}, {1,5328,64,0}, {1,5360,64,32}, {1,5456,64,0}, {1,5488,64,32}, {1,5584,64,0}, {1,5616,64,32}, {1,5712,64,0}, {1,5744,64,32}, {1,5840,64,0}, {1,5872,64,32}, {0,5968,32,0}, {0,6032,32,0}, {0,6096,32,0}, {0,6160,32,0}, {0,6224,32,0}, {0,6288,32,0}, {0,6352,32,0}, {0,6416,32,0}, {4,0,0,0}, {4,0,0,0}, {2,1872,32,0}, {2,1936,32,0}, {2,2000,32,0}, {2,2064,32,0}, {2,2128,32,0}, {2,2192,32,0}, {2,2256,32,0}, {2,2320,32,0}, {2,2384,32,0}, {2,2448,32,0}, {2,2512,32,0}, {2,2576,32,0}, {2,2640,32,0}, {2,2704,32,0}, {2,2768,32,0}, {2,2832,32,0}, {0,2896,32,0}, {0,2960,32,0}, {0,3024,32,0}, {0,3088,32,0}, {0,3152,32,0}, {0,3216,32,0}, {0,3280,32,0}, {0,3344,32,0}};

__device__ __forceinline__ unsigned cvtpk(float lo, float hi) { f32x2 v = {lo, hi}; bf16x2_t b = __builtin_convertvector(v, bf16x2_t); return __builtin_bit_cast(unsigned, b); }
__device__ __forceinline__ unsigned pk4_fp8(float a, float b, float c, float d) { unsigned w = 0u; w = __builtin_amdgcn_cvt_pk_fp8_f32(a, b, w, false); w = __builtin_amdgcn_cvt_pk_fp8_f32(c, d, w, true); return w; }
__device__ __forceinline__ float bf2f(unsigned short b) { return __builtin_bit_cast(float, (unsigned)b << 16); }
__device__ __forceinline__ float bflo(unsigned w) { return __builtin_bit_cast(float, w << 16); }
__device__ __forceinline__ float bfhi(unsigned w) { return __builtin_bit_cast(float, w & 0xffff0000u); }
__device__ __forceinline__ int crow(int r, int hi) { return (r & 3) + 8 * (r >> 2) + 4 * hi; }
#define RLX_AGENT __ATOMIC_RELAXED, __HIP_MEMORY_SCOPE_AGENT
__device__ __forceinline__ int lane_id() { int l; asm volatile("v_mbcnt_lo_u32_b32 %0, -1, 0\n\tv_mbcnt_hi_u32_b32 %0, -1, %0" : "=v"(l)); return l; }

struct swap2 { float a, b; };
__device__ __forceinline__ swap2 pl32swap(float x, float y) { const auto r = __builtin_amdgcn_permlane32_swap(__float_as_uint(x), __float_as_uint(y), false, false); const unsigned u0 = r[0], u1 = r[1]; swap2 o; o.a = __uint_as_float(u0); o.b = __uint_as_float(u1); return o; }
template <int M> __device__ __forceinline__ float shx_f(float v) { return __int_as_float(__builtin_amdgcn_ds_swizzle(__float_as_int(v), (M << 10) | 0x1f)); }
__device__ __forceinline__ float xsum32(float v) { const swap2 r = pl32swap(v, v); return r.a + r.b; }
__device__ __forceinline__ float xmax32(float v) { const swap2 r = pl32swap(v, v); return fmaxf(r.a, r.b); }
__device__ __forceinline__ int wave_isum(int v) {
    v += __builtin_amdgcn_update_dpp(0, v, 0xB1, 0xF, 0xF, true);
    v += __builtin_amdgcn_update_dpp(0, v, 0x4E, 0xF, 0xF, true);
    v += __builtin_amdgcn_update_dpp(0, v, 0x141, 0xF, 0xF, true);
    v += __builtin_amdgcn_update_dpp(0, v, 0x140, 0xF, 0xF, true);
    return __builtin_amdgcn_readlane(v, 0) + __builtin_amdgcn_readlane(v, 16) + __builtin_amdgcn_readlane(v, 32) + __builtin_amdgcn_readlane(v, 48);
}
__device__ __forceinline__ float allsum(float v) { v += shx_f<1>(v); v += shx_f<2>(v); v += shx_f<4>(v); v += shx_f<8>(v); v += shx_f<16>(v); return xsum32(v); }
__device__ __forceinline__ float wave_sum(float v) { return allsum(v); }
__device__ __forceinline__ swap2 pl16swap(float x, float y) { const auto r = __builtin_amdgcn_permlane16_swap(__float_as_uint(x), __float_as_uint(y), false, false); const unsigned u0 = r[0], u1 = r[1]; swap2 o; o.a = __uint_as_float(u0); o.b = __uint_as_float(u1); return o; }

namespace pg8 {
constexpr int BM = 256, BK = 64, HALF = 128, HTB = HALF * BK * 2, STAGE_BYTES = 8 * HTB, NXCD = 8, WGM = 8;
__device__ __forceinline__ int lds_byte(int r, int c) { const int st = (r >> 4) * 2 + (c >> 5), rr = r & 15, cc = c & 31, ob = rr * 64 + cc * 2; return st * 1024 + (ob ^ (((ob >> 9) & 1) << 5)); }
__device__ __forceinline__ void stage_rc(int b, int& R, int& C) { const int st = b / 1024, sb = b % 1024, swz = sb ^ (((sb >> 9) & 1) << 5); R = (st >> 1) * 16 + swz / 64; C = (st & 1) * 32 + (swz % 64) / 2; }
__device__ __forceinline__ int perm32(int rho) { const int n = rho >> 4, i = rho & 15; return 8 * (i >> 2) + 4 * n + (i & 3); }

struct Unit { int pm, pn, e; const char* B; const int* list; int row0, cnt, orow0; };
__device__ __forceinline__ int a_row(const Unit& u, int r) {
    if (u.list) { int rr = u.row0 + r; rr = rr < u.cnt ? rr : u.cnt - 1; return u.list[rr]; }
    return u.row0 + r;
}

struct DenseOrder {
    int nM, nN, nwg, G, c, K; const char* Bt;
    __device__ void init(int M, int N, int K_, const void* Bt_, int G_, int c_) { nM = M / BM; nN = N / BM; nwg = nM * nN; G = G_; c = c_; K = K_; Bt = (const char*)Bt_; }
    __device__ bool next(int i, Unit& u) const {
        const long L = (long)i * G + c; if (L >= nwg) return false;
        int wgid = (int)L; { const int q = nwg / NXCD, r = nwg % NXCD, xcd = wgid % NXCD, off = wgid / NXCD; wgid = (xcd < r ? xcd * (q + 1) : r * (q + 1) + (xcd - r) * q) + off; }
        const int nig = WGM * nN, gid = wgid / nig, fm = gid * WGM, gsz = (nM - fm) < WGM ? (nM - fm) : WGM;
        u.pm = fm + ((wgid % nig) % gsz); u.pn = (wgid % nig) / gsz; u.e = 0;
        u.B = Bt + (size_t)u.pn * BM * K * 2; u.list = nullptr; u.row0 = u.pm * BM; u.cnt = 0; u.orow0 = u.pm * BM; return true;
    }
};

template <class Epi, class Sched, bool GATHER, bool FP8 = false>
__device__ __forceinline__ void gemm_phase(LAS unsigned char* lds, const bf16_t* Aptr, const int K, const Sched& S, const Epi& E, const int wv) {
    int tid_ = wv * 64 + lane_id(); asm volatile("" : "+v"(tid_));
    const int tid = tid_, wid = __builtin_amdgcn_readfirstlane(tid >> 6), lane = tid & 63, wr = wid >> 2, wc = wid & 3, fr = lane & 15, fq = lane >> 4;
    const int nt = K / BK;
    unsigned voffB[2], voffA[2];
#pragma unroll
    for (int i = 0; i < 2; ++i) { int sR, sC; stage_rc(tid * 16 + i * 8192, sR, sC); const int Rb = Epi::PERM ? ((sR & ~31) + perm32(sR & 31)) : sR; voffB[i] = (unsigned)(Rb * K + sC) * 2u; voffA[i] = (unsigned)(sR * K + sC) * 2u; }
    const size_t kstep = (size_t)(BK * 2);
    const size_t hstep = (size_t)HALF * K * 2;
    const unsigned ldsw = (unsigned)wid * 1024u;
    const int aoff = FP8 ? lds_byte(wr * 64 + fr, fq * 16) : lds_byte(wr * 64 + fr, fq * 8), boff = FP8 ? lds_byte(wc * 32 + fr, fq * 16) : lds_byte(wc * 32 + fr, fq * 8);
    const int aoff2 = FP8 ? lds_byte(wr * 64 + fr, fq * 16 + 8) : aoff + 1024, boff2 = FP8 ? lds_byte(wc * 32 + fr, fq * 16 + 8) : boff + 1024;
    const char* gA = (const char*)Aptr;
#define PG8_SA(b, h) (((b) * 2 + (h)) * HTB)
#define PG8_SB(b, h) ((4 + (b) * 2 + (h)) * HTB)
#define PG8_STAGE2(bufoff, gbase, o0, o1) do { \
        __builtin_amdgcn_global_load_lds((const unsigned*)((const char*)(gbase) + (o0)), (LAS unsigned*)(lds + (bufoff) + ldsw), 16, 0, 0); \
        __builtin_amdgcn_global_load_lds((const unsigned*)((const char*)(gbase) + (o1)), (LAS unsigned*)(lds + (bufoff) + ldsw + 8192), 16, 0, 0); } while (0)
#define PG8_STAGEB(bufoff, gbase) PG8_STAGE2(bufoff, gbase, voffB[0], voffB[1])
#define PG8_STAGEA(bufoff, gbase, h, useN) do { if constexpr (GATHER) { const u32x4 vo_ = *(const LAS u32x4*)(lds + STAGE_BYTES + ((((useN) ? ui + 1 : ui) & 1) ? 8192 : 0) + tid * 16); \
            if ((h) == 0) { PG8_STAGE2(bufoff, gbase, vo_.x, vo_.y); } else { PG8_STAGE2(bufoff, gbase, vo_.z, vo_.w); } } \
        else { const char* gb_ = (const char*)(gbase) + (size_t)((useN) ? nrow0 : crow0) * K * 2 + (h) * hstep; PG8_STAGE2(bufoff, gb_, voffA[0], voffA[1]); } } while (0)
#define PG8_LD16(p_) (*(const LAS u32x4*)(p_))
#define PG8_MK8(lo_, hi_) (v8i32_t){(int)lo_.x, (int)lo_.y, (int)lo_.z, (int)lo_.w, (int)hi_.x, (int)hi_.y, (int)hi_.z, (int)hi_.w}
#define PG8_LDA(dst, b, h) do { _Pragma("unroll") for (int m = 0; m < 4; ++m) { \
        if constexpr (FP8) { const u32x4 lo_ = PG8_LD16(lds + PG8_SA(b, h) + aoff + m * 2048), hi_ = PG8_LD16(lds + PG8_SA(b, h) + aoff2 + m * 2048); dst##8[m] = PG8_MK8(lo_, hi_); } \
        else { dst[m][0] = *(const LAS bf16x8*)(lds + PG8_SA(b, h) + aoff + m * 2048); dst[m][1] = *(const LAS bf16x8*)(lds + PG8_SA(b, h) + aoff2 + m * 2048); } } } while (0)
#define PG8_LDB(dst, b, h) do { _Pragma("unroll") for (int n = 0; n < 2; ++n) { \
        if constexpr (FP8) { const u32x4 lo_ = PG8_LD16(lds + PG8_SB(b, h) + boff + n * 2048), hi_ = PG8_LD16(lds + PG8_SB(b, h) + boff2 + n * 2048); dst##8[n] = PG8_MK8(lo_, hi_); } \
        else { dst[n][0] = *(const LAS bf16x8*)(lds + PG8_SB(b, h) + boff + n * 2048); dst[n][1] = *(const LAS bf16x8*)(lds + PG8_SB(b, h) + boff2 + n * 2048); } } } while (0)
#define PG8_MMA(ai, bj, At, Bt) do { __builtin_amdgcn_s_setprio(1); _Pragma("unroll") for (int m = 0; m < 4; ++m) _Pragma("unroll") for (int n = 0; n < 2; ++n) { \
        if constexpr (FP8) { asm("v_mfma_scale_f32_16x16x128_f8f6f4 %0, %1, %2, %0, %3, %4 op_sel_hi:[0,0,0]" : "+v"(acc[ai][bj][m][n]) : "v"(Bt##8[n]), "v"(At##8[m]), "v"(sc_w_), "v"(sc_a_)); } \
        else { _Pragma("unroll") for (int k = 0; k < 2; ++k) acc[ai][bj][m][n] = __builtin_amdgcn_mfma_f32_16x16x32_bf16(Bt[n][k], At[m][k], acc[ai][bj][m][n], 0, 0, 0); } } \
        __builtin_amdgcn_s_setprio(0); } while (0)
#define PG8_WAIT_V(n) asm volatile("s_waitcnt vmcnt(" #n ")" ::: "memory")
#define PG8_WAIT_L(n) asm volatile("s_waitcnt lgkmcnt(" #n ")" ::: "memory")
#define PG8_BAR __builtin_amdgcn_s_barrier()
#define PG8_SCHED __builtin_amdgcn_sched_barrier(0)
#define PG8_AOFFS(u, par) do { unsigned v_[2][2]; _Pragma("unroll") for (int i_ = 0; i_ < 2; ++i_) { int sR_, sC_; stage_rc(tid * 16 + i_ * 8192, sR_, sC_); _Pragma("unroll") for (int h_ = 0; h_ < 2; ++h_) v_[h_][i_] = (unsigned)(a_row(u, h_ * HALF + sR_) * K + sC_) * 2u; } \
        *(LAS u32x4*)(lds + STAGE_BYTES + (((par) & 1) ? 8192 : 0) + tid * 16) = (u32x4){v_[0][0], v_[0][1], v_[1][0], v_[1][1]}; } while (0)
    Unit cur, nxt; int ui = 0;
    if (!S.next(0, cur)) return;
    f32x4 acc[2][2][4][2];
#pragma unroll
    for (int a = 0; a < 2; ++a)
#pragma unroll
        for (int b = 0; b < 2; ++b)
#pragma unroll
            for (int m = 0; m < 4; ++m)
#pragma unroll
                for (int n = 0; n < 2; ++n) acc[a][b][m][n] = (f32x4){0.f, 0.f, 0.f, 0.f};
    const int sc_w_ = E.scale_w, sc_a_ = E.scale_a;
    bf16x8 At[4][2], B0[2][2], B1[2][2]; v8i32_t At8[4], B08[2], B18[2];
    int crow0 = cur.row0, nrow0 = cur.row0;
    if constexpr (GATHER) { PG8_AOFFS(cur, 0); }
    const char* cB = cur.B;
    PG8_STAGEB(PG8_SB(0, 0), cB); PG8_STAGEB(PG8_SB(0, 1), cB + hstep); PG8_STAGEA(PG8_SA(0, 0), gA, 0, false); PG8_STAGEA(PG8_SA(0, 1), gA, 1, false);
    if (wr == 1) PG8_BAR;
    PG8_WAIT_V(2); PG8_BAR;
    PG8_STAGEB(PG8_SB(1, 0), cB + kstep); PG8_STAGEA(PG8_SA(1, 0), gA + kstep, 0, false); PG8_STAGEB(PG8_SB(1, 1), cB + hstep + kstep);
    PG8_WAIT_V(6); PG8_BAR;
    for (;;) {
        const bool has_next = S.next(ui + 1, nxt);
        if constexpr (GATHER) { if (has_next) { PG8_AOFFS(nxt, ui + 1); } else { PG8_AOFFS(cur, ui + 1); } }
        nrow0 = has_next ? nxt.row0 : crow0;
        const char* nB = has_next ? nxt.B : cB;
#pragma clang loop unroll(disable)
        for (int t = 0; t < nt; t += 2) {
            const bool last = (t == nt - 2);
            const char* a1 = gA + (size_t)(t + 1) * kstep;
            const char* a2 = last ? gA : gA + (size_t)(t + 2) * kstep; const char* b2 = last ? nB : cB + (size_t)(t + 2) * kstep;
            const char* a3 = a2 + kstep; const char* b3 = b2 + kstep;
            PG8_LDB(B0, 0, 0); PG8_LDB(B1, 0, 1); PG8_SCHED; PG8_LDA(At, 0, 0); PG8_STAGEA(PG8_SA(1, 1), a1, 1, false);
            PG8_WAIT_V(8); PG8_WAIT_L(0); PG8_BAR; PG8_MMA(0, 0, At, B0); PG8_MMA(0, 1, At, B1); PG8_BAR; PG8_SCHED;
            PG8_LDA(At, 0, 1); PG8_STAGEB(PG8_SB(0, 0), b2); PG8_STAGEB(PG8_SB(0, 1), b2 + hstep); PG8_STAGEA(PG8_SA(0, 0), a2, 0, last);
            PG8_WAIT_V(8); PG8_WAIT_L(0); PG8_BAR; PG8_MMA(1, 0, At, B0); PG8_MMA(1, 1, At, B1); PG8_BAR; PG8_SCHED;
            PG8_LDB(B0, 1, 0); PG8_LDB(B1, 1, 1); PG8_SCHED; PG8_LDA(At, 1, 0); PG8_STAGEA(PG8_SA(0, 1), a2, 1, last);
            PG8_WAIT_V(8); PG8_WAIT_L(0); PG8_BAR; PG8_MMA(0, 0, At, B0); PG8_MMA(0, 1, At, B1); PG8_BAR; PG8_SCHED;
            PG8_LDA(At, 1, 1); PG8_STAGEB(PG8_SB(1, 0), b3); PG8_STAGEB(PG8_SB(1, 1), b3 + hstep); PG8_STAGEA(PG8_SA(1, 0), a3, 0, last);
            PG8_WAIT_V(8); PG8_WAIT_L(0); PG8_BAR; PG8_MMA(1, 0, At, B0); PG8_MMA(1, 1, At, B1); PG8_BAR; PG8_SCHED;
        }
        if (wr == 0) PG8_BAR;
        { Unit eu = cur; int el = lane;
          eu.pm = __builtin_amdgcn_readfirstlane(eu.pm); eu.pn = __builtin_amdgcn_readfirstlane(eu.pn); eu.e = __builtin_amdgcn_readfirstlane(eu.e);
          eu.cnt = __builtin_amdgcn_readfirstlane(eu.cnt); eu.orow0 = __builtin_amdgcn_readfirstlane(eu.orow0);
          asm volatile("" : "+s"(eu.pm), "+s"(eu.pn), "+s"(eu.e), "+s"(eu.cnt), "+s"(eu.orow0), "+v"(el));
          E(acc, eu, wr, wc, el & 15, el >> 4); }
        if (!has_next) break;
#pragma unroll
        for (int a = 0; a < 2; ++a)
#pragma unroll
            for (int b = 0; b < 2; ++b)
#pragma unroll
                for (int m = 0; m < 4; ++m)
#pragma unroll
                    for (int n = 0; n < 2; ++n) acc[a][b][m][n] = (f32x4){0.f, 0.f, 0.f, 0.f};
        cur = nxt; cB = nB; ++ui; crow0 = nrow0;
        if (wr == 1) PG8_BAR;
    }
    PG8_WAIT_V(0);
    PG8_BAR;
#undef PG8_SA
#undef PG8_SB
#undef PG8_STAGE2
#undef PG8_STAGEB
#undef PG8_STAGEA
#undef PG8_LDA
#undef PG8_LDB
#undef PG8_MMA
#undef PG8_LD16
#undef PG8_MK8
#undef PG8_WAIT_V
#undef PG8_WAIT_L
#undef PG8_BAR
#undef PG8_SCHED
#undef PG8_AOFFS
}
}

typedef f32x4 acc_t[2][2][4][2];
constexpr int SC_W = 0x79797979, SC_X = 0x7f7f7f7f, SC_H = 0x7b7b7b7b;

struct EpiProj {
    static constexpr bool PERM = true; static constexpr int scale_w = SC_W, scale_a = SC_X;
    bf16_t* P; const f32x2* r128; const f32x2* r64; float* kmsum; int pn_off;
    __device__ __forceinline__ void operator()(const acc_t& acc, const pg8::Unit& u, int wr, int wc, int fr, int fq) const {
        const int g = (u.pn + pn_off) * 4 + wc;
        const int mode = GRP[g][0], lo = GRP[g][1], ho = GRP[g][2], fb = GRP[g][3];
        if (mode == 4) return;
        const bool ksum = (lo >= C_CK && lo < C_CV);
        float cs[16];
#pragma unroll
        for (int k = 0; k < 16; ++k) cs[k] = 0.f;
#pragma unroll
        for (int ai = 0; ai < 2; ++ai)
#pragma unroll
            for (int m = 0; m < 4; ++m) {
                const int row = u.orow0 + ai * 128 + wr * 64 + m * 16 + fr;
                f32x4 l0 = acc[ai][0][m][0], l1 = acc[ai][0][m][1], h0 = acc[ai][1][m][0], h1 = acc[ai][1][m][1];
                if (mode == 1 || mode == 2) {
                    const f32x4* tb = (const f32x4*)((mode == 1 ? r128 + (size_t)row * 64 : r64 + (size_t)row * 32) + fb + 8 * fq);
                    const f32x4 t0 = tb[0], t1 = tb[1], t2 = tb[2], t3 = tb[3];
                    f32x4 nl0, nl1, nh0, nh1;
                    nl0[0] = l0[0] * t0[0] - h0[0] * t0[1]; nh0[0] = l0[0] * t0[1] + h0[0] * t0[0];
                    nl0[1] = l0[1] * t0[2] - h0[1] * t0[3]; nh0[1] = l0[1] * t0[3] + h0[1] * t0[2];
                    nl0[2] = l0[2] * t1[0] - h0[2] * t1[1]; nh0[2] = l0[2] * t1[1] + h0[2] * t1[0];
                    nl0[3] = l0[3] * t1[2] - h0[3] * t1[3]; nh0[3] = l0[3] * t1[3] + h0[3] * t1[2];
                    nl1[0] = l1[0] * t2[0] - h1[0] * t2[1]; nh1[0] = l1[0] * t2[1] + h1[0] * t2[0];
                    nl1[1] = l1[1] * t2[2] - h1[1] * t2[3]; nh1[1] = l1[1] * t2[3] + h1[1] * t2[2];
                    nl1[2] = l1[2] * t3[0] - h1[2] * t3[1]; nh1[2] = l1[2] * t3[1] + h1[2] * t3[0];
                    nl1[3] = l1[3] * t3[2] - h1[3] * t3[3]; nh1[3] = l1[3] * t3[3] + h1[3] * t3[2];
                    l0 = nl0; l1 = nl1; h0 = nh0; h1 = nh1;
                }
                if (ksum) {
#pragma unroll
                    for (int k = 0; k < 4; ++k) { cs[k] += l0[k]; cs[4 + k] += l1[k]; cs[8 + k] += h0[k]; cs[12 + k] += h1[k]; }
                }
                bf16_t* rp = P + (size_t)row * PP + lo + 8 * fq;
                u32x4 w; w.x = cvtpk(l0[0], l0[1]); w.y = cvtpk(l0[2], l0[3]); w.z = cvtpk(l1[0], l1[1]); w.w = cvtpk(l1[2], l1[3]);
                if (mode != 3) { *(u32x4*)rp = w; u32x4 v; v.x = cvtpk(h0[0], h0[1]); v.y = cvtpk(h0[2], h0[3]); v.z = cvtpk(h1[0], h1[1]); v.w = cvtpk(h1[2], h1[3]); *(u32x4*)(rp + ho) = v; }
                else if (fq < 2) *(u32x4*)rp = w;
            }
        if (ksum) {
#pragma unroll
            for (int k = 0; k < 16; ++k) { float v = cs[k]; v += shx_f<1>(v); v += shx_f<2>(v); v += shx_f<4>(v); v += shx_f<8>(v); cs[k] = v; }
            if (fr == 0) { float* dst = kmsum + (size_t)u.pm * 512 + (lo - C_CK) + 8 * fq;
#pragma unroll
                for (int k = 0; k < 8; ++k) { atomicAdd(dst + k, cs[k]); atomicAdd(dst + 64 + k, cs[8 + k]); } }
        }
    }
};

struct EpiOut {
    static constexpr bool PERM = true; static constexpr int scale_w = 0, scale_a = 0;
    const float* X; bf16_t* Y;
    __device__ __forceinline__ void operator()(const acc_t& acc, const pg8::Unit& u, int wr, int wc, int fr, int fq) const {
#pragma unroll
        for (int ai = 0; ai < 2; ++ai)
#pragma unroll
            for (int m = 0; m < 4; ++m) {
                const size_t off = (size_t)(u.orow0 + ai * 128 + wr * 64 + m * 16 + fr) * DM + u.pn * 256 + wc * 32 + 8 * fq;
#pragma unroll
                for (int bj = 0; bj < 2; ++bj) {
                    const f32x4 x0 = *(const f32x4*)(X + off + bj * 128), x1 = *(const f32x4*)(X + off + bj * 128 + 4);
                    const f32x4 a = x0 * ALPHA + acc[ai][bj][m][0], b = x1 * ALPHA + acc[ai][bj][m][1];
                    u32x4 w; w.x = cvtpk(a[0], a[1]); w.y = cvtpk(a[2], a[3]); w.z = cvtpk(b[0], b[1]); w.w = cvtpk(b[2], b[3]);
                    *(u32x4*)(Y + off + bj * 128) = w;
                }
            }
    }
};

struct EpiGU {
    static constexpr bool PERM = true; static constexpr int scale_w = SC_W, scale_a = SC_X;
    unsigned char* H;
    __device__ __forceinline__ void operator()(const acc_t& acc, const pg8::Unit& u, int wr, int wc, int fr, int fq) const {
#pragma unroll
        for (int ai = 0; ai < 2; ++ai)
#pragma unroll
            for (int m = 0; m < 4; ++m) {
                const size_t off = (size_t)(u.orow0 + ai * 128 + wr * 64 + m * 16 + fr) * DFF + u.pn * 128 + wc * 32 + 8 * fq;
                float hv[8];
#pragma unroll
                for (int n = 0; n < 2; ++n)
#pragma unroll
                    for (int j = 0; j < 4; ++j) { const float g = acc[ai][0][m][n][j], up = acc[ai][1][m][n][j]; hv[n * 4 + j] = 16.f * g * up / (1.f + __expf(-g)); }
                u32x2 w; w.x = pk4_fp8(hv[0], hv[1], hv[2], hv[3]); w.y = pk4_fp8(hv[4], hv[5], hv[6], hv[7]);
                *(u32x2*)(H + off) = w;
            }
    }
};

struct EpiDown {
    static constexpr bool PERM = true; static constexpr int scale_w = SC_W, scale_a = SC_H;
    bf16_t* Y; const float* sgate;
    __device__ __forceinline__ void operator()(const acc_t& acc, const pg8::Unit& u, int wr, int wc, int fr, int fq) const {
#pragma unroll
        for (int ai = 0; ai < 2; ++ai)
#pragma unroll
            for (int m = 0; m < 4; ++m) {
                const int r = ai * 128 + wr * 64 + m * 16 + fr, rk = u.pm * 256 + r;
                const float gt = rk < u.cnt ? sgate[u.e * 8192 + rk] : 0.f;
                const size_t off = (size_t)(u.orow0 + r) * DM + u.pn * 256 + wc * 32 + 8 * fq;
#pragma unroll
                for (int bj = 0; bj < 2; ++bj) {
                    const f32x4 a = acc[ai][bj][m][0] * gt, b = acc[ai][bj][m][1] * gt;
                    u32x4 w; w.x = cvtpk(a[0], a[1]); w.y = cvtpk(a[2], a[3]); w.z = cvtpk(b[0], b[1]); w.w = cvtpk(b[2], b[3]);
                    *(u32x4*)(Y + off + bj * 128) = w;
                }
            }
    }
};

struct MoeSched {
    const LAS int* tab; int G, c, K; const char* Bbase; size_t Bstride; const int* lists; int gather;
    __device__ bool next(int i, pg8::Unit& u) const {
#define RFL(x) __builtin_amdgcn_readfirstlane(x)
        const int L = i * G + c; if (L >= RFL(tab[32 + 16])) return false;
        int e = 0;
#pragma unroll
        for (int k = 1; k < 16; ++k) e += (L >= RFL(tab[32 + k])) ? 1 : 0;
        const int r = L - RFL(tab[32 + e]), cnt = RFL(tab[e]), mt = (cnt + 255) >> 8, nt = RFL(r / mt), mtile = r - nt * mt;
        u.pm = mtile; u.pn = nt; u.e = e; u.B = Bbase + (size_t)e * Bstride + (size_t)nt * 256 * K * 2;
        u.cnt = cnt; u.orow0 = RFL(tab[16 + e]) + mtile * 256;
        if (gather) { u.list = lists + e * 8192; u.row0 = mtile * 256; } else { u.list = nullptr; u.row0 = u.orow0; }
        return true;
#undef RFL
    }
};

struct FAState { f32x16 o[4]; float m, l; };
template <int NSTEP> struct KVRegs { u32x4 k[NSTEP]; u32x4 v[8]; };

__device__ __forceinline__ s16x4 vtr(const LAS char* p) { typedef short v4i16_t __attribute__((ext_vector_type(4)));
    return __builtin_bit_cast(s16x4, __builtin_amdgcn_ds_read_tr16_b64_v4i16((LAS v4i16_t*)p)); }

template <int NSTEP, class TF>
__device__ __forceinline__ void fa_load(KVRegs<NSTEP>& R, const bf16_t* P, const TF& tf, int t, int kcol, int vcol, int lane) {
#pragma unroll
    for (int i = 0; i < 8; ++i) { const bf16_t* rp = P + (size_t)tf.row(t, 4 * i + (lane >> 4)) * PP + (lane & 15) * 8; R.v[i] = *(const u32x4*)(rp + vcol);
        if constexpr (NSTEP == 8) R.k[i] = *(const u32x4*)(rp + kcol); }
    if constexpr (NSTEP == 4) {
#pragma unroll
        for (int i = 0; i < 4; ++i) R.k[i] = *(const u32x4*)(P + (size_t)tf.row(t, 8 * i + (lane >> 3)) * PP + kcol + (lane & 7) * 8); }
}

template <int NSTEP, bool QLDS, class TF>
__device__ __forceinline__ void fa_run(FAState& st, const bf16x8 (&q)[QLDS ? 1 : NSTEP], const LAS char* ql, const bf16_t* P, const TF& tf, int t_lo, int t_hi, LAS char* vl, float sc, int kcol, int vcol, int lane) {
    if (t_lo >= t_hi) return;
    constexpr int KP = NSTEP == 8 ? 272 : 144;
    const int hi = lane >> 5;
    const LAS char* vt = vl + (4 * hi + ((lane & 15) >> 2)) * VP + (16 * ((lane >> 4) & 1) + 4 * (lane & 3)) * 2;
    const LAS char* kt = vl + (lane & 31) * KP + hi * 16;
    KVRegs<NSTEP> R;
    fa_load<NSTEP>(R, P, tf, t_lo, kcol, vcol, lane);
    for (int t = t_lo; t < t_hi; ++t) {
        if constexpr (NSTEP == 8) {
#pragma unroll
            for (int i = 0; i < 8; ++i) *(LAS u32x4*)(vl + (4 * i + (lane >> 4)) * KP + (lane & 15) * 16) = R.k[i];
        } else {
#pragma unroll
            for (int i = 0; i < 4; ++i) *(LAS u32x4*)(vl + (8 * i + (lane >> 3)) * KP + (lane & 7) * 16) = R.k[i];
        }
        f32x16 s = {0.f, 0.f, 0.f, 0.f, 0.f, 0.f, 0.f, 0.f, 0.f, 0.f, 0.f, 0.f, 0.f, 0.f, 0.f, 0.f};
#pragma unroll
        for (int i = 0; i < NSTEP; ++i) { bf16x8 qf; if constexpr (QLDS) qf = *(const LAS bf16x8*)(ql + i * 1024 + lane * 16); else qf = q[i];
            const bf16x8 kf = *(const LAS bf16x8*)(kt + i * 32);
            s = __builtin_amdgcn_mfma_f32_32x32x16_bf16(kf, qf, s, 0, 0, 0); }
#pragma unroll
        for (int i = 0; i < 8; ++i) *(LAS u32x4*)(vl + (4 * i + (lane >> 4)) * VP + (lane & 15) * 16) = R.v[i];
        if (t + 1 < t_hi) fa_load<NSTEP>(R, P, tf, t + 1, kcol, vcol, lane);
        float tmax = NEG_INF;
#pragma unroll
        for (int r = 0; r < 16; ++r) { const float v = tf.valid(t, r, hi) ? s[r] * sc : NEG_INF; s[r] = v; tmax = fmaxf(tmax, v); }
        tmax = xmax32(tmax);
        const float mn = fmaxf(st.m, tmax), ms = (mn == NEG_INF) ? 0.f : mn;
        const float alpha = __builtin_amdgcn_exp2f(st.m - ms);
        float ps = 0.f;
#pragma unroll
        for (int r = 0; r < 16; ++r) { const float p = __builtin_amdgcn_exp2f(s[r] - ms); s[r] = p; ps += p; }
        st.l = st.l * alpha + ps; st.m = mn;
        if (!__all(alpha == 1.f)) {
#pragma unroll
            for (int d = 0; d < 4; ++d)
#pragma unroll
                for (int r = 0; r < 16; ++r) st.o[d][r] *= alpha;
        }
        u32x4 p0, p1;
        p0.x = cvtpk(s[0], s[1]); p0.y = cvtpk(s[2], s[3]); p0.z = cvtpk(s[4], s[5]); p0.w = cvtpk(s[6], s[7]);
        p1.x = cvtpk(s[8], s[9]); p1.y = cvtpk(s[10], s[11]); p1.z = cvtpk(s[12], s[13]); p1.w = cvtpk(s[14], s[15]);
        const bf16x8 pb0 = __builtin_bit_cast(bf16x8, p0), pb1 = __builtin_bit_cast(bf16x8, p1);
#pragma unroll
        for (int d = 0; d < 4; ++d) {
            const s16x4 a0 = vtr(vt + d * 64), a1 = vtr(vt + d * 64 + 8 * VP), b0 = vtr(vt + d * 64 + 16 * VP), b1 = vtr(vt + d * 64 + 24 * VP);
            const bf16x8 v0 = {a0[0], a0[1], a0[2], a0[3], a1[0], a1[1], a1[2], a1[3]}, v1 = {b0[0], b0[1], b0[2], b0[3], b1[0], b1[1], b1[2], b1[3]};
            st.o[d] = __builtin_amdgcn_mfma_f32_32x32x16_bf16(v0, pb0, st.o[d], 0, 0, 0);
            st.o[d] = __builtin_amdgcn_mfma_f32_32x32x16_bf16(v1, pb1, st.o[d], 0, 0, 0);
        }
    }
}
__device__ __forceinline__ void fa_init(FAState& st) {
#pragma unroll
    for (int d = 0; d < 4; ++d)
#pragma unroll
        for (int r = 0; r < 16; ++r) st.o[d][r] = 0.f;
    st.m = NEG_INF; st.l = 0.f;
}
__device__ __forceinline__ void fa_normalize(FAState& st) {
    const float lt = xsum32(st.l), inv = lt > 0.f ? 1.f / lt : 0.f;
#pragma unroll
    for (int d = 0; d < 4; ++d)
#pragma unroll
        for (int r = 0; r < 16; ++r) st.o[d][r] *= inv;
}
__device__ __forceinline__ void fa_store(const FAState& st, bf16_t* orow, int hi) {
#pragma unroll
    for (int d = 0; d < 4; ++d)
#pragma unroll
        for (int g = 0; g < 4; ++g) { u32x2 w; w.x = cvtpk(st.o[d][4 * g], st.o[d][4 * g + 1]); w.y = cvtpk(st.o[d][4 * g + 2], st.o[d][4 * g + 3]);
            *(u32x2*)(orow + 32 * d + 8 * g + 4 * hi) = w; }
}
template <int NSTEP>
__device__ __forceinline__ void fa_loadq(bf16x8 (&q)[NSTEP], const bf16_t* qrow, int hi, bool on) {
#pragma unroll
    for (int s = 0; s < NSTEP; ++s) { bf16x8 z = {0, 0, 0, 0, 0, 0, 0, 0}; q[s] = on ? *(const bf16x8*)(qrow + 16 * s + 8 * hi) : z; }
}

template <int NSTEP>
__device__ __forceinline__ void fa_loadq_lds(LAS char* ql, const bf16_t* qrow, int hi, bool on, int lane) {
#pragma unroll
    for (int s = 0; s < NSTEP; ++s) { bf16x8 z = {0, 0, 0, 0, 0, 0, 0, 0}; *(LAS bf16x8*)(ql + s * 1024 + lane * 16) = on ? *(const bf16x8*)(qrow + 16 * s + 8 * hi) : z; }
}
constexpr int QL_OFF = 8 * VT_BYTES, QL_BYTES = 8192, AUX_OFF = 147456;


constexpr int E1_STAGE = 32768, E1_NS = 3;
template <int NSTEP, class TF>
__device__ __forceinline__ void e1_run(FAState& st, const bf16x8 (&q)[NSTEP], const bf16_t* Kg, const bf16_t* Vg, const int nkt, LAS char* ring, const float sc, const int kc0, const TF& tf, const int lane, const int wid) {
    const int hi = lane >> 5, r32 = lane & 31;
    unsigned doff[2];
#pragma unroll
    for (int i = 0; i < 2; ++i) { const int row = 8 * wid + 4 * i + (lane >> 4), sw = ((row & 3) << 2) | ((row >> 2) & 3); doff[i] = (unsigned)(row * PP + 8 * ((lane & 15) ^ sw)) * 2u; }
    const unsigned ldsw = (unsigned)wid * 2048u;
#define E1_DMAK(kt_, stg_) do { const char* kb_ = (const char*)(Kg + (size_t)(kt_) * 64 * PP); LAS char* sb_ = ring + (stg_) * E1_STAGE + ldsw; \
        __builtin_amdgcn_global_load_lds((const unsigned*)(kb_ + doff[0]), (LAS unsigned*)(sb_), 16, 0, 0); __builtin_amdgcn_global_load_lds((const unsigned*)(kb_ + doff[1]), (LAS unsigned*)(sb_ + 1024), 16, 0, 0); } while (0)
#define E1_DMAV(kt_, stg_) do { const char* vb_ = (const char*)(Vg + (size_t)(kt_) * 64 * PP); LAS char* sb_ = ring + (stg_) * E1_STAGE + ldsw; \
        __builtin_amdgcn_global_load_lds((const unsigned*)(vb_ + doff[0]), (LAS unsigned*)(sb_ + 16384), 16, 0, 0); __builtin_amdgcn_global_load_lds((const unsigned*)(vb_ + doff[1]), (LAS unsigned*)(sb_ + 16384 + 1024), 16, 0, 0); } while (0)
    const int swk = ((r32 & 3) << 2) | ((r32 >> 2) & 3);
    const int koff0 = 256 * r32 + 16 * ((kc0 + hi) ^ swk);
    int voff0[2];
    { const int qq = (lane & 15) >> 2, p = lane & 3, cl = 2 * ((lane >> 4) & 1) + (p >> 1);
#pragma unroll
      for (int rd = 0; rd < 2; ++rd) voff0[rd] = 16384 + 256 * (8 * rd + 4 * hi + qq) + 16 * (4 * qq + (cl ^ ((2 * rd + hi) & 3))) + 8 * (p & 1); }
    if (nkt <= 0) return;
    E1_DMAK(0, 0);
    if (nkt > 1) E1_DMAK(1, 1);
    E1_DMAV(0, 0);
    const f32x16 zero16 = {0.f, 0.f, 0.f, 0.f, 0.f, 0.f, 0.f, 0.f, 0.f, 0.f, 0.f, 0.f, 0.f, 0.f, 0.f, 0.f};
    const bf16x8 zb = {0, 0, 0, 0, 0, 0, 0, 0};
    bf16x8 pb0 = zb, pb1 = zb, pb2 = zb, pb3 = zb;
    int pend = 0, stg = 0, stp = 2;
#pragma clang loop unroll(disable)
    for (int kt = 0; kt <= nkt; ++kt) {
        if (kt + 1 < nkt) asm volatile("s_waitcnt vmcnt(4)" ::: "memory"); else if (kt < nkt) asm volatile("s_waitcnt vmcnt(2)" ::: "memory"); else asm volatile("s_waitcnt vmcnt(0)" ::: "memory");
        __builtin_amdgcn_s_barrier();
        const int sn = stg + 1 >= E1_NS ? 0 : stg + 1;
        if (kt + 2 < nkt) E1_DMAK(kt + 2, stp);
        if (kt + 1 < nkt) E1_DMAV(kt + 1, sn);
        const LAS char* sb = ring + stg * E1_STAGE;
        const bool in = kt < nkt, act0 = in && tf.active(kt, 0), act1 = in && tf.active(kt, 1);
        int act = __builtin_amdgcn_readfirstlane((act0 || act1) ? 1 : 0); asm volatile("" : "+s"(act));
        f32x16 c0 = zero16, c1 = zero16;
        float tmax = NEG_INF, ms = 0.f, alpha = 1.f, ps = 0.f;
        bool mk0 = false, mk1 = false;
        auto mw = tf.fetch(in ? kt : 0);
        if (act) {
            mk0 = tf.masked(kt, 0); mk1 = tf.masked(kt, 1) || !act1;
            int kof = koff0; asm volatile("" : "+v"(kof));
#pragma unroll
            for (int i = 0; i < NSTEP; ++i) { const bf16x8 kf0 = *(const LAS bf16x8*)(sb + (kof ^ (32 * i))), kf1 = *(const LAS bf16x8*)(sb + 8192 + (kof ^ (32 * i)));
                c0 = __builtin_amdgcn_mfma_f32_32x32x16_bf16(kf0, q[i], c0, 0, 0, 0); c1 = __builtin_amdgcn_mfma_f32_32x32x16_bf16(kf1, q[i], c1, 0, 0, 0); }
        }
        const unsigned vb0 = (unsigned)(uintptr_t)(ring + stp * E1_STAGE) + (unsigned)voff0[0], vb1 = (unsigned)(uintptr_t)(ring + stp * E1_STAGE) + (unsigned)voff0[1];
        s16x4 ta[16], tb[16];
#define E1_TRP(j_, off_) do { const unsigned ad0 = vb0 ^ (64u * ((j_) >> 2)), ad1 = vb1 ^ (64u * ((j_) >> 2)); \
            asm volatile("ds_read_b64_tr_b16 %0, %1 offset:" #off_ : "=&v"(ta[j_]) : "v"(ad0) : "memory"); asm volatile("ds_read_b64_tr_b16 %0, %1 offset:" #off_ : "=&v"(tb[j_]) : "v"(ad1) : "memory"); } while (0)
#define E1_PVM(j_, pb_, w_) do { asm volatile("s_waitcnt lgkmcnt(" #w_ ")" ::: "memory"); __builtin_amdgcn_sched_barrier(0); \
            st.o[(j_) >> 2] = __builtin_amdgcn_mfma_f32_32x32x16_bf16((bf16x8){ta[j_][0], ta[j_][1], ta[j_][2], ta[j_][3], tb[j_][0], tb[j_][1], tb[j_][2], tb[j_][3]}, pb_, st.o[(j_) >> 2], 0, 0, 0); \
            __builtin_amdgcn_sched_barrier(0); } while (0)
#define E1_MAX0 do { if (mk0) { _Pragma("unroll") for (int r = 0; r < 16; ++r) { const float v = (act0 && tf.valid(kt, 0, r, hi, mw)) ? c0[r] : NEG_INF; c0[r] = v; tmax = fmaxf(tmax, v); } } \
            else { _Pragma("unroll") for (int r = 0; r < 16; ++r) { const float v = act0 ? c0[r] : NEG_INF; c0[r] = v; tmax = fmaxf(tmax, v); } } __builtin_amdgcn_sched_barrier(0); } while (0)
#define E1_MAX1 do { if (mk1) { _Pragma("unroll") for (int r = 0; r < 16; ++r) { const float v = (act1 && tf.valid(kt, 1, r, hi, mw)) ? c1[r] : NEG_INF; c1[r] = v; tmax = fmaxf(tmax, v); } } \
            else { _Pragma("unroll") for (int r = 0; r < 16; ++r) tmax = fmaxf(tmax, c1[r]); } __builtin_amdgcn_sched_barrier(0); } while (0)
#define E1_RED do { const swap2 rr = pl32swap(tmax, tmax); tmax = fmaxf(rr.a, rr.b) * sc; const float mn = fmaxf(st.m, tmax); ms = (mn == NEG_INF) ? 0.f : mn; \
            alpha = __builtin_amdgcn_exp2f(st.m - ms); st.m = mn; __builtin_amdgcn_sched_barrier(0); } while (0)
#define E1_EXP(c_, lo_) do { _Pragma("unroll") for (int r = (lo_); r < (lo_) + 8; ++r) { const float p = __builtin_amdgcn_exp2f(__builtin_fmaf(c_[r], sc, -ms)); c_[r] = p; ps += p; } __builtin_amdgcn_sched_barrier(0); } while (0)
        __builtin_amdgcn_sched_barrier(0);
        if (pend) { asm volatile("s_waitcnt lgkmcnt(0)" ::: "memory"); __builtin_amdgcn_sched_barrier(0); E1_TRP(0, 0); E1_TRP(1, 4096); E1_TRP(2, 8192); E1_TRP(3, 12288);
                    E1_PVM(0, pb0, 6); E1_TRP(4, 0); E1_PVM(1, pb1, 6); E1_TRP(5, 4096); }
        if (act) E1_MAX0;
        if (pend) { E1_PVM(2, pb2, 6); E1_TRP(6, 8192); E1_PVM(3, pb3, 6); E1_TRP(7, 12288); }
        if (act) E1_MAX1;
        if (pend) { E1_PVM(4, pb0, 6); E1_TRP(8, 0); E1_PVM(5, pb1, 6); E1_TRP(9, 4096); }
        if (act) E1_RED;
        if (pend) { E1_PVM(6, pb2, 6); E1_TRP(10, 8192); E1_PVM(7, pb3, 6); E1_TRP(11, 12288); }
        if (act) E1_EXP(c0, 0);
        if (pend) { E1_PVM(8, pb0, 6); E1_TRP(12, 0); E1_PVM(9, pb1, 6); E1_TRP(13, 4096); }
        if (act) E1_EXP(c0, 8);
        if (pend) { E1_PVM(10, pb2, 6); E1_TRP(14, 8192); E1_PVM(11, pb3, 6); E1_TRP(15, 12288); }
        if (act) E1_EXP(c1, 0);
        if (pend) { E1_PVM(12, pb0, 6); E1_PVM(13, pb1, 4); }
        if (act) E1_EXP(c1, 8);
        if (pend) { E1_PVM(14, pb2, 2); E1_PVM(15, pb3, 0); }
#undef E1_TRP
#undef E1_PVM
#undef E1_MAX0
#undef E1_MAX1
#undef E1_RED
#undef E1_EXP
        if (act) {
            st.l = st.l * alpha + ps;
            if (!__all(alpha == 1.f)) {
#pragma unroll
                for (int d = 0; d < 4; ++d)
#pragma unroll
                    for (int r = 0; r < 16; ++r) st.o[d][r] *= alpha;
            }
            u32x4 w0, w1, w2, w3;
            w0.x = cvtpk(c0[0], c0[1]); w0.y = cvtpk(c0[2], c0[3]); w0.z = cvtpk(c0[4], c0[5]); w0.w = cvtpk(c0[6], c0[7]);
            w1.x = cvtpk(c0[8], c0[9]); w1.y = cvtpk(c0[10], c0[11]); w1.z = cvtpk(c0[12], c0[13]); w1.w = cvtpk(c0[14], c0[15]);
            w2.x = cvtpk(c1[0], c1[1]); w2.y = cvtpk(c1[2], c1[3]); w2.z = cvtpk(c1[4], c1[5]); w2.w = cvtpk(c1[6], c1[7]);
            w3.x = cvtpk(c1[8], c1[9]); w3.y = cvtpk(c1[10], c1[11]); w3.z = cvtpk(c1[12], c1[13]); w3.w = cvtpk(c1[14], c1[15]);
            pb0 = __builtin_bit_cast(bf16x8, w0); pb1 = __builtin_bit_cast(bf16x8, w1); pb2 = __builtin_bit_cast(bf16x8, w2); pb3 = __builtin_bit_cast(bf16x8, w3);
        }
        asm volatile("s_waitcnt lgkmcnt(0)" ::: "memory");
        pend = act; stp = stg; stg = sn;
    }
#undef E1_DMAK
#undef E1_DMAV
}

struct Args {
    const float* x; const int* pos; const float* w_in; const float* w_out; const float* dlam; const float* dng; const float* lmg; const float* lmb;
    const float* rw; const float* rb; const float* wg; const float* wu; const float* wd; const float* lfg; const float* lfb;
    float* out; unsigned char* ws; int ph_lo, ph_hi;
};

struct TFDiffE1 { int q0, qpos;
    __device__ __forceinline__ bool active(int kt, int sub) const { return 64 * kt + 32 * sub <= q0; }
    __device__ __forceinline__ bool masked(int kt, int sub) const { return 64 * kt + 32 * sub == q0; }
    __device__ __forceinline__ int fetch(int) const { return 0; }
    __device__ __forceinline__ bool valid(int kt, int sub, int r, int hi, int) const { return 64 * kt + 32 * sub + crow(r, hi) <= qpos; } };

__device__ __forceinline__ void diff_unit(const Args& A, int layer, int b, int hh, int qb, LAS char* lds, const int wv) {
    int tid_ = wv * 64 + lane_id(); asm volatile("" : "+v"(tid_));
    const int tid = tid_, lane = tid & 63, wid = __builtin_amdgcn_readfirstlane(tid >> 6), sub = wid & 3, map = wid >> 2, hi = lane >> 5;
    const bf16_t* P = (const bf16_t*)(A.ws + WS_PROJ); bf16_t* MIX = (bf16_t*)(A.ws + WS_MIX);
    const int q0 = qb * 128 + sub * 32, qpos = q0 + (lane & 31), tok = b * SEQ + qpos;
    bf16x8 q[4]; fa_loadq<4>(q, P + (size_t)tok * PP + C_BQ + hh * 128 + map * 64, hi, true);
    FAState st; fa_init(st);
    TFDiffE1 tf{q0, qpos};
    e1_run<4>(st, q, P + (size_t)(b * SEQ) * PP + C_BK + hh * 128, P + (size_t)(b * SEQ) * PP + C_BV + hh * 128, 2 * qb + 2, lds, 0.125f * LOG2E, 8 * map, tf, lane, wid);
    __syncthreads();
    fa_normalize(st);
    LAS float* xch = (LAS float*)lds + sub * 4096;
    if (map == 1) {
#pragma unroll
        for (int d = 0; d < 4; ++d)
#pragma unroll
            for (int r = 0; r < 16; ++r) xch[(d * 16 + r) * 64 + lane] = st.o[d][r];
    }
    __syncthreads();
    if (map == 0) {
        int ly_ = layer; asm volatile("" : "+s"(ly_)); const int layer = ly_;
        const float* dl = A.dlam + layer * 256;
        const float s1 = wave_sum(dl[lane] * dl[64 + lane]), s2 = wave_sum(dl[128 + lane] * dl[192 + lane]);
        float c08 = 0.8f; asm volatile("" : "+v"(c08));
        const float lam_init = c08 - 0.6f * expf(-0.3f * (float)layer);
        const float lam = expf(s1) - expf(s2) + lam_init;
        float ss = 0.f;
#pragma unroll
        for (int d = 0; d < 4; ++d)
#pragma unroll
            for (int r = 0; r < 16; ++r) { const float o = st.o[d][r] - lam * xch[(d * 16 + r) * 64 + lane]; st.o[d][r] = o; ss += o * o; }
        ss = xsum32(ss);
        const float rinv = rsqrtf(ss * (1.f / 128.f) + LN_EPS) * (1.f - lam_init);
        const float* g = A.dng + layer * 128;
#pragma unroll
        for (int d = 0; d < 4; ++d)
#pragma unroll
            for (int r = 0; r < 16; ++r) st.o[d][r] *= rinv * g[32 * d + crow(r, hi)];
        fa_store(st, MIX + (size_t)tok * DM + 512 + hh * 128, hi);
    }
}

struct TFMobaE1 { int j, q0, qpos; unsigned selmask, wavemask;
    __device__ __forceinline__ bool active(int kt, int sub) const { const int n = kt >> 2; return n < j ? ((wavemask >> n) & 1u) != 0u : (64 * kt + 32 * sub <= q0); }
    __device__ __forceinline__ bool masked(int kt, int sub) const { const int n = kt >> 2; return n < j ? true : (64 * kt + 32 * sub == q0); }
    __device__ __forceinline__ int fetch(int) const { return 0; }
    __device__ __forceinline__ bool valid(int kt, int sub, int r, int hi, int) const { const int n = kt >> 2; return n < j ? ((selmask >> n) & 1u) != 0u : (64 * kt + 32 * sub + crow(r, hi) <= qpos); } };

__device__ __forceinline__ void moba_unit(const Args& A, int layer, int b, int hh, int j, LAS char* lds, const int wv) {
    int tid_ = wv * 64 + lane_id(); asm volatile("" : "+v"(tid_));
    const int tid = tid_, lane = tid & 63, wid = __builtin_amdgcn_readfirstlane(tid >> 6), hi = lane >> 5;
    const bf16_t* P = (const bf16_t*)(A.ws + WS_PROJ); bf16_t* MIX = (bf16_t*)(A.ws + WS_MIX);
    LAS float* km = (LAS float*)(lds + AUX_OFF);
    { const float* kms = (const float*)(A.ws + WS_CTL + KM_OFF) + (size_t)((layer * NB + b) * 16) * 512 + hh * 128;
      for (int i = tid; i < j * 128; i += 512) km[i] = kms[(size_t)(i >> 7) * 512 + (i & 127)] * (1.f / 256.f); }
    __syncthreads();
    const int q0 = j * 256 + wid * 32, qpos = q0 + (lane & 31), tok = b * SEQ + qpos;
    const bf16_t* qrow = P + (size_t)tok * PP + C_CQ + hh * 128;
    float gate[16];
#pragma unroll
    for (int n = 0; n < 16; ++n) gate[n] = 0.f;
#pragma unroll 1
    for (int c = 0; c < 16; ++c) {
        const u32x4 qw = *(const u32x4*)(qrow + 8 * c);
        const float qf[8] = {bflo(qw.x), bfhi(qw.x), bflo(qw.y), bfhi(qw.y), bflo(qw.z), bfhi(qw.z), bflo(qw.w), bfhi(qw.w)};
#pragma unroll
        for (int n = 0; n < 16; ++n) {
            const f32x4 k0 = *(const LAS f32x4*)(km + n * 128 + 8 * c), k1 = *(const LAS f32x4*)(km + n * 128 + 8 * c + 4);
            gate[n] += qf[0] * k0[0] + qf[1] * k0[1] + qf[2] * k0[2] + qf[3] * k0[3] + qf[4] * k1[0] + qf[5] * k1[1] + qf[6] * k1[2] + qf[7] * k1[3];
        }
    }
    unsigned selmask = 0u;
#pragma unroll
    for (int pick = 0; pick < 3; ++pick) {
        float best = NEG_INF; int bi = -1;
#pragma unroll
        for (int n = 0; n < 16; ++n) { const bool ok = (n < j) && !((selmask >> n) & 1u) && (gate[n] > best || bi < 0); if (ok) { best = gate[n]; bi = n; } }
        if (bi >= 0) selmask |= 1u << bi;
    }
    unsigned wavemask = 0u;
#pragma unroll
    for (int n = 0; n < 16; ++n) wavemask |= (__any((selmask >> n) & 1u) ? 1u : 0u) << n;
    bf16x8 q[8]; fa_loadq<8>(q, qrow, hi, true);
    FAState st; fa_init(st);
    TFMobaE1 tf{j, q0, qpos, selmask, wavemask};
    e1_run<8>(st, q, P + (size_t)(b * SEQ) * PP + C_CK + hh * 128, P + (size_t)(b * SEQ) * PP + C_CV + hh * 128, 4 * j + 4, lds, 0.08838834764831845f * LOG2E, 0, tf, lane, wid);
    fa_normalize(st);
    int tok2 = b * SEQ + j * 256 + wid * 32 + (lane_id() & 31); asm volatile("" : "+v"(tok2));
    fa_store(st, MIX + (size_t)tok2 * DM + 1024 + hh * 128, hi);
}

struct TFDil { int rowbase, base, stride, add, uq, want, q4;
    __device__ __forceinline__ int row(int t, int key) const { int u = base + 32 * t + key; u = u < 0 ? 0 : u; int s = stride * u + add; s = s > SEQ - 1 ? SEQ - 1 : s; return rowbase + s; }
    __device__ __forceinline__ bool valid(int t, int r, int hi) const { const int u = base + 32 * t + crow(r, hi), d = uq - u; return u >= 0 && d >= 0 && d <= 128 && (want < 0 || q4 == want); } };

__device__ __forceinline__ void dil_unit(const Args& A, int b, int hh, int blk, LAS char* lds, const int wv) {
    int tid_ = wv * 64 + lane_id(); asm volatile("" : "+v"(tid_));
    const int tid = tid_, lane = tid & 63, wid = __builtin_amdgcn_readfirstlane(tid >> 6), hi = lane >> 5;
    const bf16_t* P = (const bf16_t*)(A.ws + WS_PROJ); bf16_t* MIX = (bf16_t*)(A.ws + WS_MIX);
    const int t0 = blk * 256 + (wid >> 2) * 128, r4 = wid & 3, c = lane & 31, i = c & 7, q4 = c >> 3;
    const int tq = t0 + 16 * i + 4 * q4 + r4, tok = b * SEQ + tq;
    bf16x8 q[8]; fa_loadq<8>(q, P + (size_t)tok * PP + C_DQ + hh * 128, hi, true); const LAS char* ql = nullptr;
    FAState st; fa_init(st);
    const float sc = 0.08838834764831845f * LOG2E;
    LAS char* vl = lds + wid * VT_BYTES;
    const int kc = C_DK + hh * 128, vc = C_DV + hh * 128;
    { TFDil tf{b * SEQ, t0 - 128, 1, 0, tq, -1, q4}; fa_run<8, false>(st, q, ql, P, tf, t0 >= 128 ? 0 : 4, 8, vl, sc, kc, vc, lane); }
    { const int u0 = t0 >> 2; int ts = (128 - u0 + 31) >> 5; ts = ts < 0 ? 0 : ts;
      TFDil tf{b * SEQ, u0 - 128, 4, r4, u0 + 4 * i + q4, -1, q4}; fa_run<8, false>(st, q, ql, P, tf, ts, 5, vl, sc, kc, vc, lane); }
    { const int u0 = t0 >> 4; int ts = (128 - u0 + 31) >> 5; ts = ts < 0 ? 0 : ts;
      for (int w4 = 0; w4 < 4; ++w4) { TFDil tf{b * SEQ, u0 - 128, 16, r4 + 4 * w4, u0 + i, w4, q4}; fa_run<8, false>(st, q, ql, P, tf, ts, 5, vl, sc, kc, vc, lane); } }
    fa_normalize(st);
    fa_store(st, MIX + (size_t)tok * DM + 1536 + hh * 128, hi);
}

struct TFDsaE1 { const LAS char* mb;
    __device__ __forceinline__ bool active(int, int) const { return true; }
    __device__ __forceinline__ bool masked(int, int) const { return true; }
    __device__ __forceinline__ unsigned fetch(int kt) const { return *(const LAS unsigned*)(mb + 512 * kt); }
    __device__ __forceinline__ bool valid(int, int sub, int r, int, unsigned mw) const { return ((mw >> (8 * (r & 3) + 4 * sub + (r >> 2))) & 1u) != 0u; } };

__device__ __forceinline__ unsigned ord16(unsigned h) { return (h & 0x8000u) ? (~h & 0xffffu) : (h | 0x8000u); }

__device__ __forceinline__ void dsa_unit(const Args& A, int layer, int b, int t0, LAS char* lds, const int wv, const int level) {
    int tid_ = wv * 64 + lane_id(); asm volatile("" : "+v"(tid_));
    const int tid = tid_, lane = tid & 63, wid = __builtin_amdgcn_readfirstlane(tid >> 6), hi = lane >> 5;
    const bf16_t* P = (const bf16_t*)(A.ws + WS_PROJ); bf16_t* MIX = (bf16_t*)(A.ws + WS_MIX);
    LAS unsigned short* sco = (LAS unsigned short*)lds;
    LAS char* kst = lds + 131072;
    unsigned* dsac = (unsigned*)(A.ws + WS_CTL) + CW_DSAC + 128 * layer + 64 * b + (t0 >> 6);
    const int nkeys = t0 + 16, nchunk = (nkeys + 127) >> 7;
    {
        const int r = lane & 31;
        const int tokq = b * SEQ + t0 + 2 * wid + (r >> 4);
        bf16x8 aq[4];
#pragma unroll
        for (int s = 0; s < 4; ++s) aq[s] = *(const bf16x8*)(P + (size_t)tokq * PP + C_IQ + (r & 15) * 64 + 16 * s + 8 * hi);
        float wgt[16];
#pragma unroll
        for (int rr = 0; rr < 16; ++rr) { const int head = (rr & 3) + 8 * ((rr >> 2) & 1) + 4 * hi;
            wgt[rr] = bf2f(P[(size_t)(b * SEQ + t0 + 2 * wid + (rr >> 3)) * PP + C_IW + head]) * 0.03125f; }
        const int tlim = (t0 + 2 * wid + 1) >> 5;
        const int k0_ = tid >> 3, c0_ = tid & 7;
        const bf16_t* src = P + (size_t)(b * SEQ) * PP + C_IK + c0_ * 8;
        u32x4 pa0, pa1, pb0, pb1;
#define DSA_STAGE_LOAD(d0_, d1_, ch_) do { int ka_ = 128 * (ch_) + k0_, kb_ = ka_ + 64; ka_ = ka_ > SEQ - 1 ? SEQ - 1 : ka_; kb_ = kb_ > SEQ - 1 ? SEQ - 1 : kb_; \
            d0_ = *(const u32x4*)(src + (size_t)ka_ * PP); d1_ = *(const u32x4*)(src + (size_t)kb_ * PP); } while (0)
#define DSA_CHUNK(s0_, s1_, ch_) do { \
            __syncthreads(); \
            *(LAS u32x4*)(kst + k0_ * 128 + ((c0_ ^ ((k0_ >> 1) & 7)) << 4)) = s0_; \
            *(LAS u32x4*)(kst + (k0_ + 64) * 128 + ((c0_ ^ (((k0_ + 64) >> 1) & 7)) << 4)) = s1_; \
            __syncthreads(); \
            if ((ch_) + 2 < nchunk) DSA_STAGE_LOAD(s0_, s1_, (ch_) + 2); \
              \
            _Pragma("unroll") for (int th = 0; th < 4; th += 2) { \
                bf16x8 kb_[2][4]; \
                _Pragma("unroll") for (int tt = 0; tt < 2; ++tt) { const int kr = 32 * (th + tt) + r; \
                    _Pragma("unroll") for (int s = 0; s < 4; ++s) kb_[tt][s] = *(const LAS bf16x8*)(kst + kr * 128 + (((2 * s + hi) ^ ((kr >> 1) & 7)) << 4)); } \
                f32x16 ca_[2]; \
                _Pragma("unroll") for (int tt = 0; tt < 2; ++tt) ca_[tt] = (f32x16){0.f, 0.f, 0.f, 0.f, 0.f, 0.f, 0.f, 0.f, 0.f, 0.f, 0.f, 0.f, 0.f, 0.f, 0.f, 0.f}; \
                _Pragma("unroll") for (int s = 0; s < 4; ++s) \
                    _Pragma("unroll") for (int tt = 0; tt < 2; ++tt) ca_[tt] = __builtin_amdgcn_mfma_f32_32x32x16_bf16(aq[s], kb_[tt][s], ca_[tt], 0, 0, 0); \
                _Pragma("unroll") for (int tt = 0; tt < 2; ++tt) { \
                    float p0 = 0.f, p1 = 0.f; \
                    _Pragma("unroll") for (int rr = 0; rr < 8; ++rr) { const float r0_ = __builtin_amdgcn_fmed3f(ca_[tt][rr], 0.f, 3.0e38f), r1_ = __builtin_amdgcn_fmed3f(ca_[tt][8 + rr], 0.f, 3.0e38f);     \
                        p0 = __builtin_fmaf(wgt[rr], r0_, p0); p1 = __builtin_fmaf(wgt[8 + rr], r1_, p1); } \
                    const swap2 sw = pl32swap(p0, p1); const float tot = sw.a + sw.b; \
                    const _Float16 hsc = (_Float16)tot; \
                    sco[(2 * wid + hi) * 4096 + 32 * (4 * (ch_) + th + tt) + r] = __builtin_bit_cast(unsigned short, hsc); \
                } __builtin_amdgcn_sched_barrier(0); } } while (0)
        DSA_STAGE_LOAD(pa0, pa1, 0);
        if (nchunk > 1) DSA_STAGE_LOAD(pb0, pb1, 1);
        for (int ch = 0; ch < nchunk; ch += 2) {
            DSA_CHUNK(pa0, pa1, ch);
            if (ch + 1 < nchunk) DSA_CHUNK(pb0, pb1, ch + 1);
        }
#undef DSA_CHUNK
#undef DSA_STAGE_LOAD
    }
    __syncthreads();
    if (level < 2) return;
#pragma unroll 1
    for (int qq = 0; qq < 2; ++qq) {
        const int qi = 2 * wid + qq, tq = t0 + qi, nv = tq + 1;
        unsigned long long* bmq = (unsigned long long*)(A.ws + WS_BM) + (size_t)(b * SEQ + tq) * 64;
        if (nv <= 256) { const int cntl = tq >= lane ? ((tq - lane) >> 3) + 1 : 0;
            if (lane < 8) __hip_atomic_store(bmq + lane, (1ull << cntl) - 1ull, RLX_AGENT);
            continue; }
        const int nch = (nv + 511) >> 9;
        typedef unsigned short u16x2 __attribute__((ext_vector_type(2)));
        unsigned v[32];
#pragma unroll
        for (int i = 0; i < 8; ++i) {
            if (i < nch) { const u32x4 f = *(const LAS u32x4*)(sco + qi * 4096 + i * 512 + 8 * lane);
                const unsigned w[4] = {f.x, f.y, f.z, f.w};
#pragma unroll
                for (int d = 0; d < 4; ++d) { const int k0 = i * 512 + 8 * lane + 2 * d;
                    const unsigned neg = (w[d] >> 15) & 0x00010001u, ordw = w[d] ^ ((neg * 0xffffu) | 0x80008000u);
                    const unsigned vm = (k0 <= tq ? 0x0000ffffu : 0u) | (k0 + 1 <= tq ? 0xffff0000u : 0u);
                    v[i * 4 + d] = ordw & vm; } }
            else {
#pragma unroll
                for (int d = 0; d < 4; ++d) v[i * 4 + d] = 0u; }
        }
        const unsigned one2u = 0x00010001u;
        unsigned x = 0u;
        for (int bit = 15; bit >= 0; --bit) {
            const unsigned cand = x | (1u << bit), cm1 = (cand - 1u) * 0x00010001u;
            unsigned c2u = 0u;
#pragma unroll
            for (int i = 0; i < 8; ++i) if (i < nch) {
#pragma unroll
                for (int d = 0; d < 4; ++d) { unsigned t_; asm("v_pk_sub_u16 %0, %1, %2 clamp" : "=v"(t_) : "v"(v[i * 4 + d]), "v"(cm1)); asm("v_pk_min_u16 %0, %1, %2" : "=v"(t_) : "v"(t_), "v"(one2u)); asm("v_pk_add_u16 %0, %1, %2" : "=v"(c2u) : "v"(c2u), "v"(t_)); } }
            const int cl = (int)(c2u & 0xffffu) + (int)(c2u >> 16);
            const int cnt = wave_isum(cl);
            if (cnt >= 256) x = cand;
            if (cnt == 256) break;
        }
        int gtot = 0;
        { const unsigned xs = x * 0x00010001u; unsigned c2u = 0u;
#pragma unroll
          for (int i = 0; i < 8; ++i) if (i < nch) {
#pragma unroll
              for (int d = 0; d < 4; ++d) { unsigned t_; asm("v_pk_sub_u16 %0, %1, %2 clamp" : "=v"(t_) : "v"(v[i * 4 + d]), "v"(xs)); asm("v_pk_min_u16 %0, %1, %2" : "=v"(t_) : "v"(t_), "v"(one2u)); asm("v_pk_add_u16 %0, %1, %2" : "=v"(c2u) : "v"(c2u), "v"(t_)); } }
          const int cg = (int)(c2u & 0xffffu) + (int)(c2u >> 16);
          gtot = wave_isum(cg); }
        int be = gtot;
        unsigned long long myw = 0ull;
#pragma unroll
        for (int i = 0; i < 8; ++i) if (i < nch) {
#pragma unroll
            for (int e = 0; e < 8; ++e) {
                const unsigned vv = (e & 1) ? (v[i * 4 + (e >> 1)] >> 16) : (v[i * 4 + (e >> 1)] & 0xffffu);
                const bool g = vv > x, eq = vv == x;
                const unsigned long long mg = __ballot(g), me = __ballot(eq);
                const int pe = be + (int)__builtin_amdgcn_mbcnt_hi((unsigned)(me >> 32), __builtin_amdgcn_mbcnt_lo((unsigned)me, 0u));
                const unsigned long long wj = mg | __ballot(eq && pe < 256);
                if (lane == 8 * i + e) myw = wj;
                be += __popcll(me);
            }
        }
        if (lane < 8 * nch) __hip_atomic_store(bmq + lane, myw, RLX_AGENT);
    }
    asm volatile("s_waitcnt vmcnt(0)" ::: "memory");
    __syncthreads();
    if (tid == 0) __hip_atomic_fetch_add(dsac, 1u, RLX_AGENT);
}

__device__ __forceinline__ void dsa_att_unit(const Args& A, int layer, int b, int g, LAS char* lds, const int wv) {
    int tid_ = wv * 64 + lane_id(); asm volatile("" : "+v"(tid_));
    const int tid = tid_, lane = tid & 63, wid = __builtin_amdgcn_readfirstlane(tid >> 6), hi = lane >> 5;
    const bf16_t* P = (const bf16_t*)(A.ws + WS_PROJ); bf16_t* MIX = (bf16_t*)(A.ws + WS_MIX);
    unsigned* ctl = (unsigned*)(A.ws + WS_CTL);
    if (tid == 0) {
        unsigned sp = 0u;
        while (__hip_atomic_load(ctl + CW_DSAC + 128 * layer + 64 * b + g, RLX_AGENT) < 4u) { __builtin_amdgcn_s_sleep(2);
            if ((++sp & 255u) == 0u) { if (__hip_atomic_load(ctl + CW_BAR + XB_TMO, RLX_AGENT)) break; if (sp > XB_SPIN_CAP) { atomicAdd(ctl + CW_BAR + XB_TMO, 1u); break; } } }
    }
    __syncthreads();
    __builtin_amdgcn_fence(__ATOMIC_ACQUIRE, "agent");
    LAS char* bml = lds + E1_NS * E1_STAGE;
    { const int qi = tid >> 3, e = tid & 7; const unsigned long long* src = (const unsigned long long*)(A.ws + WS_BM) + (size_t)(b * SEQ + 64 * g + qi) * 64 + e;
      for (int i = 0; 8 * i <= g; ++i) { const unsigned long long w = src[8 * i];
#pragma unroll
          for (int j = 0; j < 8; ++j) *(LAS unsigned char*)(bml + 512 * (8 * i + j) + 8 * qi + e) = (unsigned char)(w >> (8 * j)); } }
    const int c = lane & 31, qi = 8 * wid + (c >> 2), tok = b * SEQ + 64 * g + qi;
    bf16x8 q[8]; fa_loadq<8>(q, P + (size_t)tok * PP + C_AQ + (c & 3) * 128, hi, true);
    FAState st; fa_init(st);
    TFDsaE1 tf{bml + 8 * qi + 4 * hi};
    __syncthreads();
    e1_run<8>(st, q, P + (size_t)(b * SEQ) * PP + C_AK, P + (size_t)(b * SEQ) * PP + C_AV, g + 1, lds, 0.08838834764831845f * LOG2E, 0, tf, lane, wid);
    fa_normalize(st);
    fa_store(st, MIX + (size_t)tok * DM + (c & 3) * 128, hi);
}

#define XB_XCNT(j)  (256  + 64 * (j))
#define XB_XSUB(j)  (1280 + 64 * (j))
#define XB_XGEN(j)  (2304 + 64 * (j))
#define XB_TOP      3328
#define XB_TOPGEN   3392
__device__ __forceinline__ unsigned xb_ld(unsigned* p)              { return __hip_atomic_load(p, __ATOMIC_RELAXED, __HIP_MEMORY_SCOPE_AGENT); }
__device__ __forceinline__ unsigned xb_add(unsigned* p, unsigned v) { return __hip_atomic_fetch_add(p, v, __ATOMIC_RELAXED, __HIP_MEMORY_SCOPE_AGENT); }
__device__ __forceinline__ unsigned xb_xcc_id() { return (unsigned)__builtin_amdgcn_s_getreg((3 << 11) | 20) & 0xFu; }
#define XB_SPIN(cond, bar) do { unsigned _sp = 0; while (cond) { __builtin_amdgcn_s_sleep(1); \
    if ((++_sp & 255u) == 0u) { if (xb_ld(&(bar)[XB_TMO])) break; if (_sp > XB_SPIN_CAP) { atomicAdd(&(bar)[XB_TMO], 1u); break; } } } } while (0)
struct XcdBarrier { unsigned* bar; unsigned x; volatile LAS unsigned* st; };
__device__ __forceinline__ XcdBarrier xcd_barrier_post(unsigned* bar, volatile LAS unsigned* st, bool leader) {
    XcdBarrier b; b.bar = bar; b.x = xb_xcc_id(); b.st = st;
    if (leader) (void)xb_add(&bar[XB_XCNT(b.x)], 1u);
    return b;
}
__device__ __forceinline__ void xcd_barrier_complete(unsigned* bar, unsigned x, unsigned& nloc, unsigned& nx) {
    const unsigned G = gridDim.x * gridDim.y * gridDim.z;
    unsigned sum, cnt, mine, sp = 0u;
    for (;;) {
        sum = 0u; cnt = 0u; mine = 0u;
#pragma unroll
        for (unsigned j = 0; j < 16; ++j) { const unsigned c = xb_ld(&bar[XB_XCNT(j)]); sum += c; cnt += (c > 0u) ? 1u : 0u; mine = (j == x) ? c : mine; }
        if (sum == G) break;
        __builtin_amdgcn_s_sleep(1);
        if ((++sp & 255u) == 0u) { if (xb_ld(&bar[XB_TMO])) break; if (sp > XB_SPIN_CAP) { atomicAdd(&bar[XB_TMO], 1u); break; } }
    }
    nloc = mine > 0u ? mine : 1u; nx = cnt > 0u ? cnt : 1u;
}
__device__ __forceinline__ void xcd_barrier(const XcdBarrier& b, bool leader) {
    asm volatile("s_waitcnt vmcnt(0)" ::: "memory");
    __syncthreads();
    if (leader) {
        unsigned* bar = b.bar;
        __builtin_amdgcn_s_waitcnt(0);
        unsigned nloc = b.st[0], nx = b.st[1];
        if (nloc == 0u) { xcd_barrier_complete(bar, b.x, nloc, nx); b.st[0] = nloc; b.st[1] = nx; }
        const unsigned old = xb_add(&bar[XB_XSUB(b.x)], 1u);
        const unsigned gen = old / nloc;
        if (old + 1u == (gen + 1u) * nloc) {
            __builtin_amdgcn_fence(__ATOMIC_RELEASE, "agent");
            asm volatile("s_waitcnt vmcnt(0)" ::: "memory");
            const unsigned og = xb_add(&bar[XB_TOP], 1u);
            const unsigned tg = og / nx;
            if (og + 1u == (tg + 1u) * nx) xb_add(&bar[XB_TOPGEN], 1u);
            else XB_SPIN(xb_ld(&bar[XB_TOPGEN]) == tg, bar);
            __builtin_amdgcn_fence(__ATOMIC_ACQUIRE, "agent");
            xb_add(&bar[XB_XGEN(b.x)], 1u);
            asm volatile("s_waitcnt vmcnt(0)" ::: "memory");
        } else {
            XB_SPIN(xb_ld(&bar[XB_XGEN(b.x)]) == gen, bar);
            __builtin_amdgcn_fence(__ATOMIC_ACQUIRE, "agent");
            asm volatile("s_waitcnt vmcnt(0)" ::: "memory");
        }
    }
    __syncthreads();
}

struct Frame { LAS unsigned char* lds; LAS int* lctl; int wave, vcu, G; };

constexpr int NT8 = 20, NTB = 6;
constexpr size_t WIN_LAYER = 26 * MiB, WIN_BF = 10 * MiB;
struct TItem { const float* W; bf16_t* WT; int ldw, ldt, ncols, f8; };
__device__ __forceinline__ TItem decode_item(const Args& A, int it) {
    constexpr int I_IN = 208 * 32, I_OUT = 64 * 32, I_G = 32 * 32, I_D = 64 * 16;
    constexpr int N_IN = DEPTH * I_IN, N_OUT = DEPTH * I_OUT, N_GU = DEPTH * NE * 2 * I_G;
    TItem t; int r = it;
    if (r < N_IN) { const int l = r / I_IN; r -= l * I_IN; const int cb = r >> 5, kb = r & 31, bj = (cb >> 2) & 1;
        const int tile = cb >> 3, wc = cb & 3, grp = tile * 4 + wc;
        const int mode = GRP[grp][0], lo = GRP[grp][1], ho = GRP[grp][2];
        int ncols = 32, n0 = lo + (bj ? ho : 0);
        if (mode == 4) { ncols = 0; n0 = 0; } else if (mode == 3) { ncols = bj ? 0 : 16; n0 = lo; }
        t.W = A.w_in + (size_t)l * DM * PP + (size_t)(kb * 64) * PP + n0; t.ldw = PP; t.ncols = ncols; t.ldt = DM;
        if (tile < NT8) { t.f8 = 1; t.WT = (bf16_t*)(A.ws + WS_WIN + l * WIN_LAYER + (size_t)(cb * 32) * DM + kb * 64); }
        else { t.f8 = 0; t.WT = (bf16_t*)(A.ws + WS_WIN + l * WIN_LAYER + WIN_BF) + (size_t)((cb - NT8 * 8) * 32) * DM + kb * 64; }
        return t; }
    r -= N_IN;
    if (r < N_OUT) { const int l = r / I_OUT; r -= l * I_OUT; const int nb = r >> 5, kb = r & 31;
        t.W = A.w_out + (size_t)l * DM * DM + (size_t)(kb * 64) * DM + nb * 32; t.ldw = DM; t.ncols = 32; t.f8 = 0;
        t.WT = (bf16_t*)(A.ws + WS_WOUT) + (size_t)l * DM * DM + (size_t)(nb * 32) * DM + kb * 64; t.ldt = DM; return t; }
    r -= N_OUT;
    if (r < N_GU) { const int le = r / (2 * I_G); r -= le * 2 * I_G; const int up = r / I_G; r -= up * I_G; const int nb = r >> 5, kb = r & 31, n0 = nb * 32;
        t.W = (up ? A.wu : A.wg) + (size_t)le * DM * DFF + (size_t)(kb * 64) * DFF + n0; t.ldw = DFF; t.ncols = 32; t.f8 = 1;
        t.WT = (bf16_t*)((unsigned char*)(A.ws + WS_WGU) + (size_t)le * DM * DM + (size_t)(256 * (n0 >> 7) + (n0 & 127) + 128 * up) * DM + kb * 64); t.ldt = DM; return t; }
    r -= N_GU;
    { const int le = r / I_D; r -= le * I_D; const int nb = r >> 4, kb = r & 15;
      t.W = A.wd + (size_t)le * DFF * DM + (size_t)(kb * 64) * DM + nb * 32; t.ldw = DM; t.ncols = 32; t.f8 = 1;
      t.WT = (bf16_t*)((unsigned char*)(A.ws + WS_WD) + (size_t)le * DM * DFF + (size_t)(nb * 32) * DFF + kb * 64); t.ldt = DFF; return t; }
}
__device__ __forceinline__ void titem_load(const TItem& t, f32x4 (&v)[8], int lane) {
    const int c4 = (lane & 7) * 4; const bool on = c4 < t.ncols;
#pragma unroll
    for (int i = 0; i < 8; ++i) { const float* p = t.W + (size_t)((lane >> 3) + 8 * i) * t.ldw + c4; v[i] = on ? *(const f32x4*)p : (f32x4){0.f, 0.f, 0.f, 0.f}; }
}
__device__ __forceinline__ void titem_store(const TItem& t, const f32x4 (&v)[8], LAS float* scr, int lane) {
    const int c4 = (lane & 7) * 4;
#pragma unroll
    for (int i = 0; i < 8; ++i) { LAS float* d = scr + ((lane >> 3) + 8 * i) * 33 + c4; d[0] = v[i][0]; d[1] = v[i][1]; d[2] = v[i][2]; d[3] = v[i][3]; }
    asm volatile("s_waitcnt lgkmcnt(0)" ::: "memory");
    const int c = lane & 7;
#pragma unroll
    for (int j = 0; j < 4; ++j) { const int n = (lane >> 3) + 8 * j; const LAS float* s = scr + (8 * c) * 33 + n;
        if (t.f8) { u32x2 o; o.x = pk4_fp8(64.f * s[0 * 33], 64.f * s[1 * 33], 64.f * s[2 * 33], 64.f * s[3 * 33]); o.y = pk4_fp8(64.f * s[4 * 33], 64.f * s[5 * 33], 64.f * s[6 * 33], 64.f * s[7 * 33]);
            *(u32x2*)((unsigned char*)t.WT + (size_t)n * t.ldt + 8 * c) = o; }
        else { u32x4 o; o.x = cvtpk(s[0 * 33], s[1 * 33]); o.y = cvtpk(s[2 * 33], s[3 * 33]); o.z = cvtpk(s[4 * 33], s[5 * 33]); o.w = cvtpk(s[6 * 33], s[7 * 33]);
            *(u32x4*)(t.WT + (size_t)n * t.ldt + 8 * c) = o; } }
    asm volatile("s_waitcnt lgkmcnt(0)" ::: "memory");
}

constexpr int FILL_E1 = 2048, FILL_E2 = FILL_E1 + 32768, FILL_E3 = FILL_E2 + 16384, FILL_E4 = FILL_E3 + 6656, FILL_E5 = FILL_E4 + 2048, FILL_E6 = FILL_E5 + 32768, FILL_E7 = FILL_E6 + 16384;
constexpr int CW_FILL = 3200, CW_DONE = 2112;
__device__ __forceinline__ int fill_to_item(int i) {
    constexpr int N_IN = 2 * 6656, N_OUT = 2 * 2048, N_GU = 2 * 32768;
    if (i < FILL_E1) return N_IN + i;
    if (i < FILL_E2) return N_IN + N_OUT + (i - FILL_E1);
    if (i < FILL_E3) return N_IN + N_OUT + N_GU + (i - FILL_E2);
    if (i < FILL_E4) return 6656 + (i - FILL_E3);
    if (i < FILL_E5) return N_IN + 2048 + (i - FILL_E4);
    if (i < FILL_E6) return N_IN + N_OUT + 32768 + (i - FILL_E5);
    return N_IN + N_OUT + N_GU + 16384 + (i - FILL_E6);
}
__device__ __forceinline__ void fill_run(const Args& A, Frame& F, int must, bool opp, int ph) {
    unsigned* ctl = (unsigned*)(A.ws + WS_CTL);
    const int fq = F.vcu & 7;
    unsigned* qh = ctl + CW_FILL + 64 * fq; unsigned* done = ctl + CW_DONE + 64 * ph;
    const int lane = lane_id();
    __syncthreads();
    if (opp && F.wave == 0 && lane == 0) __hip_atomic_fetch_add(done, 1u, RLX_AGENT);
    LAS float* scr = (LAS float*)(F.lds + F.wave * 16384);
    for (;;) {
        __syncthreads();
        if (F.wave == 0 && lane == 0) {
            int base = FILL_E7; const int head = (int)__hip_atomic_load(qh, RLX_AGENT);
            bool go = head < FILL_E7 / 8;
            if (go && head >= must / 8) go = opp && (int)__hip_atomic_load(done, RLX_AGENT) < F.G;
            if (go) { const int bl = (int)__hip_atomic_fetch_add(qh, 16u, RLX_AGENT); base = bl < FILL_E7 / 8 ? ((bl >> 4) * 8 + fq) * 16 : FILL_E7; }
            F.lctl[1] = base;
        }
        __syncthreads();
        const int base = F.lctl[1];
        if (base >= FILL_E7) break;
        const int i0 = base + 2 * F.wave, i1 = i0 + 1;
        f32x4 va[8], vb[8]; TItem ta, tb;
        if (i0 < FILL_E7) { ta = decode_item(A, fill_to_item(i0)); titem_load(ta, va, lane); }
        if (i1 < FILL_E7) { tb = decode_item(A, fill_to_item(i1)); titem_load(tb, vb, lane); }
#ifndef PROBE_FILL2
#define PROBE_FILL2 0
#endif
        if (i0 < FILL_E7) titem_store(ta, va, scr, lane);
        if (i1 < FILL_E7) titem_store(tb, vb, scr, lane);
        if (PROBE_FILL2) {
            if (i0 < FILL_E7) { titem_load(ta, va, lane); } if (i1 < FILL_E7) { titem_load(tb, vb, lane); }
            if (i0 < FILL_E7) titem_store(ta, va, scr, lane); if (i1 < FILL_E7) titem_store(tb, vb, scr, lane); }
    }
}

__device__ __forceinline__ void phase_prologue(const Args& A, Frame& F) {
    LAS float* scr = (LAS float*)(F.lds + F.wave * 16384);
    const int lane = lane_id(), tid = F.wave * 64 + lane;
    const int gw = F.vcu * 8 + F.wave, NGW = F.G * 8;
    constexpr int NITEMS = 208 * 32;
    {
        f32x4 va[8], vb[8]; TItem ta, tb;
        int it = gw;
        if (it < NITEMS) { ta = decode_item(A, it); titem_load(ta, va, lane); }
        while (it < NITEMS) {
            const int it1 = it + NGW, it2 = it + 2 * NGW;
            if (it1 < NITEMS) { tb = decode_item(A, it1); titem_load(tb, vb, lane); }
            titem_store(ta, va, scr, lane);
            if (it1 >= NITEMS) break;
            if (it2 < NITEMS) { ta = decode_item(A, it2); titem_load(ta, va, lane); }
            titem_store(tb, vb, scr, lane);
            it = it2;
        }
    }
    { const int gt = F.vcu * 512 + tid, NT = F.G * 512; bf16_t* XB = (bf16_t*)(A.ws + WS_XB);
      for (size_t i = gt; i < (size_t)T * DM / 8; i += NT) { const f32x4 a = ((const f32x4*)A.x)[2 * i], c = ((const f32x4*)A.x)[2 * i + 1];
          u32x4 w; w.x = cvtpk(a[0], a[1]); w.y = cvtpk(a[2], a[3]); w.z = cvtpk(c[0], c[1]); w.w = cvtpk(c[2], c[3]); ((u32x4*)XB)[i] = w;
          u32x2 q8; q8.x = pk4_fp8(a[0], a[1], a[2], a[3]); q8.y = pk4_fp8(c[0], c[1], c[2], c[3]); ((u32x2*)(A.ws + WS_XQ))[i] = q8; } }
    { const int gt = F.vcu * 512 + tid, NT = F.G * 512; f32x2* r128 = (f32x2*)(A.ws + WS_R128); f32x2* r64 = (f32x2*)(A.ws + WS_R64);
      for (int i = gt; i < T * 64; i += NT) { const int tk = i >> 6, f = i & 63; const float inv = powf(10000.f, -(float)(2 * f) / 128.f), ang = (float)A.pos[tk] * inv; r128[i] = (f32x2){cosf(ang), sinf(ang)}; }
      for (int i = gt; i < T * 32; i += NT) { const int tk = i >> 5, f = i & 31; const float inv = powf(10000.f, -(float)(2 * f) / 64.f), ang = (float)A.pos[tk] * inv; r64[i] = (f32x2){cosf(ang), sinf(ang)}; } }
}

__device__ __forceinline__ void phase_proj(const Args& A, Frame& F, int layer) {
    float* kms = (float*)(A.ws + WS_CTL + KM_OFF) + (size_t)layer * NB * 16 * 512;
    {
        pg8::DenseOrder S; S.init(T, NT8 * 256, DM / 2, A.ws + WS_WIN + layer * WIN_LAYER, F.G, (int)blockIdx.x);
        EpiProj E{(bf16_t*)(A.ws + WS_PROJ), (const f32x2*)(A.ws + WS_R128), (const f32x2*)(A.ws + WS_R64), kms, 0};
        pg8::gemm_phase<EpiProj, pg8::DenseOrder, false, true>(F.lds, (const bf16_t*)(A.ws + WS_XQ), DM / 2, S, E, F.wave);
    }
    {
        pg8::DenseOrder S; S.init(T, NTB * 256, DM, A.ws + WS_WIN + layer * WIN_LAYER + WIN_BF, F.G, (int)blockIdx.x);
        EpiProj E{(bf16_t*)(A.ws + WS_PROJ), (const f32x2*)(A.ws + WS_R128), (const f32x2*)(A.ws + WS_R64), kms, NT8};
        pg8::gemm_phase<EpiProj, pg8::DenseOrder, false, false>(F.lds, (const bf16_t*)(A.ws + WS_XB), DM, S, E, F.wave);
    }
}

constexpr int N_MIX_UNITS = 1152;
__device__ __forceinline__ void phase_mixers(const Args& A, Frame& F, int layer, int rep) {
    unsigned* qh = (unsigned*)(A.ws + WS_CTL) + CW_QUEUE + 64 * layer + 16 * rep;
    LAS char* lds = (LAS char*)F.lds;
    for (;;) {
        __syncthreads();
        if (F.wave == 0 && lane_id() == 0) F.lctl[0] = (int)__hip_atomic_fetch_add(qh, 1u, RLX_AGENT);
        __syncthreads();
        const int u = F.lctl[0];
        if (u >= N_MIX_UNITS) break;
#ifndef UNIT_ONLY
#define UNIT_ONLY (rep == 0 ? 31 : PROBE_MIX)
#endif
#ifndef PROBE_DSA
#define PROBE_DSA 3
#endif
#ifndef PROBE_MIX
#define PROBE_MIX 31
#endif
        int kind, p0, p1;
        if (u < 512)       { kind = 2; p0 = 31 - (u >> 4); p1 = u & 15; }
        else if (u < 640)  { kind = 3; p0 = u - 512; p1 = 0; }
        else if (u < 704)  { kind = 1; p0 = (u - 640) & 7; p1 = 15 - ((u - 640) >> 3); }
        else if (u < 768)  { kind = 0; p0 = (u - 704) & 7; p1 = 31 - ((u - 704) >> 3); }
        else if (u < 832)  { kind = 4; p0 = (u - 768) & 1; p1 = 63 - ((u - 768) >> 1); }
        else if (u < 864)  { kind = 1; p0 = (u - 832) & 7; p1 = 7 - ((u - 832) >> 3); }
        else if (u < 928)  { kind = 0; p0 = (u - 864) & 7; p1 = 23 - ((u - 864) >> 3); }
        else if (u < 960)  { kind = 1; p0 = (u - 928) & 7; p1 = 3 - ((u - 928) >> 3); }
        else { const int v = u - 960, L = 15 - v / 12, w = v % 12;
            if (w < 8) { kind = 0; p0 = w; p1 = L; } else { kind = 4; p0 = (w - 8) & 1; p1 = 2 * L + 1 - ((w - 8) >> 1); } }
        if (kind == 0) { if (UNIT_ONLY & 1) diff_unit(A, layer, p0 >> 2, p0 & 3, p1, lds, F.wave); continue; }
        if (kind == 1) { if (UNIT_ONLY & 2) moba_unit(A, layer, p0 >> 2, p0 & 3, p1, lds, F.wave); continue; }
        if (kind == 2) { if (UNIT_ONLY & 4) dsa_unit(A, layer, p1 >> 3, 128 * p0 + 16 * (p1 & 7), lds, F.wave, rep == 0 ? 3 : PROBE_DSA); continue; }
        if (kind == 4) { if (UNIT_ONLY & 16) dsa_att_unit(A, layer, p0, p1, lds, F.wave); continue; }
        { if (UNIT_ONLY & 8) dil_unit(A, p0 >> 6, (p0 >> 4) & 3, p0 & 15, lds, F.wave); }
    }
}

__device__ __forceinline__ void phase_outproj(const Args& A, Frame& F, int layer) {
    pg8::DenseOrder S; S.init(T, DM, DM, (const bf16_t*)(A.ws + WS_WOUT) + (size_t)layer * DM * DM, F.G, (int)blockIdx.x);
    EpiOut E{layer == 0 ? A.x : (const float*)(A.ws + WS_XF2), (bf16_t*)(A.ws + WS_Y1)};
    pg8::gemm_phase<EpiOut, pg8::DenseOrder, false>(F.lds, (const bf16_t*)(A.ws + WS_MIX), DM, S, E, F.wave);
}

__device__ __forceinline__ void route_token(const float (&lg)[16], const float* rb, LAS int* lcnt, float* tok_gate, int* tok_e, int* tok_rank, int tk, int lane) {
    float aff[16], sc[16];
#pragma unroll
    for (int e = 0; e < 16; ++e) { aff[e] = 1.f / (1.f + expf(-lg[e])); sc[e] = aff[e] + rb[e]; }
    float gbest = NEG_INF; int gi = 0;
#pragma unroll
    for (int k = 0; k < 4; ++k) {
        const float a = sc[4 * k], b = sc[4 * k + 1], c = sc[4 * k + 2], d = sc[4 * k + 3];
        const float m1 = fmaxf(fmaxf(a, b), fmaxf(c, d));
        const float lo1 = fminf(a, b), hi1 = fmaxf(a, b), lo2 = fminf(c, d), hi2 = fmaxf(c, d);
        const float m2 = fmaxf(fminf(hi1, hi2), fmaxf(lo1, lo2));
        const float gs = m1 + m2;
        if (gs > gbest) { gbest = gs; gi = k; }
    }
    float s0 = sc[0], s1 = sc[1], s2_ = sc[2], s3 = sc[3], a0 = aff[0], a1 = aff[1], a2 = aff[2], a3 = aff[3];
#pragma unroll
    for (int k = 1; k < 4; ++k) if (gi == k) { s0 = sc[4 * k]; s1 = sc[4 * k + 1]; s2_ = sc[4 * k + 2]; s3 = sc[4 * k + 3]; a0 = aff[4 * k]; a1 = aff[4 * k + 1]; a2 = aff[4 * k + 2]; a3 = aff[4 * k + 3]; }
    int i1 = 0; float b1 = s0;
    if (s1 > b1) { b1 = s1; i1 = 1; } if (s2_ > b1) { b1 = s2_; i1 = 2; } if (s3 > b1) { b1 = s3; i1 = 3; }
    int i2 = -1; float b2 = NEG_INF;
    if (i1 != 0 && (i2 < 0 || s0 > b2)) { b2 = s0; i2 = 0; }
    if (i1 != 1 && (i2 < 0 || s1 > b2)) { b2 = s1; i2 = 1; }
    if (i1 != 2 && (i2 < 0 || s2_ > b2)) { b2 = s2_; i2 = 2; }
    if (i1 != 3 && (i2 < 0 || s3 > b2)) { b2 = s3; i2 = 3; }
    const float g1 = i1 == 0 ? a0 : i1 == 1 ? a1 : i1 == 2 ? a2 : a3, g2 = i2 == 0 ? a0 : i2 == 1 ? a1 : i2 == 2 ? a2 : a3;
    if (lane == 0) {
        const int e1 = gi * 4 + i1, e2 = gi * 4 + i2; const float gsum = g1 + g2;
        const int r1 = __hip_atomic_fetch_add(lcnt + e1, 1, __ATOMIC_RELAXED, __HIP_MEMORY_SCOPE_WORKGROUP), r2 = __hip_atomic_fetch_add(lcnt + e2, 1, __ATOMIC_RELAXED, __HIP_MEMORY_SCOPE_WORKGROUP);
        tok_e[2 * tk] = e1; tok_e[2 * tk + 1] = e2; tok_rank[2 * tk] = r1; tok_rank[2 * tk + 1] = r2; tok_gate[2 * tk] = g1 / gsum; tok_gate[2 * tk + 1] = g2 / gsum;
    }
}
__device__ __forceinline__ void phase_ln1_router(const Args& A, Frame& F, int layer) {
    const int lane = lane_id(), tid = F.wave * 64 + lane;
    LAS f32x4* wl = (LAS f32x4*)F.lds;
    for (int i = tid; i < 4 * 8 * 4 * 64; i += 512) { const int l = i & 63, c = (i >> 6) & 3, j = (i >> 8) & 7, q = i >> 11; wl[i] = *(const f32x4*)(A.rw + (size_t)(256 * j + 4 * l + c) * 16 + 4 * q); }
    if (tid < 16) F.lctl[96 + tid] = 0;
    __syncthreads();
    bf16_t* Y1 = (bf16_t*)(A.ws + WS_Y1); unsigned char* X1Q = (unsigned char*)(A.ws + WS_X1B);
    int* tok_e = (int*)(A.ws + WS_ROUTE + RT_TOKE); int* tok_rank = (int*)(A.ws + WS_ROUTE + RT_RANK); float* tok_gate = (float*)(A.ws + WS_ROUTE + RT_TOKG);
    LAS int* lcnt = F.lctl + 96;
    const float* g = A.lmg + layer * DM; const float* bb = A.lmb + layer * DM;
    constexpr int TPW = 2;
    u32x2 nx[TPW][8];
    { const int tkf = (F.vcu * 8 + F.wave) * TPW;
#pragma unroll
      for (int u = 0; u < TPW; ++u)
#pragma unroll
          for (int j = 0; j < 8; ++j) nx[u][j] = *(const u32x2*)(Y1 + (size_t)(tkf + u) * DM + 256 * j + 4 * lane); }
#pragma clang loop unroll(disable)
    for (int tk0 = (F.vcu * 8 + F.wave) * TPW; tk0 < T; tk0 += F.G * 8 * TPW) {
        f32x4 v[TPW][8]; float mean[TPW], rstd[TPW];
#pragma unroll
        for (int u = 0; u < TPW; ++u)
#pragma unroll
            for (int j = 0; j < 8; ++j) { const u32x2 y = nx[u][j]; v[u][j][0] = bflo(y.x); v[u][j][1] = bfhi(y.x); v[u][j][2] = bflo(y.y); v[u][j][3] = bfhi(y.y); }
        { const int tkn = tk0 + F.G * 8 * TPW;
          if (tkn < T) {
#pragma unroll
              for (int u = 0; u < TPW; ++u)
#pragma unroll
                  for (int j = 0; j < 8; ++j) nx[u][j] = *(const u32x2*)(Y1 + (size_t)(tkn + u) * DM + 256 * j + 4 * lane); } }
#pragma unroll
        for (int u = 0; u < TPW; ++u) { float s = 0.f;
#pragma unroll
            for (int j = 0; j < 8; ++j) s += (v[u][j][0] + v[u][j][1]) + (v[u][j][2] + v[u][j][3]);
            mean[u] = s; }
#pragma unroll
        for (int u = 0; u < TPW; ++u) mean[u] = allsum(mean[u]);
#pragma unroll
        for (int u = 0; u < TPW; ++u) { mean[u] *= (1.f / DM); float s2 = 0.f;
#pragma unroll
            for (int j = 0; j < 8; ++j) { v[u][j] = v[u][j] - mean[u]; s2 += (v[u][j][0] * v[u][j][0] + v[u][j][1] * v[u][j][1]) + (v[u][j][2] * v[u][j][2] + v[u][j][3] * v[u][j][3]); }
            rstd[u] = s2; }
#pragma unroll
        for (int u = 0; u < TPW; ++u) rstd[u] = allsum(rstd[u]);
#pragma unroll
        for (int u = 0; u < TPW; ++u) rstd[u] = rsqrtf(rstd[u] * (1.f / DM) + LN_EPS);
        float lg[TPW][16];
#pragma unroll
        for (int u = 0; u < TPW; ++u)
#pragma unroll
            for (int e = 0; e < 16; ++e) lg[u][e] = 0.f;
#pragma unroll
        for (int j = 0; j < 8; ++j) {
            const f32x4 gg = *(const f32x4*)(g + 256 * j + 4 * lane), b4 = *(const f32x4*)(bb + 256 * j + 4 * lane);
#pragma unroll
            for (int u = 0; u < TPW; ++u) {
                v[u][j] = v[u][j] * rstd[u] * gg + b4;
                { u32x2 w; w.x = cvtpk(v[u][j][0], v[u][j][1]); w.y = cvtpk(v[u][j][2], v[u][j][3]); *(u32x2*)(Y1 + (size_t)(tk0 + u) * DM + 256 * j + 4 * lane) = w; }
                *(unsigned*)(X1Q + (size_t)(tk0 + u) * DM + 256 * j + 4 * lane) = pk4_fp8(v[u][j][0], v[u][j][1], v[u][j][2], v[u][j][3]);
            }
#pragma unroll
            for (int c = 0; c < 4; ++c) {
#pragma unroll
                for (int q = 0; q < 4; ++q) { const f32x4 w4 = wl[((q * 8 + j) * 4 + c) * 64 + lane];
#pragma unroll
                    for (int u = 0; u < TPW; ++u) { lg[u][4 * q] += v[u][j][c] * w4[0]; lg[u][4 * q + 1] += v[u][j][c] * w4[1]; lg[u][4 * q + 2] += v[u][j][c] * w4[2]; lg[u][4 * q + 3] += v[u][j][c] * w4[3]; } }
                __builtin_amdgcn_sched_barrier(0);
            }
        }
#pragma unroll
        for (int u = 0; u < TPW; ++u)
#pragma unroll
            for (int e = 0; e < 16; ++e) lg[u][e] = allsum(lg[u][e]);
#pragma unroll
        for (int u = 0; u < TPW; ++u) route_token(lg[u], A.rb, lcnt, tok_gate, tok_e, tok_rank, tk0 + u, lane);
    }
    __syncthreads();
    { const int t2 = F.wave * 64 + lane_id();
      if (t2 < 16) ((int*)(A.ws + WS_ROUTE + RT_BLK))[F.vcu * 16 + t2] = lcnt[t2]; }
}
__device__ __forceinline__ void route_finish(const Args& A, Frame& F, int layer) {
    const int lane = lane_id(), tid = F.wave * 64 + lane;
    LAS int* tab = (LAS int*)F.lds;
    const int* blk = (const int*)(A.ws + WS_ROUTE + RT_BLK);
    for (int i = tid; i < F.G * 16; i += 512) tab[i] = blk[i];
    __syncthreads();
    if (tid < 16) { int base = 0, tot = 0;
        for (int b = 0; b < F.G; ++b) { const int c = tab[b * 16 + tid]; tot += c; if (b < F.vcu) base += c; }
        F.lctl[112 + tid] = base;
        if (F.vcu == 0) ((unsigned*)(A.ws + WS_CTL) + CW_CNT + 64 * layer)[tid] = (unsigned)tot; }
    __syncthreads();
    const int* tok_e = (const int*)(A.ws + WS_ROUTE + RT_TOKE); int* tok_rank = (int*)(A.ws + WS_ROUTE + RT_RANK); const float* tok_gate = (const float*)(A.ws + WS_ROUTE + RT_TOKG);
    int* tok_list = (int*)(A.ws + WS_ROUTE + RT_LIST); float* sgate = (float*)(A.ws + WS_ROUTE + RT_GATE);
    if (tid < 64) {
        const int k = tid & 1, u = (tid >> 1) & 1, w = (tid >> 2) & 7, it = tid >> 5;
        const int tk = (F.vcu * 8 + w) * 2 + u + F.G * 16 * it;
        if (tk < T) { const int e = tok_e[2 * tk + k], r = F.lctl[112 + e] + tok_rank[2 * tk + k];
            tok_rank[2 * tk + k] = r; tok_list[e * 8192 + r] = tk; sgate[e * 8192 + r] = tok_gate[2 * tk + k]; } }
}

__device__ __forceinline__ void moe_table(const Args& A, Frame& F, int layer) {
    __syncthreads();
    if (F.wave == 0 && lane_id() == 0) {
        const unsigned* cnt = (const unsigned*)(A.ws + WS_CTL) + CW_CNT + 64 * layer;
        int ps = 0, ub = 0;
        for (int e = 0; e < 16; ++e) { const int c = (int)__hip_atomic_load(cnt + e, RLX_AGENT), mt = (c + 255) >> 8;
            F.lctl[16 + e] = c; F.lctl[32 + e] = ps; F.lctl[48 + e] = ub; ps += mt * 256; ub += mt * 8; }
        F.lctl[48 + 16] = ub;
    }
    __syncthreads();
}
__device__ __forceinline__ void phase_moe_gu(const Args& A, Frame& F, int layer) {
    moe_table(A, F, layer);
    MoeSched S{F.lctl + 16, F.G, F.vcu, DM / 2, (const char*)(A.ws + WS_WGU) + (size_t)layer * NE * DM * DM, (size_t)DM * DM, (const int*)(A.ws + WS_ROUTE + RT_LIST), 1};
    EpiGU E{(unsigned char*)(A.ws + WS_H)};
    pg8::gemm_phase<EpiGU, MoeSched, true, true>(F.lds, (const bf16_t*)(A.ws + WS_X1B), DM / 2, S, E, F.wave);
}
__device__ __forceinline__ void phase_moe_down(const Args& A, Frame& F, int layer) {
    moe_table(A, F, layer);
    MoeSched S{F.lctl + 16, F.G, F.vcu, DFF / 2, (const char*)(A.ws + WS_WD) + (size_t)layer * NE * DM * DFF, (size_t)DM * DFF, nullptr, 0};
    EpiDown E{(bf16_t*)(A.ws + WS_YS), (const float*)(A.ws + WS_ROUTE + RT_GATE)};
    pg8::gemm_phase<EpiDown, MoeSched, false, true>(F.lds, (const bf16_t*)(A.ws + WS_H), DFF / 2, S, E, F.wave);
}

__device__ __forceinline__ void phase_final_ln(const Args& A, Frame& F, int layer) {
    moe_table(A, F, layer);
    const int lane = lane_id();
    const bf16_t* X1 = (const bf16_t*)(A.ws + WS_Y1); const bf16_t* YS = (const bf16_t*)(A.ws + WS_YS);
    const int* tok_e = (const int*)(A.ws + WS_ROUTE + RT_TOKE); const int* tok_rank = (const int*)(A.ws + WS_ROUTE + RT_RANK);
    const float* g = A.lfg + layer * DM; const float* bb = A.lfb + layer * DM;
    float* XO = layer == DEPTH - 1 ? A.out : (float*)(A.ws + WS_XF2); bf16_t* XB = (bf16_t*)(A.ws + WS_XB);
    constexpr int TPW = 4;
    for (int tk0 = (F.vcu * 8 + F.wave) * TPW; tk0 < T; tk0 += F.G * 8 * TPW) {
        f32x4 v[TPW][8]; float mean[TPW], rstd[TPW]; size_t s1[TPW], s2[TPW];
#pragma unroll
        for (int u = 0; u < TPW; ++u) { const int tk = tk0 + u; const int e1 = tok_e[2 * tk], e2 = tok_e[2 * tk + 1];
            s1[u] = (size_t)(F.lctl[32 + e1] + tok_rank[2 * tk]) * DM; s2[u] = (size_t)(F.lctl[32 + e2] + tok_rank[2 * tk + 1]) * DM; }
#pragma unroll
        for (int u = 0; u < TPW; ++u) {
#pragma unroll
            for (int j = 0; j < 8; ++j) { const int k = 256 * j + 4 * lane; const u32x2 xw = *(const u32x2*)(X1 + (size_t)(tk0 + u) * DM + k); const float x[4] = {bflo(xw.x), bfhi(xw.x), bflo(xw.y), bfhi(xw.y)};
                const u32x2 ya = *(const u32x2*)(YS + s1[u] + k), yb = *(const u32x2*)(YS + s2[u] + k);
                v[u][j][0] = x[0] * ALPHA + (bflo(ya.x) + bflo(yb.x)); v[u][j][1] = x[1] * ALPHA + (bfhi(ya.x) + bfhi(yb.x));
                v[u][j][2] = x[2] * ALPHA + (bflo(ya.y) + bflo(yb.y)); v[u][j][3] = x[3] * ALPHA + (bfhi(ya.y) + bfhi(yb.y)); } }
#pragma unroll
        for (int u = 0; u < TPW; ++u) { float s = 0.f;
#pragma unroll
            for (int j = 0; j < 8; ++j) s += (v[u][j][0] + v[u][j][1]) + (v[u][j][2] + v[u][j][3]);
            mean[u] = s; }
#pragma unroll
        for (int u = 0; u < TPW; ++u) mean[u] = allsum(mean[u]);
#pragma unroll
        for (int u = 0; u < TPW; ++u) { mean[u] *= (1.f / DM); float q2 = 0.f;
#pragma unroll
            for (int j = 0; j < 8; ++j) { v[u][j] = v[u][j] - mean[u]; q2 += (v[u][j][0] * v[u][j][0] + v[u][j][1] * v[u][j][1]) + (v[u][j][2] * v[u][j][2] + v[u][j][3] * v[u][j][3]); }
            rstd[u] = q2; }
#pragma unroll
        for (int u = 0; u < TPW; ++u) rstd[u] = allsum(rstd[u]);
#pragma unroll
        for (int u = 0; u < TPW; ++u) rstd[u] = rsqrtf(rstd[u] * (1.f / DM) + LN_EPS);
#pragma unroll
        for (int j = 0; j < 8; ++j) { const int k = 256 * j + 4 * lane; const f32x4 gg = *(const f32x4*)(g + k), b4 = *(const f32x4*)(bb + k);
#pragma unroll
            for (int u = 0; u < TPW; ++u) { const f32x4 o = v[u][j] * rstd[u] * gg + b4; *(f32x4*)(XO + (size_t)(tk0 + u) * DM + k) = o;
                if (layer != DEPTH - 1) { u32x2 w; w.x = cvtpk(o[0], o[1]); w.y = cvtpk(o[2], o[3]); *(u32x2*)(XB + (size_t)(tk0 + u) * DM + k) = w;
                    *(unsigned*)(A.ws + WS_XQ + (size_t)(tk0 + u) * DM + k) = pk4_fp8(o[0], o[1], o[2], o[3]); } } }
    }
}

constexpr int N_PHASES = 1 + 7 * DEPTH;
__global__ void __launch_bounds__(512, 2) fwd(Args A_karg) {
    extern __shared__ __attribute__((aligned(16))) unsigned char lds_raw[];
    Frame F; F.lds = (LAS unsigned char*)lds_raw; F.lctl = (LAS int*)(F.lds + LDS_CTL_OFF);
    const int wave0 = __builtin_amdgcn_readfirstlane((int)threadIdx.x >> 6); F.wave = wave0;
    F.G = gridDim.x; { const int bx = blockIdx.x; F.vcu = (F.G % 8 == 0) ? (bx % 8) * (F.G / 8) + bx / 8 : bx; }
    const int vcu0 = F.vcu;
    const int lo = A_karg.ph_lo, hi = A_karg.ph_hi;
#ifndef USE_CG_SYNC
#define USE_CG_SYNC 0
#endif
    const bool leader = (wave0 == 0 && lane_id() == 0);
    if (leader) { F.lctl[8] = 0; F.lctl[9] = 0; }
    __syncthreads();
    XcdBarrier xbar; xbar.bar = nullptr; xbar.x = 0; xbar.st = nullptr;
    if (!USE_CG_SYNC && hi - lo > 1) xbar = xcd_barrier_post((unsigned*)(A_karg.ws + WS_CTL) + CW_BAR, (volatile LAS unsigned*)(F.lctl + 8), leader);
    typedef const __attribute__((address_space(4))) Args* kargp_t;
    int ph = lo, rep = 0;
    while (ph < hi) {
        kargp_t kp = (kargp_t)__builtin_amdgcn_kernarg_segment_ptr(); asm volatile("" : "+s"(kp));
        Args A; A.x = kp->x; A.pos = kp->pos; A.w_in = kp->w_in; A.w_out = kp->w_out; A.dlam = kp->dlam; A.dng = kp->dng; A.lmg = kp->lmg; A.lmb = kp->lmb; A.rw = kp->rw; A.rb = kp->rb;
        A.wg = kp->wg; A.wu = kp->wu; A.wd = kp->wd; A.lfg = kp->lfg; A.lfb = kp->lfb; A.out = kp->out; A.ws = kp->ws; A.ph_lo = lo; A.ph_hi = hi;
        { int w_ = wave0, c_ = vcu0, g_ = (int)gridDim.x; asm volatile("" : "+s"(w_), "+s"(c_), "+s"(g_)); F.wave = w_; F.vcu = c_; F.G = g_; }
#ifdef PHASE_ONLY
        { const int layer = ph & 1;
          if (PHASE_ONLY == 0) phase_prologue(A, F);
          if (PHASE_ONLY == 1) phase_proj(A, F, layer);
          if (PHASE_ONLY == 2) phase_mixers(A, F, layer, 0);
          if (PHASE_ONLY == 3) phase_outproj(A, F, layer);
          if (PHASE_ONLY == 4) phase_ln1_router(A, F, layer);
          if (PHASE_ONLY == 5) phase_moe_gu(A, F, layer);
          if (PHASE_ONLY == 6) phase_moe_down(A, F, layer);
          if (PHASE_ONLY == 7) phase_final_ln(A, F, layer);
          ++ph; continue; }
#endif
#ifndef PROBE_REP
#define PROBE_REP 0
#endif
        const int kind = ph == 0 ? 0 : 1 + (ph - 1) % 7;
        if (ph == 0) phase_prologue(A, F);
        else {
            const int layer = (ph - 1) / 7, k = (ph - 1) % 7;
            if (k == 0) phase_proj(A, F, layer);
            else if (k == 1) phase_mixers(A, F, layer, rep);
            else if (k == 2) phase_outproj(A, F, layer);
            else if (k == 3) phase_ln1_router(A, F, layer);
            else if (k == 4) phase_moe_gu(A, F, layer);
            else if (k == 5) phase_moe_down(A, F, layer);
            else phase_final_ln(A, F, layer);
        }
        if (ph > 0 && (ph - 1) % 7 == 3 && rep == 0) {
            if (USE_CG_SYNC) cg::this_grid().sync(); else xcd_barrier(xbar, wave0 == 0 && lane_id() == 0);
            route_finish(A, F, (ph - 1) / 7);
        }
        {
            const int k7 = ph == 0 ? -1 : (ph - 1) % 7, lay = ph == 0 ? 0 : (ph - 1) / 7;
            int must = 0; bool opp = false;
            if (k7 == 0) { opp = true; }
            else if (k7 == 1) { must = lay == 0 ? FILL_E1 : FILL_E5; opp = true; }
            else if (k7 == 3) { must = lay == 0 ? FILL_E2 : FILL_E6; }
            else if (k7 == 4) { must = lay == 0 ? FILL_E3 : FILL_E7; opp = true; }
            else if (k7 == 5) { opp = true; }
            else if (k7 == 6) { must = lay == 0 ? FILL_E4 : FILL_E7; }
            if (ph > 0 && rep == 0 && (must > 0 || opp)) fill_run(A, F, must, opp, ph);
        }
        if (rep == 0 && ((PROBE_REP >> kind) & 1)) rep = 1; else { rep = 0; ++ph; }
#ifndef PROBE_SYNC
#define PROBE_SYNC 1
#endif
        if (ph < hi) { for (int k_ = 0; k_ < PROBE_SYNC; ++k_) { if (USE_CG_SYNC) cg::this_grid().sync(); else xcd_barrier(xbar, wave0 == 0 && lane_id() == 0); } }
    }
}

extern "C" void kernel_launch(void* const* d_in, const int* in_sizes, int n_in, void* d_out, int out_size, void* d_ws, size_t ws_size, hipStream_t stream) {
    static int grid = 0;
    if (grid == 0) {
        if (n_in != 15 || ws_size < WS_END) { fprintf(stderr, "kernel_launch: unexpected inputs (n_in %d, ws %zu)\n", n_in, ws_size); grid = -1; return; }
        int dev = 0, cus = 0, per_cu = 0;
        hipGetDevice(&dev); hipDeviceGetAttribute(&cus, hipDeviceAttributeMultiprocessorCount, dev);
        hipFuncSetAttribute((const void*)fwd, hipFuncAttributeMaxDynamicSharedMemorySize, LDS_BYTES);
        hipOccupancyMaxActiveBlocksPerMultiprocessor(&per_cu, (const void*)fwd, 512, LDS_BYTES);
        if (per_cu < 1) { fprintf(stderr, "kernel_launch: occupancy query says %d blocks per CU\n", per_cu); per_cu = 1; }
        (void)hipGetLastError();
        grid = cus;
    }
    if (grid < 0) return;
    hipMemsetAsync((char*)d_ws + WS_CTL, 0, CTL_BYTES, stream);
    Args a{};
    a.x = (const float*)d_in[0]; a.pos = (const int*)d_in[1]; a.w_in = (const float*)d_in[2]; a.w_out = (const float*)d_in[3]; a.dlam = (const float*)d_in[4]; a.dng = (const float*)d_in[5];
    a.lmg = (const float*)d_in[6]; a.lmb = (const float*)d_in[7]; a.rw = (const float*)d_in[8]; a.rb = (const float*)d_in[9]; a.wg = (const float*)d_in[10]; a.wu = (const float*)d_in[11];
    a.wd = (const float*)d_in[12]; a.lfg = (const float*)d_in[13]; a.lfb = (const float*)d_in[14]; a.out = (float*)d_out; a.ws = (unsigned char*)d_ws;
#if MK_N_LAUNCHES == 1
    a.ph_lo = 0; a.ph_hi = N_PHASES;
    void* args[] = {&a};
    hipError_t e = hipLaunchCooperativeKernel((const void*)fwd, dim3(grid), dim3(512), args, LDS_BYTES, stream);
    if (e != hipSuccess) fprintf(stderr, "cooperative launch failed: %s (grid %d)\n", hipGetErrorString(e), grid);
#else
    for (int ph = 0; ph < N_PHASES; ++ph) { a.ph_lo = ph; a.ph_hi = ph + 1; hipLaunchKernelGGL(fwd, dim3(grid), dim3(512), LDS_BYTES, stream, a); }
#endif
}
```

```cpp
#include <hip/hip_runtime.h>
#include <hip/hip_cooperative_groups.h>
#include <cstdio>
#include <cstdint>
namespace cg = cooperative_groups;

#ifndef MK_N_LAUNCHES
#define MK_N_LAUNCHES 1
#endif

#define LAS __attribute__((address_space(3)))
typedef unsigned short bf16_t;
typedef short bf16x8 __attribute__((ext_vector_type(8)));
typedef short s16x4 __attribute__((ext_vector_type(4)));
typedef float f32x2 __attribute__((ext_vector_type(2)));
typedef float f32x4 __attribute__((ext_vector_type(4)));
typedef float f32x16 __attribute__((ext_vector_type(16)));
typedef unsigned u32x2 __attribute__((ext_vector_type(2)));
typedef unsigned u32x4 __attribute__((ext_vector_type(4)));
typedef __bf16 bf16x2_t __attribute__((ext_vector_type(2)));
typedef int v8i32_t __attribute__((ext_vector_type(8)));

constexpr int NB = 2, SEQ = 4096, T = NB * SEQ, DM = 2048, DEPTH = 2;
constexpr int PP = 6480;
constexpr int NPROJ = 6656;
constexpr int C_AQ = 0, C_AK = 512, C_AV = 640, C_IQ = 768, C_IK = 1792, C_IW = 1856, C_BQ = 1872, C_BK = 2384, C_BV = 2896,
              C_CQ = 3408, C_CK = 3920, C_CV = 4432, C_DQ = 4944, C_DK = 5456, C_DV = 5968;
constexpr int NE = 16, DFF = 1024, HROWS = 20480;
constexpr float LN_EPS = 1e-5f;
constexpr float ALPHA = 1.41421356237309515f;
constexpr float LOG2E = 1.4426950408889634f;
constexpr float NEG_INF = -__builtin_huge_valf();

constexpr size_t MiB = 1u << 20;
constexpr size_t WS_CTL = 0, CTL_BYTES = 1 * MiB;
constexpr size_t WS_WIN = 1 * MiB;
constexpr size_t WS_WOUT = 53 * MiB;
constexpr size_t WS_WGU = 69 * MiB;
constexpr size_t WS_WD = 325 * MiB;
constexpr size_t WS_XB = 453 * MiB;
constexpr size_t WS_PROJ = 485 * MiB;
constexpr size_t WS_MIX = 587 * MiB;
constexpr size_t WS_Y1 = 619 * MiB;
constexpr size_t WS_XF2 = 683 * MiB;
constexpr size_t WS_X1B = 747 * MiB;
constexpr size_t WS_XQ = 763 * MiB;
constexpr size_t WS_H = 780 * MiB;
constexpr size_t WS_YS = 820 * MiB;
constexpr size_t WS_R128 = 900 * MiB;
constexpr size_t WS_R64 = 904 * MiB;
constexpr size_t WS_ROUTE = 906 * MiB;
constexpr size_t WS_BM = 910 * MiB;
constexpr size_t WS_END = 914 * MiB;
constexpr size_t RT_TOKE = 0, RT_RANK = 65536, RT_LIST = 131072, RT_GATE = 131072 + 524288;
constexpr size_t RT_TOKG = 2 * MiB, RT_BLK = 2 * MiB + 65536;
constexpr int CW_QUEUE = 64;
constexpr int CW_CNT = 1024;
constexpr int CW_BAR = 4096;
#define XB_TMO      128
#define XB_SPIN_CAP (1u << 22)
constexpr int CW_DSAC = 8192;
constexpr size_t KM_OFF = 262144;

constexpr int LDS_CTL_OFF = 155648;
constexpr int LDS_BYTES = 156672;
constexpr int VP = 320;
constexpr int VT_BYTES = 32 * VP;

__constant__ short GRP[104][4] = {
{1,0,64,0}, {1,32,64,32}, {1,128,64,0}, {1,160,64,32}, {1,256,64,0}, {1,288,64,32}, {1,384,64,0}, {1,416,64,32}, {1,512,64,0}, {1,544,64,32}, {0,640,32,0}, {0,704,32,0}, {2,768,32,0}, {2,832,32,0}, {2,896,32,0}, {2,960,32,0}, {2,1024,32,0}, {2,1088,32,0}, {2,1152,32,0}, {2,1216,32,0}, {2,1280,32,0}, {2,1344,32,0}, {2,1408,32,0}, {2,1472,32,0}, {2,1536,32,0}, {2,1600,32,0}, {2,1664,32,0}, {2,1728,32,0}, {2,1792,32,0}, {3,1856,0,0}, {1,3408,64,0}, {1,3440,64,32}, {1,3536,64,0}, {1,3568,64,32}, {1,3664,64,0}, {1,3696,64,32}, {1,3792,64,0}, {1,3824,64,32}, {1,3920,64,0}, {1,3952,64,32}, {1,4048,64,0}, {1,4080,64,32}, {1,4176,64,0}, {1,4208,64,32}, {1,4304,64,0}, {1,4336,64,32}, {0,4432,32,0}, {0,4496,32,0}, {0,4560,32,0}, {0,4624,32,0}, {0,4688,32,0}, {0,4752,32,0}, {0,4816,32,0}, {0,4880,32,0}, {1,4944,64,0}, {1,4976,64,32}, {1,5072,64,0}, {1,5104,64,32}, {1,5200,64,0}, {1,5232,64,32}, {1,5328,64,0}, {1,5360,64,32}, {1,5456,64,0}, {1,5488,64,32}, {1,5584,64,0}, {1,5616,64,32}, {1,5712,64,0}, {1,5744,64,32}, {1,5840,64,0}, {1,5872,64,32}, {0,5968,32,0}, {0,6032,32,0}, {0,6096,32,0}, {0,6160,32,0}, {0,6224,32,0}, {0,6288,32,0}, {0,6352,32,0}, {0,6416,32,0}, {4,0,0,0}, {4,0,0,0}, {2,1872,32,0}, {2,1936,32,0}, {2,2000,32,0}, {2,2064,32,0}, {2,2128,32,0}, {2,2192,32,0}, {2,2256,32,0}, {2,2320,32,0}, {2,2384,32,0}, {2,2448,32,0}, {2,2512,32,0}, {2,2576,32,0}, {2,2640,32,0}, {2,2704,32,0}, {2,2768,32,0}, {2,2832,32,0}, {0,2896,32,0}, {0,2960,32,0}, {0,3024,32,0}, {0,3088,32,0}, {0,3152,32,0}, {0,3216,32,0}, {0,3280,32,0}, {0,3344,32,0}};

__device__ __forceinline__ unsigned cvtpk(float lo, float hi) { f32x2 v = {lo, hi}; bf16x2_t b = __builtin_convertvector(v, bf16x2_t); return __builtin_bit_cast(unsigned, b); }
__device__ __forceinline__ unsigned pk4_fp8(float a, float b, float c, float d) { unsigned w = 0u; w = __builtin_amdgcn_cvt_pk_fp8_f32(a, b, w, false); w = __builtin_amdgcn_cvt_pk_fp8_f32(c, d, w, true); return w; }
__device__ __forceinline__ float bf2f(unsigned short b) { return __builtin_bit_cast(float, (unsigned)b << 16); }
__device__ __forceinline__ float bflo(unsigned w) { return __builtin_bit_cast(float, w << 16); }
__device__ __forceinline__ float bfhi(unsigned w) { return __builtin_bit_cast(float, w & 0xffff0000u); }
__device__ __forceinline__ int crow(int r, int hi) { return (r & 3) + 8 * (r >> 2) + 4 * hi; }
#define RLX_AGENT __ATOMIC_RELAXED, __HIP_MEMORY_SCOPE_AGENT
__device__ __forceinline__ int lane_id() { int l; asm volatile("v_mbcnt_lo_u32_b32 %0, -1, 0\n\tv_mbcnt_hi_u32_b32 %0, -1, %0" : "=v"(l)); return l; }

struct swap2 { float a, b; };
__device__ __forceinline__ swap2 pl32swap(float x, float y) { const auto r = __builtin_amdgcn_permlane32_swap(__float_as_uint(x), __float_as_uint(y), false, false); const unsigned u0 = r[0], u1 = r[1]; swap2 o; o.a = __uint_as_float(u0); o.b = __uint_as_float(u1); return o; }
template <int M> __device__ __forceinline__ float shx_f(float v) { return __int_as_float(__builtin_amdgcn_ds_swizzle(__float_as_int(v), (M << 10) | 0x1f)); }
__device__ __forceinline__ float xsum32(float v) { const swap2 r = pl32swap(v, v); return r.a + r.b; }
__device__ __forceinline__ float xmax32(float v) { const swap2 r = pl32swap(v, v); return fmaxf(r.a, r.b); }
__device__ __forceinline__ int wave_isum(int v) {
    v += __builtin_amdgcn_update_dpp(0, v, 0xB1, 0xF, 0xF, true);
    v += __builtin_amdgcn_update_dpp(0, v, 0x4E, 0xF, 0xF, true);
    v += __builtin_amdgcn_update_dpp(0, v, 0x141, 0xF, 0xF, true);
    v += __builtin_amdgcn_update_dpp(0, v, 0x140, 0xF, 0xF, true);
    return __builtin_amdgcn_readlane(v, 0) + __builtin_amdgcn_readlane(v, 16) + __builtin_amdgcn_readlane(v, 32) + __builtin_amdgcn_readlane(v, 48);
}
__device__ __forceinline__ float allsum(float v) { v += shx_f<1>(v); v += shx_f<2>(v); v += shx_f<4>(v); v += shx_f<8>(v); v += shx_f<16>(v); return xsum32(v); }
__device__ __forceinline__ float wave_sum(float v) { return allsum(v); }
__device__ __forceinline__ swap2 pl16swap(float x, float y) { const auto r = __builtin_amdgcn_permlane16_swap(__float_as_uint(x), __float_as_uint(y), false, false); const unsigned u0 = r[0], u1 = r[1]; swap2 o; o.a = __uint_as_float(u0); o.b = __uint_as_float(u1); return o; }

namespace pg8 {
constexpr int BM = 256, BK = 64, HALF = 128, HTB = HALF * BK * 2, STAGE_BYTES = 8 * HTB, NXCD = 8, WGM = 8;
__device__ __forceinline__ int lds_byte(int r, int c) { const int st = (r >> 4) * 2 + (c >> 5), rr = r & 15, cc = c & 31, ob = rr * 64 + cc * 2; return st * 1024 + (ob ^ (((ob >> 9) & 1) << 5)); }
__device__ __forceinline__ void stage_rc(int b, int& R, int& C) { const int st = b / 1024, sb = b % 1024, swz = sb ^ (((sb >> 9) & 1) << 5); R = (st >> 1) * 16 + swz / 64; C = (st & 1) * 32 + (swz % 64) / 2; }
__device__ __forceinline__ int perm32(int rho) { const int n = rho >> 4, i = rho & 15; return 8 * (i >> 2) + 4 * n + (i & 3); }

struct Unit { int pm, pn, e; const char* B; const int* list; int row0, cnt, orow0; };
__device__ __forceinline__ int a_row(const Unit& u, int r) {
    if (u.list) { int rr = u.row0 + r; rr = rr < u.cnt ? rr : u.cnt - 1; return u.list[rr]; }
    return u.row0 + r;
}

struct DenseOrder {
    int nM, nN, nwg, G, c, K; const char* Bt;
    __device__ void init(int M, int N, int K_, const void* Bt_, int G_, int c_) { nM = M / BM; nN = N / BM; nwg = nM * nN; G = G_; c = c_; K = K_; Bt = (const char*)Bt_; }
    __device__ bool next(int i, Unit& u) const {
        const long L = (long)i * G + c; if (L >= nwg) return false;
        int wgid = (int)L; { const int q = nwg / NXCD, r = nwg % NXCD, xcd = wgid % NXCD, off = wgid / NXCD; wgid = (xcd < r ? xcd * (q + 1) : r * (q + 1) + (xcd - r) * q) + off; }
        const int nig = WGM * nN, gid = wgid / nig, fm = gid * WGM, gsz = (nM - fm) < WGM ? (nM - fm) : WGM;
        u.pm = fm + ((wgid % nig) % gsz); u.pn = (wgid % nig) / gsz; u.e = 0;
        u.B = Bt + (size_t)u.pn * BM * K * 2; u.list = nullptr; u.row0 = u.pm * BM; u.cnt = 0; u.orow0 = u.pm * BM; return true;
    }
};

template <class Epi, class Sched, bool GATHER, bool FP8 = false>
__device__ __forceinline__ void gemm_phase(LAS unsigned char* lds, const bf16_t* Aptr, const int K, const Sched& S, const Epi& E, const int wv) {
    int tid_ = wv * 64 + lane_id(); asm volatile("" : "+v"(tid_));
    const int tid = tid_, wid = __builtin_amdgcn_readfirstlane(tid >> 6), lane = tid & 63, wr = wid >> 2, wc = wid & 3, fr = lane & 15, fq = lane >> 4;
    const int nt = K / BK;
    unsigned voffB[2], voffA[2];
#pragma unroll
    for (int i = 0; i < 2; ++i) { int sR, sC; stage_rc(tid * 16 + i * 8192, sR, sC); const int Rb = Epi::PERM ? ((sR & ~31) + perm32(sR & 31)) : sR; voffB[i] = (unsigned)(Rb * K + sC) * 2u; voffA[i] = (unsigned)(sR * K + sC) * 2u; }
    const size_t kstep = (size_t)(BK * 2);
    const size_t hstep = (size_t)HALF * K * 2;
    const unsigned ldsw = (unsigned)wid * 1024u;
    const int aoff = FP8 ? lds_byte(wr * 64 + fr, fq * 16) : lds_byte(wr * 64 + fr, fq * 8), boff = FP8 ? lds_byte(wc * 32 + fr, fq * 16) : lds_byte(wc * 32 + fr, fq * 8);
    const int aoff2 = FP8 ? lds_byte(wr * 64 + fr, fq * 16 + 8) : aoff + 1024, boff2 = FP8 ? lds_byte(wc * 32 + fr, fq * 16 + 8) : boff + 1024;
    const char* gA = (const char*)Aptr;
#define PG8_SA(b, h) (((b) * 2 + (h)) * HTB)
#define PG8_SB(b, h) ((4 + (b) * 2 + (h)) * HTB)
#define PG8_STAGE2(bufoff, gbase, o0, o1) do { \
        __builtin_amdgcn_global_load_lds((const unsigned*)((const char*)(gbase) + (o0)), (LAS unsigned*)(lds + (bufoff) + ldsw), 16, 0, 0); \
        __builtin_amdgcn_global_load_lds((const unsigned*)((const char*)(gbase) + (o1)), (LAS unsigned*)(lds + (bufoff) + ldsw + 8192), 16, 0, 0); } while (0)
#define PG8_STAGEB(bufoff, gbase) PG8_STAGE2(bufoff, gbase, voffB[0], voffB[1])
#define PG8_STAGEA(bufoff, gbase, h, useN) do { if constexpr (GATHER) { const u32x4 vo_ = *(const LAS u32x4*)(lds + STAGE_BYTES + ((((useN) ? ui + 1 : ui) & 1) ? 8192 : 0) + tid * 16); \
            if ((h) == 0) { PG8_STAGE2(bufoff, gbase, vo_.x, vo_.y); } else { PG8_STAGE2(bufoff, gbase, vo_.z, vo_.w); } } \
        else { const char* gb_ = (const char*)(gbase) + (size_t)((useN) ? nrow0 : crow0) * K * 2 + (h) * hstep; PG8_STAGE2(bufoff, gb_, voffA[0], voffA[1]); } } while (0)
#define PG8_LD16(p_) (*(const LAS u32x4*)(p_))
#define PG8_MK8(lo_, hi_) (v8i32_t){(int)lo_.x, (int)lo_.y, (int)lo_.z, (int)lo_.w, (int)hi_.x, (int)hi_.y, (int)hi_.z, (int)hi_.w}
#define PG8_LDA(dst, b, h) do { _Pragma("unroll") for (int m = 0; m < 4; ++m) { \
        if constexpr (FP8) { const u32x4 lo_ = PG8_LD16(lds + PG8_SA(b, h) + aoff + m * 2048), hi_ = PG8_LD16(lds + PG8_SA(b, h) + aoff2 + m * 2048); dst##8[m] = PG8_MK8(lo_, hi_); } \
        else { dst[m][0] = *(const LAS bf16x8*)(lds + PG8_SA(b, h) + aoff + m * 2048); dst[m][1] = *(const LAS bf16x8*)(lds + PG8_SA(b, h) + aoff2 + m * 2048); } } } while (0)
#define PG8_LDB(dst, b, h) do { _Pragma("unroll") for (int n = 0; n < 2; ++n) { \
        if constexpr (FP8) { const u32x4 lo_ = PG8_LD16(lds + PG8_SB(b, h) + boff + n * 2048), hi_ = PG8_LD16(lds + PG8_SB(b, h) + boff2 + n * 2048); dst##8[n] = PG8_MK8(lo_, hi_); } \
        else { dst[n][0] = *(const LAS bf16x8*)(lds + PG8_SB(b, h) + boff + n * 2048); dst[n][1] = *(const LAS bf16x8*)(lds + PG8_SB(b, h) + boff2 + n * 2048); } } } while (0)
#define PG8_MMA(ai, bj, At, Bt) do { __builtin_amdgcn_s_setprio(1); _Pragma("unroll") for (int m = 0; m < 4; ++m) _Pragma("unroll") for (int n = 0; n < 2; ++n) { \
        if constexpr (FP8) { asm("v_mfma_scale_f32_16x16x128_f8f6f4 %0, %1, %2, %0, %3, %4 op_sel_hi:[0,0,0]" : "+v"(acc[ai][bj][m][n]) : "v"(Bt##8[n]), "v"(At##8[m]), "v"(sc_w_), "v"(sc_a_)); } \
        else { _Pragma("unroll") for (int k = 0; k < 2; ++k) acc[ai][bj][m][n] = __builtin_amdgcn_mfma_f32_16x16x32_bf16(Bt[n][k], At[m][k], acc[ai][bj][m][n], 0, 0, 0); } } \
        __builtin_amdgcn_s_setprio(0); } while (0)
#define PG8_WAIT_V(n) asm volatile("s_waitcnt vmcnt(" #n ")" ::: "memory")
#define PG8_WAIT_L(n) asm volatile("s_waitcnt lgkmcnt(" #n ")" ::: "memory")
#define PG8_BAR __builtin_amdgcn_s_barrier()
#define PG8_SCHED __builtin_amdgcn_sched_barrier(0)
#define PG8_AOFFS(u, par) do { unsigned v_[2][2]; _Pragma("unroll") for (int i_ = 0; i_ < 2; ++i_) { int sR_, sC_; stage_rc(tid * 16 + i_ * 8192, sR_, sC_); _Pragma("unroll") for (int h_ = 0; h_ < 2; ++h_) v_[h_][i_] = (unsigned)(a_row(u, h_ * HALF + sR_) * K + sC_) * 2u; } \
        *(LAS u32x4*)(lds + STAGE_BYTES + (((par) & 1) ? 8192 : 0) + tid * 16) = (u32x4){v_[0][0], v_[0][1], v_[1][0], v_[1][1]}; } while (0)
    Unit cur, nxt; int ui = 0;
    if (!S.next(0, cur)) return;
    f32x4 acc[2][2][4][2];
#pragma unroll
    for (int a = 0; a < 2; ++a)
#pragma unroll
        for (int b = 0; b < 2; ++b)
#pragma unroll
            for (int m = 0; m < 4; ++m)
#pragma unroll
                for (int n = 0; n < 2; ++n) acc[a][b][m][n] = (f32x4){0.f, 0.f, 0.f, 0.f};
    const int sc_w_ = E.scale_w, sc_a_ = E.scale_a;
    bf16x8 At[4][2], B0[2][2], B1[2][2]; v8i32_t At8[4], B08[2], B18[2];
    int crow0 = cur.row0, nrow0 = cur.row0;
    if constexpr (GATHER) { PG8_AOFFS(cur, 0); }
    const char* cB = cur.B;
    PG8_STAGEB(PG8_SB(0, 0), cB); PG8_STAGEB(PG8_SB(0, 1), cB + hstep); PG8_STAGEA(PG8_SA(0, 0), gA, 0, false); PG8_STAGEA(PG8_SA(0, 1), gA, 1, false);
    if (wr == 1) PG8_BAR;
    PG8_WAIT_V(2); PG8_BAR;
    PG8_STAGEB(PG8_SB(1, 0), cB + kstep); PG8_STAGEA(PG8_SA(1, 0), gA + kstep, 0, false); PG8_STAGEB(PG8_SB(1, 1), cB + hstep + kstep);
    PG8_WAIT_V(6); PG8_BAR;
    for (;;) {
        const bool has_next = S.next(ui + 1, nxt);
        if constexpr (GATHER) { if (has_next) { PG8_AOFFS(nxt, ui + 1); } else { PG8_AOFFS(cur, ui + 1); } }
        nrow0 = has_next ? nxt.row0 : crow0;
        const char* nB = has_next ? nxt.B : cB;
#pragma clang loop unroll(disable)
        for (int t = 0; t < nt; t += 2) {
            const bool last = (t == nt - 2);
            const char* a1 = gA + (size_t)(t + 1) * kstep;
            const char* a2 = last ? gA : gA + (size_t)(t + 2) * kstep; const char* b2 = last ? nB : cB + (size_t)(t + 2) * kstep;
            const char* a3 = a2 + kstep; const char* b3 = b2 + kstep;
            PG8_LDB(B0, 0, 0); PG8_LDB(B1, 0, 1); PG8_SCHED; PG8_LDA(At, 0, 0); PG8_STAGEA(PG8_SA(1, 1), a1, 1, false);
            PG8_WAIT_V(8); PG8_WAIT_L(0); PG8_BAR; PG8_MMA(0, 0, At, B0); PG8_MMA(0, 1, At, B1); PG8_BAR; PG8_SCHED;
            PG8_LDA(At, 0, 1); PG8_STAGEB(PG8_SB(0, 0), b2); PG8_STAGEB(PG8_SB(0, 1), b2 + hstep); PG8_STAGEA(PG8_SA(0, 0), a2, 0, last);
            PG8_WAIT_V(8); PG8_WAIT_L(0); PG8_BAR; PG8_MMA(1, 0, At, B0); PG8_MMA(1, 1, At, B1); PG8_BAR; PG8_SCHED;
            PG8_LDB(B0, 1, 0); PG8_LDB(B1, 1, 1); PG8_SCHED; PG8_LDA(At, 1, 0); PG8_STAGEA(PG8_SA(0, 1), a2, 1, last);
            PG8_WAIT_V(8); PG8_WAIT_L(0); PG8_BAR; PG8_MMA(0, 0, At, B0); PG8_MMA(0, 1, At, B1); PG8_BAR; PG8_SCHED;
            PG8_LDA(At, 1, 1); PG8_STAGEB(PG8_SB(1, 0), b3); PG8_STAGEB(PG8_SB(1, 1), b3 + hstep); PG8_STAGEA(PG8_SA(1, 0), a3, 0, last);
            PG8_WAIT_V(8); PG8_WAIT_L(0); PG8_BAR; PG8_MMA(1, 0, At, B0); PG8_MMA(1, 1, At, B1); PG8_BAR; PG8_SCHED;
        }
        if (wr == 0) PG8_BAR;
        { Unit eu = cur; int el = lane;
          eu.pm = __builtin_amdgcn_readfirstlane(eu.pm); eu.pn = __builtin_amdgcn_readfirstlane(eu.pn); eu.e = __builtin_amdgcn_readfirstlane(eu.e);
          eu.cnt = __builtin_amdgcn_readfirstlane(eu.cnt); eu.orow0 = __builtin_amdgcn_readfirstlane(eu.orow0);
          asm volatile("" : "+s"(eu.pm), "+s"(eu.pn), "+s"(eu.e), "+s"(eu.cnt), "+s"(eu.orow0), "+v"(el));
          E(acc, eu, wr, wc, el & 15, el >> 4); }
        if (!has_next) break;
#pragma unroll
        for (int a = 0; a < 2; ++a)
#pragma unroll
            for (int b = 0; b < 2; ++b)
#pragma unroll
                for (int m = 0; m < 4; ++m)
#pragma unroll
                    for (int n = 0; n < 2; ++n) acc[a][b][m][n] = (f32x4){0.f, 0.f, 0.f, 0.f};
        cur = nxt; cB = nB; ++ui; crow0 = nrow0;
        if (wr == 1) PG8_BAR;
    }
    PG8_WAIT_V(0);
    PG8_BAR;
#undef PG8_SA
#undef PG8_SB
#undef PG8_STAGE2
#undef PG8_STAGEB
#undef PG8_STAGEA
#undef PG8_LDA
#undef PG8_LDB
#undef PG8_MMA
#undef PG8_LD16
#undef PG8_MK8
#undef PG8_WAIT_V
#undef PG8_WAIT_L
#undef PG8_BAR
#undef PG8_SCHED
#undef PG8_AOFFS
}
}

typedef f32x4 acc_t[2][2][4][2];
constexpr int SC_W = 0x79797979, SC_X = 0x7f7f7f7f, SC_H = 0x7b7b7b7b;

struct EpiProj {
    static constexpr bool PERM = true; static constexpr int scale_w = SC_W, scale_a = SC_X;
    bf16_t* P; const f32x2* r128; const f32x2* r64; float* kmsum; int pn_off;
    __device__ __forceinline__ void operator()(const acc_t& acc, const pg8::Unit& u, int wr, int wc, int fr, int fq) const {
        const int g = (u.pn + pn_off) * 4 + wc;
        const int mode = GRP[g][0], lo = GRP[g][1], ho = GRP[g][2], fb = GRP[g][3];
        if (mode == 4) return;
        const bool ksum = (lo >= C_CK && lo < C_CV);
        float cs[16];
#pragma unroll
        for (int k = 0; k < 16; ++k) cs[k] = 0.f;
#pragma unroll
        for (int ai = 0; ai < 2; ++ai)
#pragma unroll
            for (int m = 0; m < 4; ++m) {
                const int row = u.orow0 + ai * 128 + wr * 64 + m * 16 + fr;
                f32x4 l0 = acc[ai][0][m][0], l1 = acc[ai][0][m][1], h0 = acc[ai][1][m][0], h1 = acc[ai][1][m][1];
                if (mode == 1 || mode == 2) {
                    const f32x4* tb = (const f32x4*)((mode == 1 ? r128 + (size_t)row * 64 : r64 + (size_t)row * 32) + fb + 8 * fq);
                    const f32x4 t0 = tb[0], t1 = tb[1], t2 = tb[2], t3 = tb[3];
                    f32x4 nl0, nl1, nh0, nh1;
                    nl0[0] = l0[0] * t0[0] - h0[0] * t0[1]; nh0[0] = l0[0] * t0[1] + h0[0] * t0[0];
                    nl0[1] = l0[1] * t0[2] - h0[1] * t0[3]; nh0[1] = l0[1] * t0[3] + h0[1] * t0[2];
                    nl0[2] = l0[2] * t1[0] - h0[2] * t1[1]; nh0[2] = l0[2] * t1[1] + h0[2] * t1[0];
                    nl0[3] = l0[3] * t1[2] - h0[3] * t1[3]; nh0[3] = l0[3] * t1[3] + h0[3] * t1[2];
                    nl1[0] = l1[0] * t2[0] - h1[0] * t2[1]; nh1[0] = l1[0] * t2[1] + h1[0] * t2[0];
                    nl1[1] = l1[1] * t2[2] - h1[1] * t2[3]; nh1[1] = l1[1] * t2[3] + h1[1] * t2[2];
                    nl1[2] = l1[2] * t3[0] - h1[2] * t3[1]; nh1[2] = l1[2] * t3[1] + h1[2] * t3[0];
                    nl1[3] = l1[3] * t3[2] - h1[3] * t3[3]; nh1[3] = l1[3] * t3[3] + h1[3] * t3[2];
                    l0 = nl0; l1 = nl1; h0 = nh0; h1 = nh1;
                }
                if (ksum) {
#pragma unroll
                    for (int k = 0; k < 4; ++k) { cs[k] += l0[k]; cs[4 + k] += l1[k]; cs[8 + k] += h0[k]; cs[12 + k] += h1[k]; }
                }
                bf16_t* rp = P + (size_t)row * PP + lo + 8 * fq;
                u32x4 w; w.x = cvtpk(l0[0], l0[1]); w.y = cvtpk(l0[2], l0[3]); w.z = cvtpk(l1[0], l1[1]); w.w = cvtpk(l1[2], l1[3]);
                if (mode != 3) { *(u32x4*)rp = w; u32x4 v; v.x = cvtpk(h0[0], h0[1]); v.y = cvtpk(h0[2], h0[3]); v.z = cvtpk(h1[0], h1[1]); v.w = cvtpk(h1[2], h1[3]); *(u32x4*)(rp + ho) = v; }
                else if (fq < 2) *(u32x4*)rp = w;
            }
        if (ksum) {
#pragma unroll
            for (int k = 0; k < 16; ++k) { float v = cs[k]; v += shx_f<1>(v); v += shx_f<2>(v); v += shx_f<4>(v); v += shx_f<8>(v); cs[k] = v; }
            if (fr == 0) { float* dst = kmsum + (size_t)u.pm * 512 + (lo - C_CK) + 8 * fq;
#pragma unroll
                for (int k = 0; k < 8; ++k) { atomicAdd(dst + k, cs[k]); atomicAdd(dst + 64 + k, cs[8 + k]); } }
        }
    }
};

struct EpiOut {
    static constexpr bool PERM = true; static constexpr int scale_w = 0, scale_a = 0;
    const bf16_t* X; bf16_t* Y;
    __device__ __forceinline__ void operator()(const acc_t& acc, const pg8::Unit& u, int wr, int wc, int fr, int fq) const {
#pragma unroll
        for (int ai = 0; ai < 2; ++ai)
#pragma unroll
            for (int m = 0; m < 4; ++m) {
                const size_t off = (size_t)(u.orow0 + ai * 128 + wr * 64 + m * 16 + fr) * DM + u.pn * 256 + wc * 32 + 8 * fq;
#pragma unroll
                for (int bj = 0; bj < 2; ++bj) {
                    const u32x4 xw = *(const u32x4*)(X + off + bj * 128);
                    const f32x4 x0 = {bflo(xw.x), bfhi(xw.x), bflo(xw.y), bfhi(xw.y)}, x1 = {bflo(xw.z), bfhi(xw.z), bflo(xw.w), bfhi(xw.w)};
                    const f32x4 a = x0 * ALPHA + acc[ai][bj][m][0], b = x1 * ALPHA + acc[ai][bj][m][1];
                    u32x4 w; w.x = cvtpk(a[0], a[1]); w.y = cvtpk(a[2], a[3]); w.z = cvtpk(b[0], b[1]); w.w = cvtpk(b[2], b[3]);
                    *(u32x4*)(Y + off + bj * 128) = w;
                }
            }
    }
};

struct EpiGU {
    static constexpr bool PERM = true; static constexpr int scale_w = SC_W, scale_a = SC_X;
    unsigned char* H;
    __device__ __forceinline__ void operator()(const acc_t& acc, const pg8::Unit& u, int wr, int wc, int fr, int fq) const {
#pragma unroll
        for (int ai = 0; ai < 2; ++ai)
#pragma unroll
            for (int m = 0; m < 4; ++m) {
                const size_t off = (size_t)(u.orow0 + ai * 128 + wr * 64 + m * 16 + fr) * DFF + u.pn * 128 + wc * 32 + 8 * fq;
                float hv[8];
#pragma unroll
                for (int n = 0; n < 2; ++n)
#pragma unroll
                    for (int j = 0; j < 4; ++j) { const float g = acc[ai][0][m][n][j], up = acc[ai][1][m][n][j]; hv[n * 4 + j] = 16.f * g * up / (1.f + __expf(-g)); }
                u32x2 w; w.x = pk4_fp8(hv[0], hv[1], hv[2], hv[3]); w.y = pk4_fp8(hv[4], hv[5], hv[6], hv[7]);
                *(u32x2*)(H + off) = w;
            }
    }
};

struct EpiDown {
    static constexpr bool PERM = true; static constexpr int scale_w = SC_W, scale_a = SC_H;
    bf16_t* Y; const float* sgate;
    __device__ __forceinline__ void operator()(const acc_t& acc, const pg8::Unit& u, int wr, int wc, int fr, int fq) const {
#pragma unroll
        for (int ai = 0; ai < 2; ++ai)
#pragma unroll
            for (int m = 0; m < 4; ++m) {
                const int r = ai * 128 + wr * 64 + m * 16 + fr, rk = u.pm * 256 + r;
                const float gt = rk < u.cnt ? sgate[u.e * 8192 + rk] : 0.f;
                const size_t off = (size_t)(u.orow0 + r) * DM + u.pn * 256 + wc * 32 + 8 * fq;
#pragma unroll
                for (int bj = 0; bj < 2; ++bj) {
                    const f32x4 a = acc[ai][bj][m][0] * gt, b = acc[ai][bj][m][1] * gt;
                    u32x4 w; w.x = cvtpk(a[0], a[1]); w.y = cvtpk(a[2], a[3]); w.z = cvtpk(b[0], b[1]); w.w = cvtpk(b[2], b[3]);
                    *(u32x4*)(Y + off + bj * 128) = w;
                }
            }
    }
};

struct MoeSched {
    const LAS int* tab; int G, c, K; const char* Bbase; size_t Bstride; const int* lists; int gather;
    __device__ bool next(int i, pg8::Unit& u) const {
#define RFL(x) __builtin_amdgcn_readfirstlane(x)
        const int L = i * G + c; if (L >= RFL(tab[32 + 16])) return false;
        int e = 0;
#pragma unroll
        for (int k = 1; k < 16; ++k) e += (L >= RFL(tab[32 + k])) ? 1 : 0;
        const int r = L - RFL(tab[32 + e]), cnt = RFL(tab[e]), mt = (cnt + 255) >> 8, nt = RFL(r / mt), mtile = r - nt * mt;
        u.pm = mtile; u.pn = nt; u.e = e; u.B = Bbase + (size_t)e * Bstride + (size_t)nt * 256 * K * 2;
        u.cnt = cnt; u.orow0 = RFL(tab[16 + e]) + mtile * 256;
        if (gather) { u.list = lists + e * 8192; u.row0 = mtile * 256; } else { u.list = nullptr; u.row0 = u.orow0; }
        return true;
#undef RFL
    }
};

struct FAState { f32x16 o[4]; float m, l; };
template <int NSTEP> struct KVRegs { u32x4 k[NSTEP]; u32x4 v[8]; };

__device__ __forceinline__ s16x4 vtr(const LAS char* p) { typedef short v4i16_t __attribute__((ext_vector_type(4)));
    return __builtin_bit_cast(s16x4, __builtin_amdgcn_ds_read_tr16_b64_v4i16((LAS v4i16_t*)p)); }

template <int NSTEP, class TF>
__device__ __forceinline__ void fa_load(KVRegs<NSTEP>& R, const bf16_t* P, const TF& tf, int t, int kcol, int vcol, int lane) {
#pragma unroll
    for (int i = 0; i < 8; ++i) { const bf16_t* rp = P + (size_t)tf.row(t, 4 * i + (lane >> 4)) * PP + (lane & 15) * 8; R.v[i] = *(const u32x4*)(rp + vcol);
        if constexpr (NSTEP == 8) R.k[i] = *(const u32x4*)(rp + kcol); }
    if constexpr (NSTEP == 4) {
#pragma unroll
        for (int i = 0; i < 4; ++i) R.k[i] = *(const u32x4*)(P + (size_t)tf.row(t, 8 * i + (lane >> 3)) * PP + kcol + (lane & 7) * 8); }
}

template <int NSTEP, bool QLDS, class TF>
__device__ __forceinline__ void fa_run(FAState& st, const bf16x8 (&q)[QLDS ? 1 : NSTEP], const LAS char* ql, const bf16_t* P, const TF& tf, int t_lo, int t_hi, LAS char* vl, float sc, int kcol, int vcol, int lane) {
    if (t_lo >= t_hi) return;
    constexpr int KP = NSTEP == 8 ? 272 : 144;
    const int hi = lane >> 5;
    const LAS char* vt = vl + (4 * hi + ((lane & 15) >> 2)) * VP + (16 * ((lane >> 4) & 1) + 4 * (lane & 3)) * 2;
    const LAS char* kt = vl + (lane & 31) * KP + hi * 16;
    KVRegs<NSTEP> R;
    fa_load<NSTEP>(R, P, tf, t_lo, kcol, vcol, lane);
    for (int t = t_lo; t < t_hi; ++t) {
        if constexpr (NSTEP == 8) {
#pragma unroll
            for (int i = 0; i < 8; ++i) *(LAS u32x4*)(vl + (4 * i + (lane >> 4)) * KP + (lane & 15) * 16) = R.k[i];
        } else {
#pragma unroll
            for (int i = 0; i < 4; ++i) *(LAS u32x4*)(vl + (8 * i + (lane >> 3)) * KP + (lane & 7) * 16) = R.k[i];
        }
        f32x16 s = {0.f, 0.f, 0.f, 0.f, 0.f, 0.f, 0.f, 0.f, 0.f, 0.f, 0.f, 0.f, 0.f, 0.f, 0.f, 0.f};
#pragma unroll
        for (int i = 0; i < NSTEP; ++i) { bf16x8 qf; if constexpr (QLDS) qf = *(const LAS bf16x8*)(ql + i * 1024 + lane * 16); else qf = q[i];
            const bf16x8 kf = *(const LAS bf16x8*)(kt + i * 32);
            s = __builtin_amdgcn_mfma_f32_32x32x16_bf16(kf, qf, s, 0, 0, 0); }
#pragma unroll
        for (int i = 0; i < 8; ++i) *(LAS u32x4*)(vl + (4 * i + (lane >> 4)) * VP + (lane & 15) * 16) = R.v[i];
        if (t + 1 < t_hi) fa_load<NSTEP>(R, P, tf, t + 1, kcol, vcol, lane);
        float tmax = NEG_INF;
#pragma unroll
        for (int r = 0; r < 16; ++r) { const float v = tf.valid(t, r, hi) ? s[r] * sc : NEG_INF; s[r] = v; tmax = fmaxf(tmax, v); }
        tmax = xmax32(tmax);
        const float mn = fmaxf(st.m, tmax), ms = (mn == NEG_INF) ? 0.f : mn;
        const float alpha = __builtin_amdgcn_exp2f(st.m - ms);
        float ps = 0.f;
#pragma unroll
        for (int r = 0; r < 16; ++r) { const float p = __builtin_amdgcn_exp2f(s[r] - ms); s[r] = p; ps += p; }
        st.l = st.l * alpha + ps; st.m = mn;
        if (!__all(alpha == 1.f)) {
#pragma unroll
            for (int d = 0; d < 4; ++d)
#pragma unroll
                for (int r = 0; r < 16; ++r) st.o[d][r] *= alpha;
        }
        u32x4 p0, p1;
        p0.x = cvtpk(s[0], s[1]); p0.y = cvtpk(s[2], s[3]); p0.z = cvtpk(s[4], s[5]); p0.w = cvtpk(s[6], s[7]);
        p1.x = cvtpk(s[8], s[9]); p1.y = cvtpk(s[10], s[11]); p1.z = cvtpk(s[12], s[13]); p1.w = cvtpk(s[14], s[15]);
        const bf16x8 pb0 = __builtin_bit_cast(bf16x8, p0), pb1 = __builtin_bit_cast(bf16x8, p1);
#pragma unroll
        for (int d = 0; d < 4; ++d) {
            const s16x4 a0 = vtr(vt + d * 64), a1 = vtr(vt + d * 64 + 8 * VP), b0 = vtr(vt + d * 64 + 16 * VP), b1 = vtr(vt + d * 64 + 24 * VP);
            const bf16x8 v0 = {a0[0], a0[1], a0[2], a0[3], a1[0], a1[1], a1[2], a1[3]}, v1 = {b0[0], b0[1], b0[2], b0[3], b1[0], b1[1], b1[2], b1[3]};
            st.o[d] = __builtin_amdgcn_mfma_f32_32x32x16_bf16(v0, pb0, st.o[d], 0, 0, 0);
            st.o[d] = __builtin_amdgcn_mfma_f32_32x32x16_bf16(v1, pb1, st.o[d], 0, 0, 0);
        }
    }
}
__device__ __forceinline__ void fa_init(FAState& st) {
#pragma unroll
    for (int d = 0; d < 4; ++d)
#pragma unroll
        for (int r = 0; r < 16; ++r) st.o[d][r] = 0.f;
    st.m = NEG_INF; st.l = 0.f;
}
__device__ __forceinline__ void fa_normalize(FAState& st) {
    const float lt = xsum32(st.l), inv = lt > 0.f ? 1.f / lt : 0.f;
#pragma unroll
    for (int d = 0; d < 4; ++d)
#pragma unroll
        for (int r = 0; r < 16; ++r) st.o[d][r] *= inv;
}
__device__ __forceinline__ void fa_store(const FAState& st, bf16_t* orow, int hi) {
#pragma unroll
    for (int d = 0; d < 4; ++d)
#pragma unroll
        for (int g = 0; g < 4; ++g) { u32x2 w; w.x = cvtpk(st.o[d][4 * g], st.o[d][4 * g + 1]); w.y = cvtpk(st.o[d][4 * g + 2], st.o[d][4 * g + 3]);
            *(u32x2*)(orow + 32 * d + 8 * g + 4 * hi) = w; }
}
template <int NSTEP>
__device__ __forceinline__ void fa_loadq(bf16x8 (&q)[NSTEP], const bf16_t* qrow, int hi, bool on) {
#pragma unroll
    for (int s = 0; s < NSTEP; ++s) { bf16x8 z = {0, 0, 0, 0, 0, 0, 0, 0}; q[s] = on ? *(const bf16x8*)(qrow + 16 * s + 8 * hi) : z; }
}

template <int NSTEP>
__device__ __forceinline__ void fa_loadq_lds(LAS char* ql, const bf16_t* qrow, int hi, bool on, int lane) {
#pragma unroll
    for (int s = 0; s < NSTEP; ++s) { bf16x8 z = {0, 0, 0, 0, 0, 0, 0, 0}; *(LAS bf16x8*)(ql + s * 1024 + lane * 16) = on ? *(const bf16x8*)(qrow + 16 * s + 8 * hi) : z; }
}
constexpr int QL_OFF = 8 * VT_BYTES, QL_BYTES = 8192, AUX_OFF = 147456;


constexpr int E1_STAGE = 32768, E1_NS = 3;
template <int NSTEP, class TF>
__device__ __forceinline__ void e1_run(FAState& st, const bf16x8 (&q)[NSTEP], const bf16_t* Kg, const bf16_t* Vg, const int nkt, LAS char* ring, const float sc, const int kc0, const TF& tf, const int lane, const int wid) {
    const int hi = lane >> 5, r32 = lane & 31;
    unsigned doff[2];
#pragma unroll
    for (int i = 0; i < 2; ++i) { const int row = 8 * wid + 4 * i + (lane >> 4), sw = ((row & 3) << 2) | ((row >> 2) & 3); doff[i] = (unsigned)(row * PP + 8 * ((lane & 15) ^ sw)) * 2u; }
    const unsigned ldsw = (unsigned)wid * 2048u;
#define E1_DMAK(kt_, stg_) do { const char* kb_ = (const char*)(Kg + (size_t)(kt_) * 64 * PP); LAS char* sb_ = ring + (stg_) * E1_STAGE + ldsw; \
        __builtin_amdgcn_global_load_lds((const unsigned*)(kb_ + doff[0]), (LAS unsigned*)(sb_), 16, 0, 0); __builtin_amdgcn_global_load_lds((const unsigned*)(kb_ + doff[1]), (LAS unsigned*)(sb_ + 1024), 16, 0, 0); } while (0)
#define E1_DMAV(kt_, stg_) do { const char* vb_ = (const char*)(Vg + (size_t)(kt_) * 64 * PP); LAS char* sb_ = ring + (stg_) * E1_STAGE + ldsw; \
        __builtin_amdgcn_global_load_lds((const unsigned*)(vb_ + doff[0]), (LAS unsigned*)(sb_ + 16384), 16, 0, 0); __builtin_amdgcn_global_load_lds((const unsigned*)(vb_ + doff[1]), (LAS unsigned*)(sb_ + 16384 + 1024), 16, 0, 0); } while (0)
    const int swk = ((r32 & 3) << 2) | ((r32 >> 2) & 3);
    const int koff0 = 256 * r32 + 16 * ((kc0 + hi) ^ swk);
    int voff0[2];
    { const int qq = (lane & 15) >> 2, p = lane & 3, cl = 2 * ((lane >> 4) & 1) + (p >> 1);
#pragma unroll
      for (int rd = 0; rd < 2; ++rd) voff0[rd] = 16384 + 256 * (8 * rd + 4 * hi + qq) + 16 * (4 * qq + (cl ^ ((2 * rd + hi) & 3))) + 8 * (p & 1); }
    if (nkt <= 0) return;
    E1_DMAK(0, 0);
    if (nkt > 1) E1_DMAK(1, 1);
    E1_DMAV(0, 0);
    const f32x16 zero16 = {0.f, 0.f, 0.f, 0.f, 0.f, 0.f, 0.f, 0.f, 0.f, 0.f, 0.f, 0.f, 0.f, 0.f, 0.f, 0.f};
    const bf16x8 zb = {0, 0, 0, 0, 0, 0, 0, 0};
    bf16x8 pb0 = zb, pb1 = zb, pb2 = zb, pb3 = zb;
    int pend = 0, stg = 0, stp = 2;
#pragma clang loop unroll(disable)
    for (int kt = 0; kt <= nkt; ++kt) {
        if (kt + 1 < nkt) asm volatile("s_waitcnt vmcnt(4)" ::: "memory"); else if (kt < nkt) asm volatile("s_waitcnt vmcnt(2)" ::: "memory"); else asm volatile("s_waitcnt vmcnt(0)" ::: "memory");
        __builtin_amdgcn_s_barrier();
        const int sn = stg + 1 >= E1_NS ? 0 : stg + 1;
        if (kt + 2 < nkt) E1_DMAK(kt + 2, stp);
        if (kt + 1 < nkt) E1_DMAV(kt + 1, sn);
        const LAS char* sb = ring + stg * E1_STAGE;
        const bool in = kt < nkt, act0 = in && tf.active(kt, 0), act1 = in && tf.active(kt, 1);
        int act = __builtin_amdgcn_readfirstlane((act0 || act1) ? 1 : 0); asm volatile("" : "+s"(act));
        f32x16 c0 = zero16, c1 = zero16;
        float tmax = NEG_INF, ms = 0.f, alpha = 1.f, ps = 0.f;
        bool mk0 = false, mk1 = false;
        auto mw = tf.fetch(in ? kt : 0);
        if (act) {
            mk0 = tf.masked(kt, 0); mk1 = tf.masked(kt, 1) || !act1;
            int kof = koff0; asm volatile("" : "+v"(kof));
#pragma unroll
            for (int i = 0; i < NSTEP; ++i) { const bf16x8 kf0 = *(const LAS bf16x8*)(sb + (kof ^ (32 * i))), kf1 = *(const LAS bf16x8*)(sb + 8192 + (kof ^ (32 * i)));
                c0 = __builtin_amdgcn_mfma_f32_32x32x16_bf16(kf0, q[i], c0, 0, 0, 0); c1 = __builtin_amdgcn_mfma_f32_32x32x16_bf16(kf1, q[i], c1, 0, 0, 0); }
        }
        const unsigned vb0 = (unsigned)(uintptr_t)(ring + stp * E1_STAGE) + (unsigned)voff0[0], vb1 = (unsigned)(uintptr_t)(ring + stp * E1_STAGE) + (unsigned)voff0[1];
        s16x4 ta[16], tb[16];
#define E1_TRP(j_, off_) do { const unsigned ad0 = vb0 ^ (64u * ((j_) >> 2)), ad1 = vb1 ^ (64u * ((j_) >> 2)); \
            asm volatile("ds_read_b64_tr_b16 %0, %1 offset:" #off_ : "=&v"(ta[j_]) : "v"(ad0) : "memory"); asm volatile("ds_read_b64_tr_b16 %0, %1 offset:" #off_ : "=&v"(tb[j_]) : "v"(ad1) : "memory"); } while (0)
#define E1_PVM(j_, pb_, w_) do { asm volatile("s_waitcnt lgkmcnt(" #w_ ")" ::: "memory"); __builtin_amdgcn_sched_barrier(0); \
            st.o[(j_) >> 2] = __builtin_amdgcn_mfma_f32_32x32x16_bf16((bf16x8){ta[j_][0], ta[j_][1], ta[j_][2], ta[j_][3], tb[j_][0], tb[j_][1], tb[j_][2], tb[j_][3]}, pb_, st.o[(j_) >> 2], 0, 0, 0); \
            __builtin_amdgcn_sched_barrier(0); } while (0)
#define E1_MAX0 do { if (mk0) { _Pragma("unroll") for (int r = 0; r < 16; ++r) { const float v = (act0 && tf.valid(kt, 0, r, hi, mw)) ? c0[r] : NEG_INF; c0[r] = v; tmax = fmaxf(tmax, v); } } \
            else { _Pragma("unroll") for (int r = 0; r < 16; ++r) { const float v = act0 ? c0[r] : NEG_INF; c0[r] = v; tmax = fmaxf(tmax, v); } } __builtin_amdgcn_sched_barrier(0); } while (0)
#define E1_MAX1 do { if (mk1) { _Pragma("unroll") for (int r = 0; r < 16; ++r) { const float v = (act1 && tf.valid(kt, 1, r, hi, mw)) ? c1[r] : NEG_INF; c1[r] = v; tmax = fmaxf(tmax, v); } } \
            else { _Pragma("unroll") for (int r = 0; r < 16; ++r) tmax = fmaxf(tmax, c1[r]); } __builtin_amdgcn_sched_barrier(0); } while (0)
#define E1_RED do { const swap2 rr = pl32swap(tmax, tmax); tmax = fmaxf(rr.a, rr.b) * sc; const float mn = fmaxf(st.m, tmax); ms = (mn == NEG_INF) ? 0.f : mn; \
            alpha = __builtin_amdgcn_exp2f(st.m - ms); st.m = mn; __builtin_amdgcn_sched_barrier(0); } while (0)
#define E1_EXP(c_, lo_) do { _Pragma("unroll") for (int r = (lo_); r < (lo_) + 8; ++r) { const float p = __builtin_amdgcn_exp2f(__builtin_fmaf(c_[r], sc, -ms)); c_[r] = p; ps += p; } __builtin_amdgcn_sched_barrier(0); } while (0)
        __builtin_amdgcn_sched_barrier(0);
        if (pend) { asm volatile("s_waitcnt lgkmcnt(0)" ::: "memory"); __builtin_amdgcn_sched_barrier(0); E1_TRP(0, 0); E1_TRP(1, 4096); E1_TRP(2, 8192); E1_TRP(3, 12288);
                    E1_PVM(0, pb0, 6); E1_TRP(4, 0); E1_PVM(1, pb1, 6); E1_TRP(5, 4096); }
        if (act) E1_MAX0;
        if (pend) { E1_PVM(2, pb2, 6); E1_TRP(6, 8192); E1_PVM(3, pb3, 6); E1_TRP(7, 12288); }
        if (act) E1_MAX1;
        if (pend) { E1_PVM(4, pb0, 6); E1_TRP(8, 0); E1_PVM(5, pb1, 6); E1_TRP(9, 4096); }
        if (act) E1_RED;
        if (pend) { E1_PVM(6, pb2, 6); E1_TRP(10, 8192); E1_PVM(7, pb3, 6); E1_TRP(11, 12288); }
        if (act) E1_EXP(c0, 0);
        if (pend) { E1_PVM(8, pb0, 6); E1_TRP(12, 0); E1_PVM(9, pb1, 6); E1_TRP(13, 4096); }
        if (act) E1_EXP(c0, 8);
        if (pend) { E1_PVM(10, pb2, 6); E1_TRP(14, 8192); E1_PVM(11, pb3, 6); E1_TRP(15, 12288); }
        if (act) E1_EXP(c1, 0);
        if (pend) { E1_PVM(12, pb0, 6); E1_PVM(13, pb1, 4); }
        if (act) E1_EXP(c1, 8);
        if (pend) { E1_PVM(14, pb2, 2); E1_PVM(15, pb3, 0); }
#undef E1_TRP
#undef E1_PVM
#undef E1_MAX0
#undef E1_MAX1
#undef E1_RED
#undef E1_EXP
        if (act) {
            st.l = st.l * alpha + ps;
            if (!__all(alpha == 1.f)) {
#pragma unroll
                for (int d = 0; d < 4; ++d)
#pragma unroll
                    for (int r = 0; r < 16; ++r) st.o[d][r] *= alpha;
            }
            u32x4 w0, w1, w2, w3;
            w0.x = cvtpk(c0[0], c0[1]); w0.y = cvtpk(c0[2], c0[3]); w0.z = cvtpk(c0[4], c0[5]); w0.w = cvtpk(c0[6], c0[7]);
            w1.x = cvtpk(c0[8], c0[9]); w1.y = cvtpk(c0[10], c0[11]); w1.z = cvtpk(c0[12], c0[13]); w1.w = cvtpk(c0[14], c0[15]);
            w2.x = cvtpk(c1[0], c1[1]); w2.y = cvtpk(c1[2], c1[3]); w2.z = cvtpk(c1[4], c1[5]); w2.w = cvtpk(c1[6], c1[7]);
            w3.x = cvtpk(c1[8], c1[9]); w3.y = cvtpk(c1[10], c1[11]); w3.z = cvtpk(c1[12], c1[13]); w3.w = cvtpk(c1[14], c1[15]);
            pb0 = __builtin_bit_cast(bf16x8, w0); pb1 = __builtin_bit_cast(bf16x8, w1); pb2 = __builtin_bit_cast(bf16x8, w2); pb3 = __builtin_bit_cast(bf16x8, w3);
        }
        asm volatile("s_waitcnt lgkmcnt(0)" ::: "memory");
        pend = act; stp = stg; stg = sn;
    }
#undef E1_DMAK
#undef E1_DMAV
}

struct Args {
    const float* x; const int* pos; const float* w_in; const float* w_out; const float* dlam; const float* dng; const float* lmg; const float* lmb;
    const float* rw; const float* rb; const float* wg; const float* wu; const float* wd; const float* lfg; const float* lfb;
    float* out; unsigned char* ws; int ph_lo, ph_hi;
};

struct TFDiffE1 { int q0, qpos;
    __device__ __forceinline__ bool active(int kt, int sub) const { return 64 * kt + 32 * sub <= q0; }
    __device__ __forceinline__ bool masked(int kt, int sub) const { return 64 * kt + 32 * sub == q0; }
    __device__ __forceinline__ int fetch(int) const { return 0; }
    __device__ __forceinline__ bool valid(int kt, int sub, int r, int hi, int) const { return 64 * kt + 32 * sub + crow(r, hi) <= qpos; } };

__device__ __forceinline__ void diff_unit(const Args& A, int layer, int b, int hh, int qb, LAS char* lds, const int wv) {
    int tid_ = wv * 64 + lane_id(); asm volatile("" : "+v"(tid_));
    const int tid = tid_, lane = tid & 63, wid = __builtin_amdgcn_readfirstlane(tid >> 6), sub = wid & 3, map = wid >> 2, hi = lane >> 5;
    const bf16_t* P = (const bf16_t*)(A.ws + WS_PROJ); bf16_t* MIX = (bf16_t*)(A.ws + WS_MIX);
    const int q0 = qb * 128 + sub * 32, qpos = q0 + (lane & 31), tok = b * SEQ + qpos;
    bf16x8 q[4]; fa_loadq<4>(q, P + (size_t)tok * PP + C_BQ + hh * 128 + map * 64, hi, true);
    FAState st; fa_init(st);
    TFDiffE1 tf{q0, qpos};
    e1_run<4>(st, q, P + (size_t)(b * SEQ) * PP + C_BK + hh * 128, P + (size_t)(b * SEQ) * PP + C_BV + hh * 128, 2 * qb + 2, lds, 0.125f * LOG2E, 8 * map, tf, lane, wid);
    __syncthreads();
    fa_normalize(st);
    LAS float* xch = (LAS float*)lds + sub * 4096;
    if (map == 1) {
#pragma unroll
        for (int d = 0; d < 4; ++d)
#pragma unroll
            for (int r = 0; r < 16; ++r) xch[(d * 16 + r) * 64 + lane] = st.o[d][r];
    }
    __syncthreads();
    if (map == 0) {
        int ly_ = layer; asm volatile("" : "+s"(ly_)); const int layer = ly_;
        const float* dl = A.dlam + layer * 256;
        const float s1 = wave_sum(dl[lane] * dl[64 + lane]), s2 = wave_sum(dl[128 + lane] * dl[192 + lane]);
        float c08 = 0.8f; asm volatile("" : "+v"(c08));
        const float lam_init = c08 - 0.6f * expf(-0.3f * (float)layer);
        const float lam = expf(s1) - expf(s2) + lam_init;
        float ss = 0.f;
#pragma unroll
        for (int d = 0; d < 4; ++d)
#pragma unroll
            for (int r = 0; r < 16; ++r) { const float o = st.o[d][r] - lam * xch[(d * 16 + r) * 64 + lane]; st.o[d][r] = o; ss += o * o; }
        ss = xsum32(ss);
        const float rinv = rsqrtf(ss * (1.f / 128.f) + LN_EPS) * (1.f - lam_init);
        const float* g = A.dng + layer * 128;
#pragma unroll
        for (int d = 0; d < 4; ++d)
#pragma unroll
            for (int r = 0; r < 16; ++r) st.o[d][r] *= rinv * g[32 * d + crow(r, hi)];
        fa_store(st, MIX + (size_t)tok * DM + 512 + hh * 128, hi);
    }
}

struct TFMobaE1 { int j, q0, qpos; unsigned selmask, wavemask;
    __device__ __forceinline__ bool active(int kt, int sub) const { const int n = kt >> 2; return n < j ? ((wavemask >> n) & 1u) != 0u : (64 * kt + 32 * sub <= q0); }
    __device__ __forceinline__ bool masked(int kt, int sub) const { const int n = kt >> 2; return n < j ? true : (64 * kt + 32 * sub == q0); }
    __device__ __forceinline__ int fetch(int) const { return 0; }
    __device__ __forceinline__ bool valid(int kt, int sub, int r, int hi, int) const { const int n = kt >> 2; return n < j ? ((selmask >> n) & 1u) != 0u : (64 * kt + 32 * sub + crow(r, hi) <= qpos); } };

__device__ __forceinline__ void moba_unit(const Args& A, int layer, int b, int hh, int j, LAS char* lds, const int wv) {
    int tid_ = wv * 64 + lane_id(); asm volatile("" : "+v"(tid_));
    const int tid = tid_, lane = tid & 63, wid = __builtin_amdgcn_readfirstlane(tid >> 6), hi = lane >> 5;
    const bf16_t* P = (const bf16_t*)(A.ws + WS_PROJ); bf16_t* MIX = (bf16_t*)(A.ws + WS_MIX);
    LAS float* km = (LAS float*)(lds + AUX_OFF);
    { const float* kms = (const float*)(A.ws + WS_CTL + KM_OFF) + (size_t)((layer * NB + b) * 16) * 512 + hh * 128;
      float kv[4];
#pragma unroll
      for (int k = 0; k < 4; ++k) { const int i = tid + 512 * k; kv[k] = i < j * 128 ? kms[(size_t)(i >> 7) * 512 + (i & 127)] : 0.f; }
#pragma unroll
      for (int k = 0; k < 4; ++k) { const int i = tid + 512 * k; if (i < j * 128) km[i] = kv[k] * (1.f / 256.f); } }
    __syncthreads();
    const int q0 = j * 256 + wid * 32, qpos = q0 + (lane & 31), tok = b * SEQ + qpos;
    const bf16_t* qrow = P + (size_t)tok * PP + C_CQ + hh * 128;
    float gate[16];
#pragma unroll
    for (int n = 0; n < 16; ++n) gate[n] = 0.f;
    u32x4 qnx = *(const u32x4*)(qrow);
#pragma unroll 1
    for (int c = 0; c < 16; ++c) {
        const u32x4 qw = qnx; if (c + 1 < 16) qnx = *(const u32x4*)(qrow + 8 * (c + 1));
        const float qf[8] = {bflo(qw.x), bfhi(qw.x), bflo(qw.y), bfhi(qw.y), bflo(qw.z), bfhi(qw.z), bflo(qw.w), bfhi(qw.w)};
#pragma unroll
        for (int n = 0; n < 16; ++n) {
            const f32x4 k0 = *(const LAS f32x4*)(km + n * 128 + 8 * c), k1 = *(const LAS f32x4*)(km + n * 128 + 8 * c + 4);
            gate[n] += qf[0] * k0[0] + qf[1] * k0[1] + qf[2] * k0[2] + qf[3] * k0[3] + qf[4] * k1[0] + qf[5] * k1[1] + qf[6] * k1[2] + qf[7] * k1[3];
        }
    }
    unsigned selmask = 0u;
#pragma unroll
    for (int pick = 0; pick < 3; ++pick) {
        float best = NEG_INF; int bi = -1;
#pragma unroll
        for (int n = 0; n < 16; ++n) { const bool ok = (n < j) && !((selmask >> n) & 1u) && (gate[n] > best || bi < 0); if (ok) { best = gate[n]; bi = n; } }
        if (bi >= 0) selmask |= 1u << bi;
    }
    unsigned wavemask = 0u;
#pragma unroll
    for (int n = 0; n < 16; ++n) wavemask |= (__any((selmask >> n) & 1u) ? 1u : 0u) << n;
    bf16x8 q[8]; fa_loadq<8>(q, qrow, hi, true);
    FAState st; fa_init(st);
    TFMobaE1 tf{j, q0, qpos, selmask, wavemask};
    e1_run<8>(st, q, P + (size_t)(b * SEQ) * PP + C_CK + hh * 128, P + (size_t)(b * SEQ) * PP + C_CV + hh * 128, 4 * j + 4, lds, 0.08838834764831845f * LOG2E, 0, tf, lane, wid);
    fa_normalize(st);
    int tok2 = b * SEQ + j * 256 + wid * 32 + (lane_id() & 31); asm volatile("" : "+v"(tok2));
    fa_store(st, MIX + (size_t)tok2 * DM + 1024 + hh * 128, hi);
}

struct TFDil { int rowbase, base, stride, add, uq, want, q4;
    __device__ __forceinline__ int row(int t, int key) const { int u = base + 32 * t + key; u = u < 0 ? 0 : u; int s = stride * u + add; s = s > SEQ - 1 ? SEQ - 1 : s; return rowbase + s; }
    __device__ __forceinline__ bool valid(int t, int r, int hi) const { const int u = base + 32 * t + crow(r, hi), d = uq - u; return u >= 0 && d >= 0 && d <= 128 && (want < 0 || q4 == want); } };

__device__ __forceinline__ void dil_unit(const Args& A, int b, int hh, int blk, LAS char* lds, const int wv) {
    int tid_ = wv * 64 + lane_id(); asm volatile("" : "+v"(tid_));
    const int tid = tid_, lane = tid & 63, wid = __builtin_amdgcn_readfirstlane(tid >> 6), hi = lane >> 5;
    const bf16_t* P = (const bf16_t*)(A.ws + WS_PROJ); bf16_t* MIX = (bf16_t*)(A.ws + WS_MIX);
    const int t0 = blk * 256 + (wid >> 2) * 128, r4 = wid & 3, c = lane & 31, i = c & 7, q4 = c >> 3;
    const int tq = t0 + 16 * i + 4 * q4 + r4, tok = b * SEQ + tq;
    bf16x8 q[8]; fa_loadq<8>(q, P + (size_t)tok * PP + C_DQ + hh * 128, hi, true); const LAS char* ql = nullptr;
    FAState st; fa_init(st);
    const float sc = 0.08838834764831845f * LOG2E;
    LAS char* vl = lds + wid * VT_BYTES;
    const int kc = C_DK + hh * 128, vc = C_DV + hh * 128;
    { TFDil tf{b * SEQ, t0 - 128, 1, 0, tq, -1, q4}; fa_run<8, false>(st, q, ql, P, tf, t0 >= 128 ? 0 : 4, 8, vl, sc, kc, vc, lane); }
    { const int u0 = t0 >> 2; int ts = (128 - u0 + 31) >> 5; ts = ts < 0 ? 0 : ts;
      TFDil tf{b * SEQ, u0 - 128, 4, r4, u0 + 4 * i + q4, -1, q4}; fa_run<8, false>(st, q, ql, P, tf, ts, 5, vl, sc, kc, vc, lane); }
    { const int u0 = t0 >> 4; int ts = (128 - u0 + 31) >> 5; ts = ts < 0 ? 0 : ts;
      for (int w4 = 0; w4 < 4; ++w4) { TFDil tf{b * SEQ, u0 - 128, 16, r4 + 4 * w4, u0 + i, w4, q4}; fa_run<8, false>(st, q, ql, P, tf, ts, 5, vl, sc, kc, vc, lane); } }
    fa_normalize(st);
    fa_store(st, MIX + (size_t)tok * DM + 1536 + hh * 128, hi);
}

struct TFDsaE1 { const LAS char* mb;
    __device__ __forceinline__ bool active(int, int) const { return true; }
    __device__ __forceinline__ bool masked(int, int) const { return true; }
    __device__ __forceinline__ unsigned fetch(int kt) const { return *(const LAS unsigned*)(mb + 512 * kt); }
    __device__ __forceinline__ bool valid(int, int sub, int r, int, unsigned mw) const { return ((mw >> (8 * (r & 3) + 4 * sub + (r >> 2))) & 1u) != 0u; } };

__device__ __forceinline__ unsigned ord16(unsigned h) { return (h & 0x8000u) ? (~h & 0xffffu) : (h | 0x8000u); }

__device__ __forceinline__ void dsa_unit(const Args& A, int layer, int b, int t0, LAS char* lds, const int wv, const int level) {
    int tid_ = wv * 64 + lane_id(); asm volatile("" : "+v"(tid_));
    const int tid = tid_, lane = tid & 63, wid = __builtin_amdgcn_readfirstlane(tid >> 6), hi = lane >> 5;
    const bf16_t* P = (const bf16_t*)(A.ws + WS_PROJ); bf16_t* MIX = (bf16_t*)(A.ws + WS_MIX);
    LAS unsigned short* sco = (LAS unsigned short*)lds;
    LAS char* kst = lds + 131072;
    unsigned* dsac = (unsigned*)(A.ws + WS_CTL) + CW_DSAC + 128 * layer + 64 * b + (t0 >> 6);
    const int nkeys = t0 + 16, nchunk = (nkeys + 127) >> 7;
    {
        const int r = lane & 31;
        const int tokq = b * SEQ + t0 + 2 * wid + (r >> 4);
        bf16x8 aq[4];
#pragma unroll
        for (int s = 0; s < 4; ++s) aq[s] = *(const bf16x8*)(P + (size_t)tokq * PP + C_IQ + (r & 15) * 64 + 16 * s + 8 * hi);
        float wgt[16];
#pragma unroll
        for (int rr = 0; rr < 16; ++rr) { const int head = (rr & 3) + 8 * ((rr >> 2) & 1) + 4 * hi;
            wgt[rr] = bf2f(P[(size_t)(b * SEQ + t0 + 2 * wid + (rr >> 3)) * PP + C_IW + head]) * 0.03125f; }
        const int tlim = (t0 + 2 * wid + 1) >> 5;
        const int k0_ = tid >> 3, c0_ = tid & 7;
        const bf16_t* src = P + (size_t)(b * SEQ) * PP + C_IK + c0_ * 8;
        u32x4 pa0, pa1, pb0, pb1;
#define DSA_STAGE_LOAD(d0_, d1_, ch_) do { int ka_ = 128 * (ch_) + k0_, kb_ = ka_ + 64; ka_ = ka_ > SEQ - 1 ? SEQ - 1 : ka_; kb_ = kb_ > SEQ - 1 ? SEQ - 1 : kb_; \
            d0_ = *(const u32x4*)(src + (size_t)ka_ * PP); d1_ = *(const u32x4*)(src + (size_t)kb_ * PP); } while (0)
#define DSA_CHUNK(s0_, s1_, ch_) do { \
            __syncthreads(); \
            *(LAS u32x4*)(kst + k0_ * 128 + ((c0_ ^ ((k0_ >> 1) & 7)) << 4)) = s0_; \
            *(LAS u32x4*)(kst + (k0_ + 64) * 128 + ((c0_ ^ (((k0_ + 64) >> 1) & 7)) << 4)) = s1_; \
            __syncthreads(); \
            if ((ch_) + 2 < nchunk) DSA_STAGE_LOAD(s0_, s1_, (ch_) + 2); \
              \
            _Pragma("unroll") for (int th = 0; th < 4; th += 2) { \
                bf16x8 kb_[2][4]; \
                _Pragma("unroll") for (int tt = 0; tt < 2; ++tt) { const int kr = 32 * (th + tt) + r; \
                    _Pragma("unroll") for (int s = 0; s < 4; ++s) kb_[tt][s] = *(const LAS bf16x8*)(kst + kr * 128 + (((2 * s + hi) ^ ((kr >> 1) & 7)) << 4)); } \
                f32x16 ca_[2]; \
                _Pragma("unroll") for (int tt = 0; tt < 2; ++tt) ca_[tt] = (f32x16){0.f, 0.f, 0.f, 0.f, 0.f, 0.f, 0.f, 0.f, 0.f, 0.f, 0.f, 0.f, 0.f, 0.f, 0.f, 0.f}; \
                _Pragma("unroll") for (int s = 0; s < 4; ++s) \
                    _Pragma("unroll") for (int tt = 0; tt < 2; ++tt) ca_[tt] = __builtin_amdgcn_mfma_f32_32x32x16_bf16(aq[s], kb_[tt][s], ca_[tt], 0, 0, 0); \
                _Pragma("unroll") for (int tt = 0; tt < 2; ++tt) { \
                    float p0 = 0.f, p1 = 0.f; \
                    _Pragma("unroll") for (int rr = 0; rr < 8; ++rr) { const float r0_ = __builtin_amdgcn_fmed3f(ca_[tt][rr], 0.f, 3.0e38f), r1_ = __builtin_amdgcn_fmed3f(ca_[tt][8 + rr], 0.f, 3.0e38f);     \
                        p0 = __builtin_fmaf(wgt[rr], r0_, p0); p1 = __builtin_fmaf(wgt[8 + rr], r1_, p1); } \
                    const swap2 sw = pl32swap(p0, p1); const float tot = sw.a + sw.b; \
                    const _Float16 hsc = (_Float16)tot; \
                    sco[(2 * wid + hi) * 4096 + 32 * (4 * (ch_) + th + tt) + r] = __builtin_bit_cast(unsigned short, hsc); \
                } __builtin_amdgcn_sched_barrier(0); } } while (0)
        DSA_STAGE_LOAD(pa0, pa1, 0);
        if (nchunk > 1) DSA_STAGE_LOAD(pb0, pb1, 1);
        for (int ch = 0; ch < nchunk; ch += 2) {
            DSA_CHUNK(pa0, pa1, ch);
            if (ch + 1 < nchunk) DSA_CHUNK(pb0, pb1, ch + 1);
        }
#undef DSA_CHUNK
#undef DSA_STAGE_LOAD
    }
    __syncthreads();
    if (level < 2) return;
#pragma unroll 1
    for (int qq = 0; qq < 2; ++qq) {
        const int qi = 2 * wid + qq, tq = t0 + qi, nv = tq + 1;
        unsigned long long* bmq = (unsigned long long*)(A.ws + WS_BM) + (size_t)(b * SEQ + tq) * 64;
        if (nv <= 256) { const int cntl = tq >= lane ? ((tq - lane) >> 3) + 1 : 0;
            if (lane < 8) __hip_atomic_store(bmq + lane, (1ull << cntl) - 1ull, RLX_AGENT);
            continue; }
        const int nch = (nv + 511) >> 9;
        typedef unsigned short u16x2 __attribute__((ext_vector_type(2)));
        unsigned v[32];
#pragma unroll
        for (int i = 0; i < 8; ++i) {
            if (i < nch) { const u32x4 f = *(const LAS u32x4*)(sco + qi * 4096 + i * 512 + 8 * lane);
                const unsigned w[4] = {f.x, f.y, f.z, f.w};
#pragma unroll
                for (int d = 0; d < 4; ++d) { const int k0 = i * 512 + 8 * lane + 2 * d;
                    const unsigned neg = (w[d] >> 15) & 0x00010001u, ordw = w[d] ^ ((neg * 0xffffu) | 0x80008000u);
                    const unsigned vm = (k0 <= tq ? 0x0000ffffu : 0u) | (k0 + 1 <= tq ? 0xffff0000u : 0u);
                    v[i * 4 + d] = ordw & vm; } }
            else {
#pragma unroll
                for (int d = 0; d < 4; ++d) v[i * 4 + d] = 0u; }
        }
        unsigned tp[32];
#pragma unroll
        for (int r = 0; r < 32; ++r) tp[r] = v[r];
#define DSA_TSTAGE(j_, m_) { _Pragma("unroll") for (int k = 0; k < 32; ++k) if ((k & (j_)) == 0) { const unsigned t_ = ((tp[k] >> (j_)) ^ tp[k + (j_)]) & (m_); tp[k + (j_)] ^= t_; tp[k] ^= t_ << (j_); } }
        DSA_TSTAGE(16, 0x0000ffffu) DSA_TSTAGE(8, 0x00ff00ffu) DSA_TSTAGE(4, 0x0f0f0f0fu) DSA_TSTAGE(2, 0x33333333u) DSA_TSTAGE(1, 0x55555555u)
#undef DSA_TSTAGE
        unsigned x = 0u, mlo = 0xffffffffu, mhi = 0xffffffffu;
        int gtot = 0;
#pragma unroll
        for (int bit = 15; bit >= 0; --bit) {
            const unsigned olo = mlo & tp[bit], ohi = mhi & tp[16 + bit];
            const int tot = wave_isum(__builtin_popcount(olo) + __builtin_popcount(ohi));
            if (gtot + tot >= 256) { x |= 1u << bit; mlo = olo; mhi = ohi; } else { gtot += tot; mlo ^= olo; mhi ^= ohi; }
        }
        unsigned long long myw = 0ull;
        const int etot = wave_isum(__builtin_popcount(mlo) + __builtin_popcount(mhi));
        if (gtot + etot == 256 && x != 0u) {
#pragma unroll
            for (int i = 0; i < 8; ++i) if (i < nch) {
#pragma unroll
                for (int e = 0; e < 8; ++e) {
                    const unsigned vv = (e & 1) ? (v[i * 4 + (e >> 1)] >> 16) : (v[i * 4 + (e >> 1)] & 0xffffu);
                    const unsigned long long wj = __ballot(vv >= x);
                    if (lane == 8 * i + e) myw = wj;
                }
            }
        } else {
        int be = gtot;
#pragma unroll
        for (int i = 0; i < 8; ++i) if (i < nch) {
#pragma unroll
            for (int e = 0; e < 8; ++e) {
                const unsigned vv = (e & 1) ? (v[i * 4 + (e >> 1)] >> 16) : (v[i * 4 + (e >> 1)] & 0xffffu);
                const bool g = vv > x, eq = vv == x;
                const unsigned long long mg = __ballot(g), me = __ballot(eq);
                const int pe = be + (int)__builtin_amdgcn_mbcnt_hi((unsigned)(me >> 32), __builtin_amdgcn_mbcnt_lo((unsigned)me, 0u));
                const unsigned long long wj = mg | __ballot(eq && pe < 256);
                if (lane == 8 * i + e) myw = wj;
                be += __popcll(me);
            }
        }
        }
        if (lane < 8 * nch) __hip_atomic_store(bmq + lane, myw, RLX_AGENT);
    }
    asm volatile("s_waitcnt vmcnt(0)" ::: "memory");
    __syncthreads();
    if (tid == 0) __hip_atomic_fetch_add(dsac, 1u, RLX_AGENT);
}

__device__ __forceinline__ void dsa_att_unit(const Args& A, int layer, int b, int g, LAS char* lds, const int wv) {
    int tid_ = wv * 64 + lane_id(); asm volatile("" : "+v"(tid_));
    const int tid = tid_, lane = tid & 63, wid = __builtin_amdgcn_readfirstlane(tid >> 6), hi = lane >> 5;
    const bf16_t* P = (const bf16_t*)(A.ws + WS_PROJ); bf16_t* MIX = (bf16_t*)(A.ws + WS_MIX);
    unsigned* ctl = (unsigned*)(A.ws + WS_CTL);
    if (tid == 0) {
        unsigned sp = 0u;
        while (__hip_atomic_load(ctl + CW_DSAC + 128 * layer + 64 * b + g, RLX_AGENT) < 4u) { __builtin_amdgcn_s_sleep(2);
            if ((++sp & 255u) == 0u) { if (__hip_atomic_load(ctl + CW_BAR + XB_TMO, RLX_AGENT)) break; if (sp > XB_SPIN_CAP) { atomicAdd(ctl + CW_BAR + XB_TMO, 1u); break; } } }
    }
    __syncthreads();
    __builtin_amdgcn_fence(__ATOMIC_ACQUIRE, "agent");
    LAS char* bml = lds + E1_NS * E1_STAGE;
    { const int qi = tid >> 3, e = tid & 7; const unsigned long long* src = (const unsigned long long*)(A.ws + WS_BM) + (size_t)(b * SEQ + 64 * g + qi) * 64 + e;
      unsigned long long wv[8];
#pragma unroll
      for (int i = 0; i < 8; ++i) wv[i] = (8 * i <= g) ? src[8 * i] : 0ull;
#pragma unroll
      for (int i = 0; i < 8; ++i) if (8 * i <= g) { const unsigned long long w = wv[i];
#pragma unroll
          for (int j = 0; j < 8; ++j) *(LAS unsigned char*)(bml + 512 * (8 * i + j) + 8 * qi + e) = (unsigned char)(w >> (8 * j)); } }
    const int c = lane & 31, qi = 8 * wid + (c >> 2), tok = b * SEQ + 64 * g + qi;
    bf16x8 q[8]; fa_loadq<8>(q, P + (size_t)tok * PP + C_AQ + (c & 3) * 128, hi, true);
    FAState st; fa_init(st);
    TFDsaE1 tf{bml + 8 * qi + 4 * hi};
    __syncthreads();
    e1_run<8>(st, q, P + (size_t)(b * SEQ) * PP + C_AK, P + (size_t)(b * SEQ) * PP + C_AV, g + 1, lds, 0.08838834764831845f * LOG2E, 0, tf, lane, wid);
    fa_normalize(st);
    fa_store(st, MIX + (size_t)tok * DM + (c & 3) * 128, hi);
}

#define XB_XCNT(j)  (256  + 64 * (j))
#define XB_XSUB(j)  (1280 + 64 * (j))
#define XB_XGEN(j)  (2304 + 64 * (j))
#define XB_TOP      3328
#define XB_TOPGEN   3392
__device__ __forceinline__ unsigned xb_ld(unsigned* p)              { return __hip_atomic_load(p, __ATOMIC_RELAXED, __HIP_MEMORY_SCOPE_AGENT); }
__device__ __forceinline__ unsigned xb_add(unsigned* p, unsigned v) { return __hip_atomic_fetch_add(p, v, __ATOMIC_RELAXED, __HIP_MEMORY_SCOPE_AGENT); }
__device__ __forceinline__ unsigned xb_xcc_id() { return (unsigned)__builtin_amdgcn_s_getreg((3 << 11) | 20) & 0xFu; }
#define XB_SPIN(cond, bar) do { unsigned _sp = 0; while (cond) { __builtin_amdgcn_s_sleep(1); \
    if ((++_sp & 255u) == 0u) { if (xb_ld(&(bar)[XB_TMO])) break; if (_sp > XB_SPIN_CAP) { atomicAdd(&(bar)[XB_TMO], 1u); break; } } } } while (0)
struct XcdBarrier { unsigned* bar; unsigned x; volatile LAS unsigned* st; };
__device__ __forceinline__ XcdBarrier xcd_barrier_post(unsigned* bar, volatile LAS unsigned* st, bool leader) {
    XcdBarrier b; b.bar = bar; b.x = xb_xcc_id(); b.st = st;
    if (leader) (void)xb_add(&bar[XB_XCNT(b.x)], 1u);
    return b;
}
__device__ __forceinline__ void xcd_barrier_complete(unsigned* bar, unsigned x, unsigned& nloc, unsigned& nx) {
    const unsigned G = gridDim.x * gridDim.y * gridDim.z;
    unsigned sum, cnt, mine, sp = 0u;
    for (;;) {
        sum = 0u; cnt = 0u; mine = 0u;
#pragma unroll
        for (unsigned j = 0; j < 16; ++j) { const unsigned c = xb_ld(&bar[XB_XCNT(j)]); sum += c; cnt += (c > 0u) ? 1u : 0u; mine = (j == x) ? c : mine; }
        if (sum == G) break;
        __builtin_amdgcn_s_sleep(1);
        if ((++sp & 255u) == 0u) { if (xb_ld(&bar[XB_TMO])) break; if (sp > XB_SPIN_CAP) { atomicAdd(&bar[XB_TMO], 1u); break; } }
    }
    nloc = mine > 0u ? mine : 1u; nx = cnt > 0u ? cnt : 1u;
}
__device__ __forceinline__ void xcd_barrier(const XcdBarrier& b, bool leader) {
    asm volatile("s_waitcnt vmcnt(0)" ::: "memory");
    __syncthreads();
    if (leader) {
        unsigned* bar = b.bar;
        __builtin_amdgcn_s_waitcnt(0);
        unsigned nloc = b.st[0], nx = b.st[1];
        if (nloc == 0u) { xcd_barrier_complete(bar, b.x, nloc, nx); b.st[0] = nloc; b.st[1] = nx; }
        const unsigned old = xb_add(&bar[XB_XSUB(b.x)], 1u);
        const unsigned gen = old / nloc;
        if (old + 1u == (gen + 1u) * nloc) {
            __builtin_amdgcn_fence(__ATOMIC_RELEASE, "agent");
            asm volatile("s_waitcnt vmcnt(0)" ::: "memory");
            const unsigned og = xb_add(&bar[XB_TOP], 1u);
            const unsigned tg = og / nx;
            __builtin_amdgcn_fence(__ATOMIC_ACQUIRE, "agent");
            if (og + 1u == (tg + 1u) * nx) xb_add(&bar[XB_TOPGEN], 1u);
            else XB_SPIN(xb_ld(&bar[XB_TOPGEN]) == tg, bar);
            asm volatile("s_waitcnt vmcnt(0)" ::: "memory");
        } else {
            __builtin_amdgcn_fence(__ATOMIC_ACQUIRE, "agent");
            XB_SPIN(xb_ld(&bar[XB_TOPGEN]) == gen, bar);
            asm volatile("s_waitcnt vmcnt(0)" ::: "memory");
        }
    }
    __syncthreads();
}

struct Frame { LAS unsigned char* lds; LAS int* lctl; int wave, vcu, G; };

constexpr int NT8 = 20, NTB = 6;
constexpr size_t WIN_LAYER = 26 * MiB, WIN_BF = 10 * MiB;
struct TItem { const float* W; bf16_t* WT; int ldw, ldt, ncols, f8; };
__device__ __forceinline__ int item_remap(int r, int KB) { const int G = r >> 4, j = r & 15, KBB = KB >> 2, nbb = G / KBB, kbb = G - nbb * KBB; return (nbb * 4 + (j >> 2)) * KB + kbb * 4 + (j & 3); }
__device__ __forceinline__ TItem decode_item(const Args& A, int it) {
    constexpr int I_IN = 208 * 32, I_OUT = 64 * 32, I_G = 32 * 32, I_D = 64 * 16;
    constexpr int N_IN = DEPTH * I_IN, N_OUT = DEPTH * I_OUT, N_GU = DEPTH * NE * 2 * I_G;
    TItem t; int r = it;
    if (r < N_IN) { const int l = r / I_IN; r -= l * I_IN; r = item_remap(r, 32); const int cb = r >> 5, kb = r & 31, bj = (cb >> 2) & 1;
        const int tile = cb >> 3, wc = cb & 3, grp = tile * 4 + wc;
        const int mode = GRP[grp][0], lo = GRP[grp][1], ho = GRP[grp][2];
        int ncols = 32, n0 = lo + (bj ? ho : 0);
        if (mode == 4) { ncols = 0; n0 = 0; } else if (mode == 3) { ncols = bj ? 0 : 16; n0 = lo; }
        t.W = A.w_in + (size_t)l * DM * PP + (size_t)(kb * 64) * PP + n0; t.ldw = PP; t.ncols = ncols; t.ldt = DM;
        if (tile < NT8) { t.f8 = 1; t.WT = (bf16_t*)(A.ws + WS_WIN + l * WIN_LAYER + (size_t)(cb * 32) * DM + kb * 64); }
        else { t.f8 = 0; t.WT = (bf16_t*)(A.ws + WS_WIN + l * WIN_LAYER + WIN_BF) + (size_t)((cb - NT8 * 8) * 32) * DM + kb * 64; }
        return t; }
    r -= N_IN;
    if (r < N_OUT) { const int l = r / I_OUT; r -= l * I_OUT; r = item_remap(r, 32); const int nb = r >> 5, kb = r & 31;
        t.W = A.w_out + (size_t)l * DM * DM + (size_t)(kb * 64) * DM + nb * 32; t.ldw = DM; t.ncols = 32; t.f8 = 0;
        t.WT = (bf16_t*)(A.ws + WS_WOUT) + (size_t)l * DM * DM + (size_t)(nb * 32) * DM + kb * 64; t.ldt = DM; return t; }
    r -= N_OUT;
    if (r < N_GU) { const int le = r / (2 * I_G); r -= le * 2 * I_G; const int up = r / I_G; r -= up * I_G; r = item_remap(r, 32); const int nb = r >> 5, kb = r & 31, n0 = nb * 32;
        t.W = (up ? A.wu : A.wg) + (size_t)le * DM * DFF + (size_t)(kb * 64) * DFF + n0; t.ldw = DFF; t.ncols = 32; t.f8 = 1;
        t.WT = (bf16_t*)((unsigned char*)(A.ws + WS_WGU) + (size_t)le * DM * DM + (size_t)(256 * (n0 >> 7) + (n0 & 127) + 128 * up) * DM + kb * 64); t.ldt = DM; return t; }
    r -= N_GU;
    { const int le = r / I_D; r -= le * I_D; r = item_remap(r, 16); const int nb = r >> 4, kb = r & 15;
      t.W = A.wd + (size_t)le * DFF * DM + (size_t)(kb * 64) * DM + nb * 32; t.ldw = DM; t.ncols = 32; t.f8 = 1;
      t.WT = (bf16_t*)((unsigned char*)(A.ws + WS_WD) + (size_t)le * DM * DFF + (size_t)(nb * 32) * DFF + kb * 64); t.ldt = DFF; return t; }
}
__device__ __forceinline__ void titem_load(const TItem& t, f32x4 (&v)[8], int lane) {
    const int c4 = (lane & 7) * 4; const bool on = c4 < t.ncols;
#pragma unroll
    for (int i = 0; i < 8; ++i) { const float* p = t.W + (size_t)((lane >> 3) + 8 * i) * t.ldw + c4; v[i] = on ? *(const f32x4*)p : (f32x4){0.f, 0.f, 0.f, 0.f}; }
}
__device__ __forceinline__ void titem_store(const TItem& t, const f32x4 (&v)[8], LAS float* scr, int lane) {
    const int c4 = (lane & 7) * 4;
#pragma unroll
    for (int i = 0; i < 8; ++i) { LAS float* d = scr + ((lane >> 3) + 8 * i) * 33 + c4; d[0] = v[i][0]; d[1] = v[i][1]; d[2] = v[i][2]; d[3] = v[i][3]; }
    asm volatile("s_waitcnt lgkmcnt(0)" ::: "memory");
    const int c = lane & 7;
#pragma unroll
    for (int j = 0; j < 4; ++j) { const int n = (lane >> 3) + 8 * j; const LAS float* s = scr + (8 * c) * 33 + n;
        if (t.f8) { u32x2 o; o.x = pk4_fp8(64.f * s[0 * 33], 64.f * s[1 * 33], 64.f * s[2 * 33], 64.f * s[3 * 33]); o.y = pk4_fp8(64.f * s[4 * 33], 64.f * s[5 * 33], 64.f * s[6 * 33], 64.f * s[7 * 33]);
            *(u32x2*)((unsigned char*)t.WT + (size_t)n * t.ldt + 8 * c) = o; }
        else { u32x4 o; o.x = cvtpk(s[0 * 33], s[1 * 33]); o.y = cvtpk(s[2 * 33], s[3 * 33]); o.z = cvtpk(s[4 * 33], s[5 * 33]); o.w = cvtpk(s[6 * 33], s[7 * 33]);
            *(u32x4*)(t.WT + (size_t)n * t.ldt + 8 * c) = o; } }
    asm volatile("s_waitcnt lgkmcnt(0)" ::: "memory");
}

constexpr int FILL_E1 = 2048, FILL_E2 = FILL_E1 + 32768, FILL_E3 = FILL_E2 + 16384, FILL_E4 = FILL_E3 + 6656, FILL_E5 = FILL_E4 + 2048, FILL_E6 = FILL_E5 + 32768, FILL_E7 = FILL_E6 + 16384;
constexpr int CW_FILL = 3200, CW_DONE = 2112;
__device__ __forceinline__ int fill_to_item(int i) {
    constexpr int N_IN = 2 * 6656, N_OUT = 2 * 2048, N_GU = 2 * 32768;
    if (i < FILL_E1) return N_IN + i;
    if (i < FILL_E2) return N_IN + N_OUT + (i - FILL_E1);
    if (i < FILL_E3) return N_IN + N_OUT + N_GU + (i - FILL_E2);
    if (i < FILL_E4) return 6656 + (i - FILL_E3);
    if (i < FILL_E5) return N_IN + 2048 + (i - FILL_E4);
    if (i < FILL_E6) return N_IN + N_OUT + 32768 + (i - FILL_E5);
    return N_IN + N_OUT + N_GU + 16384 + (i - FILL_E6);
}
__device__ __forceinline__ void fill_run(const Args& A, Frame& F, int must, bool opp, int ph) {
    unsigned* ctl = (unsigned*)(A.ws + WS_CTL);
    const int fq = F.vcu & 7;
    unsigned* qh = ctl + CW_FILL + 64 * fq; unsigned* done = ctl + CW_DONE + 64 * ph;
    const int lane = lane_id();
    __syncthreads();
    if (opp && F.wave == 0 && lane == 0) __hip_atomic_fetch_add(done, 1u, RLX_AGENT);
    LAS float* scr = (LAS float*)(F.lds + F.wave * 16384);
    for (;;) {
        __syncthreads();
        if (F.wave == 0 && lane == 0) {
            int base = FILL_E7; const int head = (int)__hip_atomic_load(qh, RLX_AGENT);
            bool go = head < FILL_E7 / 8;
            if (go && head >= must / 8) go = opp && (int)__hip_atomic_load(done, RLX_AGENT) < F.G;
            if (go) { const int bl = (int)__hip_atomic_fetch_add(qh, 16u, RLX_AGENT); base = bl < FILL_E7 / 8 ? ((bl >> 4) * 8 + fq) * 16 : FILL_E7; }
            F.lctl[1] = base;
        }
        __syncthreads();
        const int base = F.lctl[1];
        if (base >= FILL_E7) break;
        const int i0 = base + 2 * F.wave, i1 = i0 + 1;
        f32x4 va[8], vb[8]; TItem ta, tb;
        if (i0 < FILL_E7) { ta = decode_item(A, fill_to_item(i0)); titem_load(ta, va, lane); }
        if (i1 < FILL_E7) { tb = decode_item(A, fill_to_item(i1)); titem_load(tb, vb, lane); }
#ifndef PROBE_FILL2
#define PROBE_FILL2 0
#endif
        if (i0 < FILL_E7) titem_store(ta, va, scr, lane);
        if (i1 < FILL_E7) titem_store(tb, vb, scr, lane);
        if (PROBE_FILL2) {
            if (i0 < FILL_E7) { titem_load(ta, va, lane); } if (i1 < FILL_E7) { titem_load(tb, vb, lane); }
            if (i0 < FILL_E7) titem_store(ta, va, scr, lane); if (i1 < FILL_E7) titem_store(tb, vb, scr, lane); }
    }
}

__device__ __forceinline__ void phase_prologue(const Args& A, Frame& F) {
    LAS float* scr = (LAS float*)(F.lds + F.wave * 16384);
    const int lane = lane_id(), tid = F.wave * 64 + lane;
    const int gw = F.vcu * 8 + F.wave, NGW = F.G * 8;
    constexpr int NITEMS = 208 * 32;
    {
        f32x4 va[8], vb[8]; TItem ta, tb;
        int it = gw;
        if (it < NITEMS) { ta = decode_item(A, it); titem_load(ta, va, lane); }
        while (it < NITEMS) {
            const int it1 = it + NGW, it2 = it + 2 * NGW;
            if (it1 < NITEMS) { tb = decode_item(A, it1); titem_load(tb, vb, lane); }
            titem_store(ta, va, scr, lane);
            if (it1 >= NITEMS) break;
            if (it2 < NITEMS) { ta = decode_item(A, it2); titem_load(ta, va, lane); }
            titem_store(tb, vb, scr, lane);
            it = it2;
        }
    }
    { const int gt = F.vcu * 512 + tid, NT = F.G * 512; bf16_t* XB = (bf16_t*)(A.ws + WS_XB);
      for (size_t i = gt; i < (size_t)T * DM / 8; i += NT) { const f32x4 a = ((const f32x4*)A.x)[2 * i], c = ((const f32x4*)A.x)[2 * i + 1];
          u32x4 w; w.x = cvtpk(a[0], a[1]); w.y = cvtpk(a[2], a[3]); w.z = cvtpk(c[0], c[1]); w.w = cvtpk(c[2], c[3]); ((u32x4*)XB)[i] = w;
          u32x2 q8; q8.x = pk4_fp8(a[0], a[1], a[2], a[3]); q8.y = pk4_fp8(c[0], c[1], c[2], c[3]); ((u32x2*)(A.ws + WS_XQ))[i] = q8; } }
    { const int gt = F.vcu * 512 + tid, NT = F.G * 512; f32x2* r128 = (f32x2*)(A.ws + WS_R128); f32x2* r64 = (f32x2*)(A.ws + WS_R64);
      for (int i = gt; i < T * 64; i += NT) { const int tk = i >> 6, f = i & 63; const float inv = powf(10000.f, -(float)(2 * f) / 128.f), ang = (float)A.pos[tk] * inv; r128[i] = (f32x2){cosf(ang), sinf(ang)}; }
      for (int i = gt; i < T * 32; i += NT) { const int tk = i >> 5, f = i & 31; const float inv = powf(10000.f, -(float)(2 * f) / 64.f), ang = (float)A.pos[tk] * inv; r64[i] = (f32x2){cosf(ang), sinf(ang)}; } }
}

__device__ __forceinline__ void phase_proj(const Args& A, Frame& F, int layer) {
    float* kms = (float*)(A.ws + WS_CTL + KM_OFF) + (size_t)layer * NB * 16 * 512;
    {
        pg8::DenseOrder S; S.init(T, NT8 * 256, DM / 2, A.ws + WS_WIN + layer * WIN_LAYER, F.G, (int)blockIdx.x);
        EpiProj E{(bf16_t*)(A.ws + WS_PROJ), (const f32x2*)(A.ws + WS_R128), (const f32x2*)(A.ws + WS_R64), kms, 0};
        pg8::gemm_phase<EpiProj, pg8::DenseOrder, false, true>(F.lds, (const bf16_t*)(A.ws + WS_XQ), DM / 2, S, E, F.wave);
    }
    {
        pg8::DenseOrder S; S.init(T, NTB * 256, DM, A.ws + WS_WIN + layer * WIN_LAYER + WIN_BF, F.G, (int)blockIdx.x);
        EpiProj E{(bf16_t*)(A.ws + WS_PROJ), (const f32x2*)(A.ws + WS_R128), (const f32x2*)(A.ws + WS_R64), kms, NT8};
        pg8::gemm_phase<EpiProj, pg8::DenseOrder, false, false>(F.lds, (const bf16_t*)(A.ws + WS_XB), DM, S, E, F.wave);
    }
}

constexpr int N_MIX_UNITS = 1152;
__device__ __forceinline__ void phase_mixers(const Args& A, Frame& F, int layer, int rep) {
    unsigned* qh = (unsigned*)(A.ws + WS_CTL) + CW_QUEUE + 64 * layer + 16 * rep;
    LAS char* lds = (LAS char*)F.lds;
    for (;;) {
        __syncthreads();
        if (F.wave == 0 && lane_id() == 0) F.lctl[0] = (int)__hip_atomic_fetch_add(qh, 1u, RLX_AGENT);
        __syncthreads();
        const int u = F.lctl[0];
        if (u >= N_MIX_UNITS) break;
#ifndef UNIT_ONLY
#define UNIT_ONLY (rep == 0 ? 31 : PROBE_MIX)
#endif
#ifndef PROBE_DSA
#define PROBE_DSA 3
#endif
#ifndef PROBE_MIX
#define PROBE_MIX 31
#endif
        int kind, p0, p1;
        if (u < 512)       { kind = 2; p0 = 31 - (u >> 4); p1 = u & 15; }
        else if (u < 640)  { kind = 3; p0 = u - 512; p1 = 0; }
        else if (u < 704)  { kind = 1; p0 = (u - 640) & 7; p1 = 15 - ((u - 640) >> 3); }
        else if (u < 768)  { kind = 0; p0 = (u - 704) & 7; p1 = 31 - ((u - 704) >> 3); }
        else if (u < 832)  { kind = 4; p0 = (u - 768) & 1; p1 = 63 - ((u - 768) >> 1); }
        else if (u < 864)  { kind = 1; p0 = (u - 832) & 7; p1 = 7 - ((u - 832) >> 3); }
        else if (u < 928)  { kind = 0; p0 = (u - 864) & 7; p1 = 23 - ((u - 864) >> 3); }
        else if (u < 960)  { kind = 1; p0 = (u - 928) & 7; p1 = 3 - ((u - 928) >> 3); }
        else { const int v = u - 960, L = 15 - v / 12, w = v % 12;
            if (w < 8) { kind = 0; p0 = w; p1 = L; } else { kind = 4; p0 = (w - 8) & 1; p1 = 2 * L + 1 - ((w - 8) >> 1); } }
        if (kind == 0) { if (UNIT_ONLY & 1) diff_unit(A, layer, p0 >> 2, p0 & 3, p1, lds, F.wave); continue; }
        if (kind == 1) { if (UNIT_ONLY & 2) moba_unit(A, layer, p0 >> 2, p0 & 3, p1, lds, F.wave); continue; }
        if (kind == 2) { if (UNIT_ONLY & 4) dsa_unit(A, layer, p1 >> 3, 128 * p0 + 16 * (p1 & 7), lds, F.wave, rep == 0 ? 3 : PROBE_DSA); continue; }
        if (kind == 4) { if (UNIT_ONLY & 16) dsa_att_unit(A, layer, p0, p1, lds, F.wave); continue; }
        { if (UNIT_ONLY & 8) dil_unit(A, p0 >> 6, (p0 >> 4) & 3, p0 & 15, lds, F.wave); }
    }
}

__device__ __forceinline__ void phase_outproj(const Args& A, Frame& F, int layer) {
    pg8::DenseOrder S; S.init(T, DM, DM, (const bf16_t*)(A.ws + WS_WOUT) + (size_t)layer * DM * DM, F.G, (int)blockIdx.x);
    EpiOut E{(const bf16_t*)(A.ws + WS_XB), (bf16_t*)(A.ws + WS_Y1)};
    pg8::gemm_phase<EpiOut, pg8::DenseOrder, false>(F.lds, (const bf16_t*)(A.ws + WS_MIX), DM, S, E, F.wave);
}

__device__ __forceinline__ void route_token(const float (&lg)[16], const float* rb, LAS int* lcnt, float* tok_gate, int* tok_e, int* tok_rank, int tk, int lane) {
    float aff[16], sc[16];
#pragma unroll
    for (int e = 0; e < 16; ++e) { aff[e] = 1.f / (1.f + expf(-lg[e])); sc[e] = aff[e] + rb[e]; }
    float gbest = NEG_INF; int gi = 0;
#pragma unroll
    for (int k = 0; k < 4; ++k) {
        const float a = sc[4 * k], b = sc[4 * k + 1], c = sc[4 * k + 2], d = sc[4 * k + 3];
        const float m1 = fmaxf(fmaxf(a, b), fmaxf(c, d));
        const float lo1 = fminf(a, b), hi1 = fmaxf(a, b), lo2 = fminf(c, d), hi2 = fmaxf(c, d);
        const float m2 = fmaxf(fminf(hi1, hi2), fmaxf(lo1, lo2));
        const float gs = m1 + m2;
        if (gs > gbest) { gbest = gs; gi = k; }
    }
    float s0 = sc[0], s1 = sc[1], s2_ = sc[2], s3 = sc[3], a0 = aff[0], a1 = aff[1], a2 = aff[2], a3 = aff[3];
#pragma unroll
    for (int k = 1; k < 4; ++k) if (gi == k) { s0 = sc[4 * k]; s1 = sc[4 * k + 1]; s2_ = sc[4 * k + 2]; s3 = sc[4 * k + 3]; a0 = aff[4 * k]; a1 = aff[4 * k + 1]; a2 = aff[4 * k + 2]; a3 = aff[4 * k + 3]; }
    int i1 = 0; float b1 = s0;
    if (s1 > b1) { b1 = s1; i1 = 1; } if (s2_ > b1) { b1 = s2_; i1 = 2; } if (s3 > b1) { b1 = s3; i1 = 3; }
    int i2 = -1; float b2 = NEG_INF;
    if (i1 != 0 && (i2 < 0 || s0 > b2)) { b2 = s0; i2 = 0; }
    if (i1 != 1 && (i2 < 0 || s1 > b2)) { b2 = s1; i2 = 1; }
    if (i1 != 2 && (i2 < 0 || s2_ > b2)) { b2 = s2_; i2 = 2; }
    if (i1 != 3 && (i2 < 0 || s3 > b2)) { b2 = s3; i2 = 3; }
    const float g1 = i1 == 0 ? a0 : i1 == 1 ? a1 : i1 == 2 ? a2 : a3, g2 = i2 == 0 ? a0 : i2 == 1 ? a1 : i2 == 2 ? a2 : a3;
    if (lane == 0) {
        const int e1 = gi * 4 + i1, e2 = gi * 4 + i2; const float gsum = g1 + g2;
        const int r1 = __hip_atomic_fetch_add(lcnt + e1, 1, __ATOMIC_RELAXED, __HIP_MEMORY_SCOPE_WORKGROUP), r2 = __hip_atomic_fetch_add(lcnt + e2, 1, __ATOMIC_RELAXED, __HIP_MEMORY_SCOPE_WORKGROUP);
        tok_e[2 * tk] = e1; tok_e[2 * tk + 1] = e2; tok_rank[2 * tk] = r1; tok_rank[2 * tk + 1] = r2; tok_gate[2 * tk] = g1 / gsum; tok_gate[2 * tk + 1] = g2 / gsum;
    }
}
__device__ __forceinline__ void phase_ln1_router(const Args& A, Frame& F, int layer) {
    const int lane = lane_id(), tid = F.wave * 64 + lane;
    LAS f32x4* wl = (LAS f32x4*)F.lds;
    for (int i = tid; i < 4 * 8 * 4 * 64; i += 512) { const int l = i & 63, c = (i >> 6) & 3, j = (i >> 8) & 7, q = i >> 11; wl[i] = *(const f32x4*)(A.rw + (size_t)(256 * j + 4 * l + c) * 16 + 4 * q); }
    if (tid < 16) F.lctl[96 + tid] = 0;
    __syncthreads();
    bf16_t* Y1 = (bf16_t*)(A.ws + WS_Y1); unsigned char* X1Q = (unsigned char*)(A.ws + WS_X1B);
    int* tok_e = (int*)(A.ws + WS_ROUTE + RT_TOKE); int* tok_rank = (int*)(A.ws + WS_ROUTE + RT_RANK); float* tok_gate = (float*)(A.ws + WS_ROUTE + RT_TOKG);
    LAS int* lcnt = F.lctl + 96;
    const float* g = A.lmg + layer * DM; const float* bb = A.lmb + layer * DM;
    constexpr int TPW = 2;
    u32x2 nx[TPW][8];
    { const int tkf = (F.vcu * 8 + F.wave) * TPW;
#pragma unroll
      for (int u = 0; u < TPW; ++u)
#pragma unroll
          for (int j = 0; j < 8; ++j) nx[u][j] = *(const u32x2*)(Y1 + (size_t)(tkf + u) * DM + 256 * j + 4 * lane); }
#pragma clang loop unroll(disable)
    for (int tk0 = (F.vcu * 8 + F.wave) * TPW; tk0 < T; tk0 += F.G * 8 * TPW) {
        f32x4 v[TPW][8]; float mean[TPW], rstd[TPW];
#pragma unroll
        for (int u = 0; u < TPW; ++u)
#pragma unroll
            for (int j = 0; j < 8; ++j) { const u32x2 y = nx[u][j]; v[u][j][0] = bflo(y.x); v[u][j][1] = bfhi(y.x); v[u][j][2] = bflo(y.y); v[u][j][3] = bfhi(y.y); }
        { const int tkn = tk0 + F.G * 8 * TPW;
          if (tkn < T) {
#pragma unroll
              for (int u = 0; u < TPW; ++u)
#pragma unroll
                  for (int j = 0; j < 8; ++j) nx[u][j] = *(const u32x2*)(Y1 + (size_t)(tkn + u) * DM + 256 * j + 4 * lane); } }
#pragma unroll
        for (int u = 0; u < TPW; ++u) { float s = 0.f;
#pragma unroll
            for (int j = 0; j < 8; ++j) s += (v[u][j][0] + v[u][j][1]) + (v[u][j][2] + v[u][j][3]);
            mean[u] = s; }
#pragma unroll
        for (int u = 0; u < TPW; ++u) mean[u] = allsum(mean[u]);
#pragma unroll
        for (int u = 0; u < TPW; ++u) { mean[u] *= (1.f / DM); float s2 = 0.f;
#pragma unroll
            for (int j = 0; j < 8; ++j) { v[u][j] = v[u][j] - mean[u]; s2 += (v[u][j][0] * v[u][j][0] + v[u][j][1] * v[u][j][1]) + (v[u][j][2] * v[u][j][2] + v[u][j][3] * v[u][j][3]); }
            rstd[u] = s2; }
#pragma unroll
        for (int u = 0; u < TPW; ++u) rstd[u] = allsum(rstd[u]);
#pragma unroll
        for (int u = 0; u < TPW; ++u) rstd[u] = rsqrtf(rstd[u] * (1.f / DM) + LN_EPS);
        float lg[TPW][16];
#pragma unroll
        for (int u = 0; u < TPW; ++u)
#pragma unroll
            for (int e = 0; e < 16; ++e) lg[u][e] = 0.f;
#pragma unroll
        for (int j = 0; j < 8; ++j) {
            const f32x4 gg = *(const f32x4*)(g + 256 * j + 4 * lane), b4 = *(const f32x4*)(bb + 256 * j + 4 * lane);
#pragma unroll
            for (int u = 0; u < TPW; ++u) {
                v[u][j] = v[u][j] * rstd[u] * gg + b4;
                { u32x2 w; w.x = cvtpk(v[u][j][0], v[u][j][1]); w.y = cvtpk(v[u][j][2], v[u][j][3]); *(u32x2*)(Y1 + (size_t)(tk0 + u) * DM + 256 * j + 4 * lane) = w; }
                *(unsigned*)(X1Q + (size_t)(tk0 + u) * DM + 256 * j + 4 * lane) = pk4_fp8(v[u][j][0], v[u][j][1], v[u][j][2], v[u][j][3]);
            }
#pragma unroll
            for (int c = 0; c < 4; ++c) {
#pragma unroll
                for (int q = 0; q < 4; ++q) { const f32x4 w4 = wl[((q * 8 + j) * 4 + c) * 64 + lane];
#pragma unroll
                    for (int u = 0; u < TPW; ++u) { lg[u][4 * q] += v[u][j][c] * w4[0]; lg[u][4 * q + 1] += v[u][j][c] * w4[1]; lg[u][4 * q + 2] += v[u][j][c] * w4[2]; lg[u][4 * q + 3] += v[u][j][c] * w4[3]; } }
                __builtin_amdgcn_sched_barrier(0);
            }
        }
#pragma unroll
        for (int u = 0; u < TPW; ++u)
#pragma unroll
            for (int e = 0; e < 16; ++e) lg[u][e] = allsum(lg[u][e]);
#pragma unroll
        for (int u = 0; u < TPW; ++u) route_token(lg[u], A.rb, lcnt, tok_gate, tok_e, tok_rank, tk0 + u, lane);
    }
    __syncthreads();
    { const int t2 = F.wave * 64 + lane_id();
      if (t2 < 16) ((int*)(A.ws + WS_ROUTE + RT_BLK))[F.vcu * 16 + t2] = lcnt[t2]; }
}
__device__ __forceinline__ void route_finish(const Args& A, Frame& F, int layer) {
    const int lane = lane_id(), tid = F.wave * 64 + lane;
    LAS int* tab = (LAS int*)F.lds;
    const int* blk = (const int*)(A.ws + WS_ROUTE + RT_BLK);
    LAS int* ptot = tab, *pbase = tab + 512;
    { const int e = tid & 15, part = tid >> 4; int tot = 0, base = 0;
      for (int b = part; b < F.G; b += 32) { const int c = blk[b * 16 + e]; tot += c; if (b < F.vcu) base += c; }
      ptot[tid] = tot; pbase[tid] = base; }
    __syncthreads();
    if (tid < 16) { int base = 0, tot = 0;
#pragma unroll
        for (int p_ = 0; p_ < 32; ++p_) { tot += ptot[p_ * 16 + tid]; base += pbase[p_ * 16 + tid]; }
        F.lctl[112 + tid] = base;
        if (F.vcu == 0) ((unsigned*)(A.ws + WS_CTL) + CW_CNT + 64 * layer)[tid] = (unsigned)tot; }
    __syncthreads();
    const int* tok_e = (const int*)(A.ws + WS_ROUTE + RT_TOKE); int* tok_rank = (int*)(A.ws + WS_ROUTE + RT_RANK); const float* tok_gate = (const float*)(A.ws + WS_ROUTE + RT_TOKG);
    int* tok_list = (int*)(A.ws + WS_ROUTE + RT_LIST); float* sgate = (float*)(A.ws + WS_ROUTE + RT_GATE);
    if (tid < 64) {
        const int k = tid & 1, u = (tid >> 1) & 1, w = (tid >> 2) & 7, it = tid >> 5;
        const int tk = (F.vcu * 8 + w) * 2 + u + F.G * 16 * it;
        if (tk < T) { const int e = tok_e[2 * tk + k], r = F.lctl[112 + e] + tok_rank[2 * tk + k];
            tok_rank[2 * tk + k] = r; tok_list[e * 8192 + r] = tk; sgate[e * 8192 + r] = tok_gate[2 * tk + k]; } }
}

__device__ __forceinline__ void moe_table(const Args& A, Frame& F, int layer) {
    __syncthreads();
    if (F.wave == 0) {
        const unsigned* cnt = (const unsigned*)(A.ws + WS_CTL) + CW_CNT + 64 * layer;
        const int lane = lane_id();
        if (lane < 16) F.lctl[16 + lane] = (int)__hip_atomic_load(cnt + lane, RLX_AGENT);
        __builtin_amdgcn_fence(__ATOMIC_RELEASE, "wavefront"); __builtin_amdgcn_wave_barrier();
        if (lane == 0) {
            int ps = 0, ub = 0;
            for (int e = 0; e < 16; ++e) { const int c = F.lctl[16 + e], mt = (c + 255) >> 8; F.lctl[32 + e] = ps; F.lctl[48 + e] = ub; ps += mt * 256; ub += mt * 8; }
            F.lctl[48 + 16] = ub;
        }
    }
    __syncthreads();
}
__device__ __forceinline__ void phase_moe_gu(const Args& A, Frame& F, int layer) {
    moe_table(A, F, layer);
    MoeSched S{F.lctl + 16, F.G, F.vcu, DM / 2, (const char*)(A.ws + WS_WGU) + (size_t)layer * NE * DM * DM, (size_t)DM * DM, (const int*)(A.ws + WS_ROUTE + RT_LIST), 1};
    EpiGU E{(unsigned char*)(A.ws + WS_H)};
    pg8::gemm_phase<EpiGU, MoeSched, true, true>(F.lds, (const bf16_t*)(A.ws + WS_X1B), DM / 2, S, E, F.wave);
}
__device__ __forceinline__ void phase_moe_down(const Args& A, Frame& F, int layer) {
    moe_table(A, F, layer);
    MoeSched S{F.lctl + 16, F.G, F.vcu, DFF / 2, (const char*)(A.ws + WS_WD) + (size_t)layer * NE * DM * DFF, (size_t)DM * DFF, nullptr, 0};
    EpiDown E{(bf16_t*)(A.ws + WS_YS), (const float*)(A.ws + WS_ROUTE + RT_GATE)};
    pg8::gemm_phase<EpiDown, MoeSched, false, true>(F.lds, (const bf16_t*)(A.ws + WS_H), DFF / 2, S, E, F.wave);
}

__device__ __forceinline__ void phase_final_ln(const Args& A, Frame& F, int layer) {
    moe_table(A, F, layer);
    const int lane = lane_id();
    const bf16_t* X1 = (const bf16_t*)(A.ws + WS_Y1); const bf16_t* YS = (const bf16_t*)(A.ws + WS_YS);
    const int* tok_e = (const int*)(A.ws + WS_ROUTE + RT_TOKE); const int* tok_rank = (const int*)(A.ws + WS_ROUTE + RT_RANK);
    const float* g = A.lfg + layer * DM; const float* bb = A.lfb + layer * DM;
    float* XO = A.out; bf16_t* XB = (bf16_t*)(A.ws + WS_XB);
    constexpr int TPW = 4;
    for (int tk0 = (F.vcu * 8 + F.wave) * TPW; tk0 < T; tk0 += F.G * 8 * TPW) {
        f32x4 v[TPW][8]; float mean[TPW], rstd[TPW]; size_t s1[TPW], s2[TPW];
#pragma unroll
        for (int u = 0; u < TPW; ++u) { const int tk = tk0 + u; const int e1 = tok_e[2 * tk], e2 = tok_e[2 * tk + 1];
            s1[u] = (size_t)(F.lctl[32 + e1] + tok_rank[2 * tk]) * DM; s2[u] = (size_t)(F.lctl[32 + e2] + tok_rank[2 * tk + 1]) * DM; }
#pragma unroll
        for (int u = 0; u < TPW; ++u) {
#pragma unroll
            for (int j = 0; j < 8; ++j) { const int k = 256 * j + 4 * lane; const u32x2 xw = *(const u32x2*)(X1 + (size_t)(tk0 + u) * DM + k); const float x[4] = {bflo(xw.x), bfhi(xw.x), bflo(xw.y), bfhi(xw.y)};
                const u32x2 ya = *(const u32x2*)(YS + s1[u] + k), yb = *(const u32x2*)(YS + s2[u] + k);
                v[u][j][0] = x[0] * ALPHA + (bflo(ya.x) + bflo(yb.x)); v[u][j][1] = x[1] * ALPHA + (bfhi(ya.x) + bfhi(yb.x));
                v[u][j][2] = x[2] * ALPHA + (bflo(ya.y) + bflo(yb.y)); v[u][j][3] = x[3] * ALPHA + (bfhi(ya.y) + bfhi(yb.y)); } }
#pragma unroll
        for (int u = 0; u < TPW; ++u) { float s = 0.f;
#pragma unroll
            for (int j = 0; j < 8; ++j) s += (v[u][j][0] + v[u][j][1]) + (v[u][j][2] + v[u][j][3]);
            mean[u] = s; }
#pragma unroll
        for (int u = 0; u < TPW; ++u) mean[u] = allsum(mean[u]);
#pragma unroll
        for (int u = 0; u < TPW; ++u) { mean[u] *= (1.f / DM); float q2 = 0.f;
#pragma unroll
            for (int j = 0; j < 8; ++j) { v[u][j] = v[u][j] - mean[u]; q2 += (v[u][j][0] * v[u][j][0] + v[u][j][1] * v[u][j][1]) + (v[u][j][2] * v[u][j][2] + v[u][j][3] * v[u][j][3]); }
            rstd[u] = q2; }
#pragma unroll
        for (int u = 0; u < TPW; ++u) rstd[u] = allsum(rstd[u]);
#pragma unroll
        for (int u = 0; u < TPW; ++u) rstd[u] = rsqrtf(rstd[u] * (1.f / DM) + LN_EPS);
#pragma unroll
        for (int j = 0; j < 8; ++j) { const int k = 256 * j + 4 * lane; const f32x4 gg = *(const f32x4*)(g + k), b4 = *(const f32x4*)(bb + k);
#pragma unroll
            for (int u = 0; u < TPW; ++u) { const f32x4 o = v[u][j] * rstd[u] * gg + b4;
                if (layer == DEPTH - 1) *(f32x4*)(XO + (size_t)(tk0 + u) * DM + k) = o;
                if (layer != DEPTH - 1) { u32x2 w; w.x = cvtpk(o[0], o[1]); w.y = cvtpk(o[2], o[3]); *(u32x2*)(XB + (size_t)(tk0 + u) * DM + k) = w;
                    *(unsigned*)(A.ws + WS_XQ + (size_t)(tk0 + u) * DM + k) = pk4_fp8(o[0], o[1], o[2], o[3]); } } }
    }
}

constexpr int N_PHASES = 1 + 7 * DEPTH;
__global__ void __launch_bounds__(512, 2) fwd(Args A_karg) {
    extern __shared__ __attribute__((aligned(16))) unsigned char lds_raw[];
    Frame F; F.lds = (LAS unsigned char*)lds_raw; F.lctl = (LAS int*)(F.lds + LDS_CTL_OFF);
    const int wave0 = __builtin_amdgcn_readfirstlane((int)threadIdx.x >> 6); F.wave = wave0;
    F.G = gridDim.x; { const int bx = blockIdx.x; F.vcu = (F.G % 8 == 0) ? (bx % 8) * (F.G / 8) + bx / 8 : bx; }
    const int vcu0 = F.vcu;
    const int lo = A_karg.ph_lo, hi = A_karg.ph_hi;
#ifndef USE_CG_SYNC
#define USE_CG_SYNC 0
#endif
    const bool leader = (wave0 == 0 && lane_id() == 0);
    if (leader) { F.lctl[8] = 0; F.lctl[9] = 0; }
    __syncthreads();
    XcdBarrier xbar; xbar.bar = nullptr; xbar.x = 0; xbar.st = nullptr;
    if (!USE_CG_SYNC && hi - lo > 1) xbar = xcd_barrier_post((unsigned*)(A_karg.ws + WS_CTL) + CW_BAR, (volatile LAS unsigned*)(F.lctl + 8), leader);
    typedef const __attribute__((address_space(4))) Args* kargp_t;
    int ph = lo, rep = 0;
    while (ph < hi) {
        kargp_t kp = (kargp_t)__builtin_amdgcn_kernarg_segment_ptr(); asm volatile("" : "+s"(kp));
        Args A; A.x = kp->x; A.pos = kp->pos; A.w_in = kp->w_in; A.w_out = kp->w_out; A.dlam = kp->dlam; A.dng = kp->dng; A.lmg = kp->lmg; A.lmb = kp->lmb; A.rw = kp->rw; A.rb = kp->rb;
        A.wg = kp->wg; A.wu = kp->wu; A.wd = kp->wd; A.lfg = kp->lfg; A.lfb = kp->lfb; A.out = kp->out; A.ws = kp->ws; A.ph_lo = lo; A.ph_hi = hi;
        { int w_ = wave0, c_ = vcu0, g_ = (int)gridDim.x; asm volatile("" : "+s"(w_), "+s"(c_), "+s"(g_)); F.wave = w_; F.vcu = c_; F.G = g_; }
#ifdef PHASE_ONLY
        { const int layer = ph & 1;
          if (PHASE_ONLY == 0) phase_prologue(A, F);
          if (PHASE_ONLY == 1) phase_proj(A, F, layer);
          if (PHASE_ONLY == 2) phase_mixers(A, F, layer, 0);
          if (PHASE_ONLY == 3) phase_outproj(A, F, layer);
          if (PHASE_ONLY == 4) phase_ln1_router(A, F, layer);
          if (PHASE_ONLY == 5) phase_moe_gu(A, F, layer);
          if (PHASE_ONLY == 6) phase_moe_down(A, F, layer);
          if (PHASE_ONLY == 7) phase_final_ln(A, F, layer);
          ++ph; continue; }
#endif
#ifndef PROBE_REP
#define PROBE_REP 0
#endif
        const int kind = ph == 0 ? 0 : 1 + (ph - 1) % 7;
        if (ph == 0) phase_prologue(A, F);
        else {
            const int layer = (ph - 1) / 7, k = (ph - 1) % 7;
            if (k == 0) phase_proj(A, F, layer);
            else if (k == 1) phase_mixers(A, F, layer, rep);
            else if (k == 2) phase_outproj(A, F, layer);
            else if (k == 3) phase_ln1_router(A, F, layer);
            else if (k == 4) phase_moe_gu(A, F, layer);
            else if (k == 5) phase_moe_down(A, F, layer);
            else phase_final_ln(A, F, layer);
        }
        if (ph > 0 && (ph - 1) % 7 == 3 && rep == 0) {
            if (USE_CG_SYNC) cg::this_grid().sync(); else xcd_barrier(xbar, wave0 == 0 && lane_id() == 0);
            route_finish(A, F, (ph - 1) / 7);
        }
        {
            const int k7 = ph == 0 ? -1 : (ph - 1) % 7, lay = ph == 0 ? 0 : (ph - 1) / 7;
            int must = 0; bool opp = false;
            if (k7 == 0) { opp = true; }
            else if (k7 == 1) { must = lay == 0 ? FILL_E1 : FILL_E5; opp = true; }
            else if (k7 == 3) { must = lay == 0 ? FILL_E2 : FILL_E6; }
            else if (k7 == 4) { must = lay == 0 ? FILL_E3 : FILL_E7; opp = true; }
            else if (k7 == 5) { opp = true; }
            else if (k7 == 6) { must = lay == 0 ? FILL_E4 : FILL_E7; }
            if (ph > 0 && rep == 0 && (must > 0 || opp)) fill_run(A, F, must, opp, ph);
        }
        if (rep == 0 && ((PROBE_REP >> kind) & 1)) rep = 1; else { rep = 0; ++ph; }
#ifndef PROBE_SYNC
#define PROBE_SYNC 1
#endif
        if (ph < hi) { for (int k_ = 0; k_ < PROBE_SYNC; ++k_) { if (USE_CG_SYNC) cg::this_grid().sync(); else xcd_barrier(xbar, wave0 == 0 && lane_id() == 0); } }
    }
}

extern "C" void kernel_launch(void* const* d_in, const int* in_sizes, int n_in, void* d_out, int out_size, void* d_ws, size_t ws_size, hipStream_t stream) {
    static int grid = 0;
    if (grid == 0) {
        if (n_in != 15 || ws_size < WS_END) { fprintf(stderr, "kernel_launch: unexpected inputs (n_in %d, ws %zu)\n", n_in, ws_size); grid = -1; return; }
        int dev = 0, cus = 0, per_cu = 0;
        hipGetDevice(&dev); hipDeviceGetAttribute(&cus, hipDeviceAttributeMultiprocessorCount, dev);
        hipFuncSetAttribute((const void*)fwd, hipFuncAttributeMaxDynamicSharedMemorySize, LDS_BYTES);
        hipOccupancyMaxActiveBlocksPerMultiprocessor(&per_cu, (const void*)fwd, 512, LDS_BYTES);
        if (per_cu < 1) { fprintf(stderr, "kernel_launch: occupancy query says %d blocks per CU\n", per_cu); per_cu = 1; }
        (void)hipGetLastError();
        grid = cus;
    }
    if (grid < 0) return;
    hipMemsetAsync((char*)d_ws + WS_CTL, 0, CTL_BYTES, stream);
    Args a{};
    a.x = (const float*)d_in[0]; a.pos = (const int*)d_in[1]; a.w_in = (const float*)d_in[2]; a.w_out = (const float*)d_in[3]; a.dlam = (const float*)d_in[4]; a.dng = (const float*)d_in[5];
    a.lmg = (const float*)d_in[6]; a.lmb = (const float*)d_in[7]; a.rw = (const float*)d_in[8]; a.rb = (const float*)d_in[9]; a.wg = (const float*)d_in[10]; a.wu = (const float*)d_in[11];
    a.wd = (const float*)d_in[12]; a.lfg = (const float*)d_in[13]; a.lfb = (const float*)d_in[14]; a.out = (float*)d_out; a.ws = (unsigned char*)d_ws;
#if MK_N_LAUNCHES == 1
    a.ph_lo = 0; a.ph_hi = N_PHASES;
    void* args[] = {&a};
    hipError_t e = hipLaunchCooperativeKernel((const void*)fwd, dim3(grid), dim3(512), args, LDS_BYTES, stream);
    if (e != hipSuccess) fprintf(stderr, "cooperative launch failed: %s (grid %d)\n", hipGetErrorString(e), grid);
#else
    for (int ph = 0; ph < N_PHASES; ++ph) { a.ph_lo = ph; a.ph_hi = ph + 1; hipLaunchKernelGGL(fwd, dim3(grid), dim3(512), LDS_BYTES, stream, a); }
#endif
}
```
